# Optimizing an MI355X kernel written in HIP

```python
import jax
import jax.numpy as jnp
from jax import lax
import numpy as np

D_MODEL = 1024
BATCH = 2
SEQ = 8192
DEPTH = 2
DEC_BATCH = 8
DEC_SEQ = 16
PAST_LEN = 4096

CHUNK = 64
LEFT_CHUNKS = 8
ATT_WINDOW = LEFT_CHUNKS * CHUNK
BAND = (LEFT_CHUNKS + 1) * CHUNK
N_HEADS_A = 8
HEAD_DIM_A = 64
WIDTH_A = N_HEADS_A * HEAD_DIM_A
REL_CLIP = 256
N_HEADS_B = 4
HEAD_DIM_B = 128
WIDTH_B = N_HEADS_B * HEAD_DIM_B
MIX_WIDTH = WIDTH_A + WIDTH_B
D_FF = 2816
CONV_W = 3
EPS = 1e-6
IN_SPLITS = (WIDTH_A, 2 * WIDTH_A, 3 * WIDTH_A,
             3 * WIDTH_A + WIDTH_B, 3 * WIDTH_A + 2 * WIDTH_B, 3 * WIDTH_A + 3 * WIDTH_B,
             3 * WIDTH_A + 4 * WIDTH_B, 3 * WIDTH_A + 4 * WIDTH_B + N_HEADS_B)
D_IN = 3 * WIDTH_A + 4 * WIDTH_B + 2 * N_HEADS_B

kernel_name = "hymba_chunkattn_mlstm_convffn_step"


def rms_norm(x, g):
    xf = x.astype(jnp.float32)
    y = xf * lax.rsqrt(jnp.mean(xf * xf, axis=-1, keepdims=True) + EPS)
    return (y * g.astype(jnp.float32)).astype(x.dtype)


def rel_bias(rel_table, q_pos, k_pos):
    idx = jnp.clip(q_pos[:, None] - k_pos[None, :], -REL_CLIP, REL_CLIP) + REL_CLIP
    return rel_table[:, idx].astype(jnp.float32)


def band_attention_prompt(q, k, v, rel_table):
    B, S = q.shape[:2]
    n_chunks = S // CHUNK
    qc = q.reshape(B, n_chunks, CHUNK, N_HEADS_A, HEAD_DIM_A)
    pad = ((0, 0), (ATT_WINDOW, 0), (0, 0), (0, 0))
    kp = jnp.pad(k, pad).reshape(B, n_chunks + LEFT_CHUNKS, CHUNK, N_HEADS_A, HEAD_DIM_A)
    vp = jnp.pad(v, pad).reshape(B, n_chunks + LEFT_CHUNKS, CHUNK, N_HEADS_A, HEAD_DIM_A)
    band_idx = jnp.arange(n_chunks)[:, None] + jnp.arange(LEFT_CHUNKS + 1)[None, :]
    kb = kp[:, band_idx].reshape(B, n_chunks, BAND, N_HEADS_A, HEAD_DIM_A)
    vb = vp[:, band_idx].reshape(B, n_chunks, BAND, N_HEADS_A, HEAD_DIM_A)
    s = jnp.einsum('bcqhd,bckhd->bhcqk', qc, kb, preferred_element_type=jnp.float32)
    s = s * (HEAD_DIM_A ** -0.5)
    bias = rel_bias(rel_table, ATT_WINDOW + jnp.arange(CHUNK), jnp.arange(BAND))
    s = s + bias[None, :, None]
    valid = (jnp.arange(n_chunks)[:, None] + jnp.arange(BAND)[None, :] // CHUNK) >= LEFT_CHUNKS
    s = jnp.where(valid[None, None, :, None, :], s, -jnp.inf)
    p = jax.nn.softmax(s, axis=-1).astype(v.dtype)
    o = jnp.einsum('bhcqk,bckhd->bcqhd', p, vb)
    return o.reshape(B, S, WIDTH_A)


def band_attention_step(q, k, v, k_cache, v_cache, rel_table):
    B, S = q.shape[:2]
    L = k_cache.shape[2]
    kk = jnp.concatenate([k_cache.astype(k.dtype), k.transpose(0, 2, 1, 3)], axis=2)
    vv = jnp.concatenate([v_cache.astype(v.dtype), v.transpose(0, 2, 1, 3)], axis=2)
    s = jnp.einsum('bqhd,bhkd->bhqk', q, kk, preferred_element_type=jnp.float32)
    s = s * (HEAD_DIM_A ** -0.5) + rel_bias(rel_table, L + jnp.arange(S), jnp.arange(L + S))[None]
    p = jax.nn.softmax(s, axis=-1).astype(v.dtype)
    o = jnp.einsum('bhqk,bhkd->bqhd', p, vv)
    return o.reshape(B, S, WIDTH_A)


def mlstm_block(carry, inp):
    c_prev, n_prev, m_prev = carry
    q, k, v, ig, lf = inp
    L = q.shape[2]
    b = jnp.cumsum(lf, axis=-1)
    causal = jnp.tril(jnp.ones((L, L), dtype=bool))
    d_mat = b[..., :, None] - b[..., None, :] + ig[..., None, :]
    d_mat = jnp.where(causal, d_mat, -jnp.inf)
    inter = b + m_prev[..., None]
    m_t = jnp.maximum(inter, jnp.max(d_mat, axis=-1))
    w_intra = jnp.exp(d_mat - m_t[..., None])
    w_inter = jnp.exp(inter - m_t)
    qk = jnp.einsum('bhtd,bhsd->bhts', q, k) * w_intra
    num = jnp.einsum('bhts,bhse->bhte', qk, v) + w_inter[..., None] * jnp.einsum('bhtd,bhde->bhte', q, c_prev)
    den = jnp.sum(qk, axis=-1) + w_inter * jnp.einsum('bhtd,bhd->bht', q, n_prev)
    h = num / jnp.maximum(jnp.abs(den), jnp.exp(-m_t))[..., None]
    m_new = m_t[..., -1]
    w_s = jnp.exp(b[..., -1:] - b + ig - m_new[..., None])
    decay = jnp.exp(b[..., -1] + m_prev - m_new)
    c_new = decay[..., None, None] * c_prev + jnp.einsum('bhs,bhsd,bhse->bhde', w_s, k, v)
    n_new = decay[..., None] * n_prev + jnp.einsum('bhs,bhsd->bhd', w_s, k)
    return (c_new, n_new, m_new), h


def mlstm_sequence(q, k, v, ig, lf, c0, n0, m0):
    B, H, S, d = q.shape
    carry0 = (c0.astype(jnp.float32), n0.astype(jnp.float32), m0.astype(jnp.float32))
    if S <= CHUNK:
        carry, h = mlstm_block(carry0, (q, k, v, ig, lf))
        return h, carry
    nb = S // CHUNK

    def to_blocks(t):
        return jnp.moveaxis(t.reshape((B, H, nb, CHUNK) + t.shape[3:]), 2, 0)

    xs = (to_blocks(q), to_blocks(k), to_blocks(v), to_blocks(ig), to_blocks(lf))
    carry, hb = lax.scan(mlstm_block, carry0, xs)
    h = jnp.moveaxis(hb, 0, 2).reshape(B, H, S, d)
    return h, carry


def conv_ffn(h, buf, w_up, w_conv, b_conv, w_down):
    S = h.shape[1]
    u = h @ w_up
    ext = jnp.concatenate([buf.astype(u.dtype), u], axis=1)
    y = b_conv
    for j in range(CONV_W):
        y = y + ext[:, j:j + S] * w_conv[j]
    gate, up = jnp.split(y, 2, axis=-1)
    out = (jax.nn.gelu(gate, approximate=True) * up) @ w_down
    return out, ext[:, S:]


def layer(x, k_cache, v_cache, c0, n0, m0, conv_buf, norm_g, w_in, b_i, b_f, rel_table,
          g_att, g_mlstm, w_out, w_up, w_conv, b_conv, w_down):
    B, S, _ = x.shape
    h = rms_norm(x, norm_g[0])
    z = h @ w_in
    qa, ka, va, qb, kb, vb, ob, ib, fb = jnp.split(z, IN_SPLITS, axis=-1)
    qa = qa.reshape(B, S, N_HEADS_A, HEAD_DIM_A)
    ka = ka.reshape(B, S, N_HEADS_A, HEAD_DIM_A)
    va = va.reshape(B, S, N_HEADS_A, HEAD_DIM_A)
    if k_cache is None:
        att = band_attention_prompt(qa, ka, va, rel_table)
        keep = min(ATT_WINDOW, S)
        new_k = ka[:, S - keep:].transpose(0, 2, 1, 3)
        new_v = va[:, S - keep:].transpose(0, 2, 1, 3)
    else:
        att = band_attention_step(qa, ka, va, k_cache, v_cache, rel_table)
        new_k = ka.transpose(0, 2, 1, 3)
        new_v = va.transpose(0, 2, 1, 3)
    att = rms_norm(att, g_att)

    def heads_b(t):
        return t.reshape(B, S, N_HEADS_B, HEAD_DIM_B).transpose(0, 2, 1, 3).astype(jnp.float32)

    qh = heads_b(qb)
    kh = heads_b(kb) * (HEAD_DIM_B ** -0.5)
    vh = heads_b(vb)
    ig = (ib + b_i).astype(jnp.float32).transpose(0, 2, 1)
    lf = jax.nn.log_sigmoid((fb + b_f).astype(jnp.float32)).transpose(0, 2, 1)
    hb, (c1, n1, m1) = mlstm_sequence(qh, kh, vh, ig, lf, c0, n0, m0)
    hb = hb * lax.rsqrt(jnp.mean(hb * hb, axis=-1, keepdims=True) + EPS)
    hb = hb.transpose(0, 2, 1, 3).reshape(B, S, WIDTH_B)
    mlstm_out = (hb * g_mlstm.astype(jnp.float32) * jax.nn.sigmoid(ob.astype(jnp.float32))).astype(x.dtype)

    mix = jnp.concatenate([att, mlstm_out], axis=-1) @ w_out
    x = x + rms_norm(mix, norm_g[1])
    ffn, new_buf = conv_ffn(rms_norm(x, norm_g[2]), conv_buf, w_up, w_conv, b_conv, w_down)
    x = x + rms_norm(ffn, norm_g[3])
    return x, new_k, new_v, c1, n1, m1, new_buf


def setup_inputs(seed: int = 0) -> dict:
    key = jax.random.key(seed)
    ks = jax.random.split(key, 20)
    att_cache = min(ATT_WINDOW, PAST_LEN)
    f32 = jnp.float32
    nrm = lambda k, shape, s: (jax.random.normal(k, shape, f32) * s)
    return {
        "x_prompt": nrm(ks[0], (BATCH, SEQ, D_MODEL), 1.0),
        "x_sample": nrm(ks[1], (DEC_BATCH, DEC_SEQ, D_MODEL), 1.0),
        "cache_k_att": nrm(ks[2], (DEPTH, DEC_BATCH, N_HEADS_A, att_cache, HEAD_DIM_A), 1.0),
        "cache_v_att": nrm(ks[3], (DEPTH, DEC_BATCH, N_HEADS_A, att_cache, HEAD_DIM_A), 1.0),
        "state_mlstm_c": nrm(ks[4], (DEPTH, DEC_BATCH, N_HEADS_B, HEAD_DIM_B, HEAD_DIM_B), 0.1),
        "state_mlstm_n": nrm(ks[5], (DEPTH, DEC_BATCH, N_HEADS_B, HEAD_DIM_B), 0.1),
        "state_mlstm_m": nrm(ks[6], (DEPTH, DEC_BATCH, N_HEADS_B), 0.5),
        "cache_ffn_conv": nrm(ks[7], (DEPTH, DEC_BATCH, CONV_W - 1, 2 * D_FF), 1.0),
        "norm_g": 1.0 + nrm(ks[8], (DEPTH, 4, D_MODEL), 0.05),
        "w_in": nrm(ks[9], (DEPTH, D_MODEL, D_IN), D_MODEL ** -0.5),
        "b_i": nrm(ks[10], (DEPTH, N_HEADS_B), 0.1),
        "b_f": jnp.linspace(3.0, 6.0, N_HEADS_B, dtype=f32)[None, :] + nrm(ks[11], (DEPTH, N_HEADS_B), 0.1),
        "rel_table": nrm(ks[12], (DEPTH, N_HEADS_A, 2 * REL_CLIP + 1), 0.5),
        "g_att": 1.0 + nrm(ks[13], (DEPTH, WIDTH_A), 0.05),
        "g_mlstm": 1.0 + nrm(ks[14], (DEPTH, WIDTH_B), 0.05),
        "w_out": nrm(ks[15], (DEPTH, MIX_WIDTH, D_MODEL), MIX_WIDTH ** -0.5),
        "w_up": nrm(ks[16], (DEPTH, D_MODEL, 2 * D_FF), D_MODEL ** -0.5),
        "w_conv": nrm(ks[17], (DEPTH, CONV_W, 2 * D_FF), CONV_W ** -0.5),
        "b_conv": nrm(ks[18], (DEPTH, 2 * D_FF), 0.02),
        "w_down": nrm(ks[19], (DEPTH, D_FF, D_MODEL), D_FF ** -0.5),
    }


def reference(x_prompt, x_sample, cache_k_att, cache_v_att, state_mlstm_c, state_mlstm_n,
              state_mlstm_m, cache_ffn_conv, norm_g, w_in, b_i, b_f, rel_table, g_att, g_mlstm,
              w_out, w_up, w_conv, b_conv, w_down):
    bp = x_prompt.shape[0]
    c_zero = jnp.zeros((bp, N_HEADS_B, HEAD_DIM_B, HEAD_DIM_B), jnp.float32)
    n_zero = jnp.zeros((bp, N_HEADS_B, HEAD_DIM_B), jnp.float32)
    m_zero = jnp.zeros((bp, N_HEADS_B), jnp.float32)
    buf_zero = jnp.zeros((bp, CONV_W - 1, 2 * D_FF), x_prompt.dtype)
    xp = x_prompt
    xs = x_sample
    pk, pv, pc, pn, pm, pconv = [], [], [], [], [], []
    sk, sv, sc, sn, sm, sconv = [], [], [], [], [], []
    for l in range(DEPTH):
        xp, k1, v1, c1, n1, m1, b1 = layer(
            xp, None, None, c_zero, n_zero, m_zero, buf_zero, norm_g[l], w_in[l], b_i[l], b_f[l],
            rel_table[l], g_att[l], g_mlstm[l], w_out[l], w_up[l], w_conv[l], b_conv[l], w_down[l])
        pk.append(k1); pv.append(v1); pc.append(c1); pn.append(n1); pm.append(m1); pconv.append(b1)
        xs, k2, v2, c2, n2, m2, b2 = layer(
            xs, cache_k_att[l], cache_v_att[l], state_mlstm_c[l], state_mlstm_n[l], state_mlstm_m[l],
            cache_ffn_conv[l], norm_g[l], w_in[l], b_i[l], b_f[l], rel_table[l], g_att[l], g_mlstm[l],
            w_out[l], w_up[l], w_conv[l], b_conv[l], w_down[l])
        sk.append(k2); sv.append(v2); sc.append(c2); sn.append(n2); sm.append(m2); sconv.append(b2)
    k_att_prompt = jnp.stack(pk)
    v_att_prompt = jnp.stack(pv)
    mlstm_c_prompt = jnp.stack(pc)
    mlstm_n_prompt = jnp.stack(pn)
    mlstm_m_prompt = jnp.stack(pm)
    ffn_conv_prompt = jnp.stack(pconv)
    k_att_sample = jnp.stack(sk)
    v_att_sample = jnp.stack(sv)
    mlstm_c_sample = jnp.stack(sc)
    mlstm_n_sample = jnp.stack(sn)
    mlstm_m_sample = jnp.stack(sm)
    ffn_conv_sample = jnp.stack(sconv)
    return (xp, xs, k_att_prompt, v_att_prompt, mlstm_c_prompt, mlstm_n_prompt, mlstm_m_prompt,
            ffn_conv_prompt, k_att_sample, v_att_sample, mlstm_c_sample, mlstm_n_sample,
            mlstm_m_sample, ffn_conv_sample)
```

```cpp
#include <hip/hip_runtime.h>
#include <hip/hip_cooperative_groups.h>
#include <cstdio>
#include <cstdint>
#include <cmath>
namespace cg = cooperative_groups;

namespace pg8 {
#define PG8_LAS __attribute__((address_space(3)))
typedef unsigned short bf16_t;
typedef short bf16x8 __attribute__((ext_vector_type(8)));
typedef float f32x4 __attribute__((ext_vector_type(4)));
typedef unsigned u32x4 __attribute__((ext_vector_type(4)));
constexpr int BM = 256, BK = 64, HALF = 128, HTB = HALF * BK * 2  , STAGE_BYTES = 8 * HTB, NXCD = 8, WGM = 8;

__host__ __device__ __forceinline__ int lds_byte(int r, int c) { const int st = (r >> 4) * 2 + (c >> 5), rr = r & 15, cc = c & 31, ob = rr * 64 + cc * 2; return st * 1024 + (ob ^ (((ob >> 9) & 1) << 5)); }
__host__ __device__ __forceinline__ void stage_rc(int b, int& R, int& C) { const int st = b / 1024, sb = b % 1024, swz = sb ^ (((sb >> 9) & 1) << 5); R = (st >> 1) * 16 + swz / 64; C = (st & 1) * 32 + (swz % 64) / 2; }
__host__ __device__ __forceinline__ int perm32(int rho) { const int n = rho >> 4, i = rho & 15; return 8 * (i >> 2) + 4 * n + (i & 3); }

struct Unit { int pm, pn; };
struct Gemm { const bf16_t* A; const bf16_t* Bt; int M, N, K; };

struct StaticOrder {
    int nM, nN, nwg, G, c;
    __host__ __device__ void init(int M, int N, int G_, int c_) { nM = M / BM; nN = N / BM; nwg = nM * nN; G = G_; c = c_; }
    __host__ __device__ bool next(int i, Unit& u) const {
        const long L = (long)i * G + c; if (L >= nwg) return false;
        int wgid = (int)L; { const int q = nwg / NXCD, r = nwg % NXCD, xcd = wgid % NXCD, off = wgid / NXCD; wgid = (xcd < r ? xcd * (q + 1) : r * (q + 1) + (xcd - r) * q) + off; }
        const int nig = WGM * nN, gid = wgid / nig, fm = gid * WGM, gsz = (nM - fm) < WGM ? (nM - fm) : WGM;
        u.pm = fm + ((wgid % nig) % gsz); u.pn = (wgid % nig) / gsz; return true;
    }
    __device__ __forceinline__ void a_ready(const Unit&) const {}
    __device__ __forceinline__ void done(const Unit&) const {}
};

typedef float f32x2e __attribute__((ext_vector_type(2)));
typedef __bf16 bf16x2e __attribute__((ext_vector_type(2)));
__device__ __forceinline__ unsigned cvt_pk_bf16(float lo, float hi) { f32x2e v = {lo, hi}; bf16x2e b = __builtin_convertvector(v, bf16x2e); return __builtin_bit_cast(unsigned, b); }
__device__ __forceinline__ float gelu_t(float x) { const float ee = __builtin_amdgcn_exp2f(x * (2.3022082f + 0.10294324f * x * x)); return x - x * __builtin_amdgcn_rcpf(ee + 1.f); }
__device__ __forceinline__ float dpp_shr1(float v) { return __builtin_bit_cast(float, __builtin_amdgcn_update_dpp(0, __builtin_bit_cast(int, v), 0x111, 0xf, 0xf, true)); }
__device__ __forceinline__ float dpp_shr2(float v) { return __builtin_bit_cast(float, __builtin_amdgcn_update_dpp(0, __builtin_bit_cast(int, v), 0x112, 0xf, 0xf, true)); }
struct EpiGen {
    static constexpr bool PERM = true, AFTER_DRAIN = false;
    void* O; int ldc; int mode;
    void* O2; const float* cw; const float* cb;
    float* IGo; float* LFo; const float* bi; const float* bfg;
    __device__ __forceinline__ void operator()(const f32x4 (&acc)[2][2][4][2], const Unit& u, int wr, int wc, int fr, int fq) const {
        const int row0 = u.pm * BM + wr * 64 + fr; const int col0 = u.pn * BM + wc * 32 + 8 * fq;
        if (mode == 3) {
            const int f0 = u.pn * 128 + wc * 32 + 8 * fq;
#pragma unroll
            for (int n = 0; n < 2; ++n) {
                const int fn = f0 + 4 * n;
                const f32x4 w0g = *(const f32x4*)(cw + fn), w1g = *(const f32x4*)(cw + 5632 + fn), w2g = *(const f32x4*)(cw + 2 * 5632 + fn), bg = *(const f32x4*)(cb + fn);
                const f32x4 w0u = *(const f32x4*)(cw + 2816 + fn), w1u = *(const f32x4*)(cw + 5632 + 2816 + fn), w2u = *(const f32x4*)(cw + 2 * 5632 + 2816 + fn), bu = *(const f32x4*)(cb + 2816 + fn);
#pragma unroll
                for (int ai = 0; ai < 2; ++ai)
#pragma unroll
                    for (int m = 0; m < 4; ++m) { const int row = row0 + ai * HALF + m * 16;
                        float og[4];
#pragma unroll
                        for (int i = 0; i < 4; ++i) { const float ug = acc[ai][0][m][n][i], uu = acc[ai][1][m][n][i];
                            const float yg = bg[i] + dpp_shr2(ug) * w0g[i] + dpp_shr1(ug) * w1g[i] + ug * w2g[i];
                            const float yu = bu[i] + dpp_shr2(uu) * w0u[i] + dpp_shr1(uu) * w1u[i] + uu * w2u[i];
                            og[i] = gelu_t(yg) * yu; }
                        if (fr >= 2) { unsigned w0 = cvt_pk_bf16(og[0], og[1]), w1 = cvt_pk_bf16(og[2], og[3]);
                            unsigned* dst = (unsigned*)((bf16_t*)O + (size_t)row * 2816 + fn); dst[0] = w0; dst[1] = w1; } }
            }
            if (fr < 2 || fr >= 14) {
#pragma unroll
                for (int ai = 0; ai < 2; ++ai)
#pragma unroll
                    for (int m = 0; m < 4; ++m) { const int row = row0 + ai * HALF + m * 16;
                        bf16_t* q = (bf16_t*)O2 + (size_t)((row >> 4) * 4 + (fr < 2 ? fr : fr - 12)) * 5632 + f0;
                        u32x4 wg, wu; const f32x4 g0 = acc[ai][0][m][0], g1 = acc[ai][0][m][1], u0 = acc[ai][1][m][0], u1 = acc[ai][1][m][1];
                        wg.x = cvt_pk_bf16(g0[0], g0[1]); wg.y = cvt_pk_bf16(g0[2], g0[3]); wg.z = cvt_pk_bf16(g1[0], g1[1]); wg.w = cvt_pk_bf16(g1[2], g1[3]);
                        wu.x = cvt_pk_bf16(u0[0], u0[1]); wu.y = cvt_pk_bf16(u0[2], u0[3]); wu.z = cvt_pk_bf16(u1[0], u1[1]); wu.w = cvt_pk_bf16(u1[2], u1[3]);
                        *(u32x4*)q = wg; *(u32x4*)(q + 2816) = wu; }
            }
        } else if (mode == 2) {
#pragma unroll
            for (int ai = 0; ai < 2; ++ai)
#pragma unroll
                for (int m = 0; m < 4; ++m) { float* rowp = (float*)O + (size_t)(row0 + ai * HALF + m * 16) * ldc + col0;
#pragma unroll
                    for (int bj = 0; bj < 2; ++bj) { *(f32x4*)(rowp + bj * HALF) = acc[ai][bj][m][0]; *(f32x4*)(rowp + bj * HALF + 4) = acc[ai][bj][m][1]; } }
        } else if (mode == 1 && u.pn == 14) {
            if (wc == 0 && fq == 0) {
                const f32x4 bi4 = *(const f32x4*)bi, bf4 = *(const f32x4*)bfg;
#pragma unroll
                for (int ai = 0; ai < 2; ++ai)
#pragma unroll
                    for (int m = 0; m < 4; ++m) { const int row = row0 + ai * HALF + m * 16;
                        *(f32x4*)(IGo + (size_t)row * 4) = acc[ai][0][m][0] + bi4;
                        f32x4 x = acc[ai][0][m][1] + bf4, o;
#pragma unroll
                        for (int i = 0; i < 4; ++i) o[i] = fminf(x[i], 0.f) - log1pf(expf(-fabsf(x[i])));
                        *(f32x4*)(LFo + (size_t)row * 4) = o; }
            }
        } else {
            const int ldz = (mode == 1) ? 3584 : ldc;
            float sc = 1.f; if (mode == 1) { sc = (u.pn < 2) ? 0.18033688011112042f   : ((u.pn == 8 || u.pn == 9) ? 0.08838834764831845f : 1.f); }
#pragma unroll
            for (int ai = 0; ai < 2; ++ai)
#pragma unroll
                for (int m = 0; m < 4; ++m) { bf16_t* rowp = (bf16_t*)O + (size_t)(row0 + ai * HALF + m * 16) * ldz + col0;
#pragma unroll
                    for (int bj = 0; bj < 2; ++bj) { f32x4 v0 = acc[ai][bj][m][0] * sc, v1 = acc[ai][bj][m][1] * sc;
                        u32x4 w; w.x = cvt_pk_bf16(v0[0], v0[1]); w.y = cvt_pk_bf16(v0[2], v0[3]); w.z = cvt_pk_bf16(v1[0], v1[1]); w.w = cvt_pk_bf16(v1[2], v1[3]);
                        *(u32x4*)(rowp + bj * HALF) = w; } }
        }
    }
    __device__ __forceinline__ void fused(f32x4 (&acc)[2][2][4][2], const Unit& u, int wr, int wc, int fr, int fq, PG8_LAS unsigned char* lds, int wid, int lane) const {}
};
template <class Epi, class Sched, bool ALIGN_EPI = false, bool SP2 = false>
__device__ __forceinline__ void gemm_phase(PG8_LAS unsigned char* lds, const Gemm g, const Sched& S, const Epi& E) {
    int tid_ = threadIdx.x; asm volatile("" : "+v"(tid_)); const int tid = tid_, wid = __builtin_amdgcn_readfirstlane(tid >> 6), lane = tid & 63, wr = wid >> 2, wc = wid & 3, fr = lane & 15, fq = lane >> 4;
    const int K = g.K, nt = K / BK;
    unsigned voffA[2], voffB[2];
#pragma unroll
    for (int i = 0; i < 2; ++i) { int R, C; stage_rc(tid * 16 + i * 8192, R, C); const int Rb = Epi::PERM ? ((R & ~31) + perm32(R & 31)) : R;
        voffA[i] = (unsigned)(R * K + C) * 2u; voffB[i] = (unsigned)(Rb * K + C) * 2u; }
    const size_t kstep = (size_t)(BK * 2);
    const size_t hstep = (size_t)HALF * K * 2;
    const size_t tstep = 2 * hstep;
    const unsigned ldsw = (unsigned)wid * 1024u;
    const int aoff = lds_byte(wr * 64 + fr, fq * 8), boff = lds_byte(wc * 32 + fr, fq * 8);
#define PG8_SA(b, h) (((b) * 2 + (h)) * HTB)
#define PG8_SB(b, h) ((4 + (b) * 2 + (h)) * HTB)
#define PG8_STAGE(bufoff, gbase, voff) do { _Pragma("unroll") for (int _i = 0; _i < 2; ++_i) \
        __builtin_amdgcn_global_load_lds((const unsigned*)((const char*)(gbase) + (voff)[_i]), (PG8_LAS unsigned*)(lds + (bufoff) + ldsw + _i * 8192), 16, 0, 0); } while (0)
#define PG8_LDA(dst, b, h) do { _Pragma("unroll") for (int m = 0; m < 4; ++m) _Pragma("unroll") for (int k = 0; k < 2; ++k) dst[m][k] = *(const PG8_LAS bf16x8*)(lds + PG8_SA(b, h) + aoff + m * 2048 + k * 1024); } while (0)
#define PG8_LDB(dst, b, h) do { _Pragma("unroll") for (int n = 0; n < 2; ++n) _Pragma("unroll") for (int k = 0; k < 2; ++k) dst[n][k] = *(const PG8_LAS bf16x8*)(lds + PG8_SB(b, h) + boff + n * 2048 + k * 1024); } while (0)
#define PG8_MMA(ai, bj, At, Bt) do { __builtin_amdgcn_s_setprio(1); _Pragma("unroll") for (int m = 0; m < 4; ++m) _Pragma("unroll") for (int n = 0; n < 2; ++n) _Pragma("unroll") for (int k = 0; k < 2; ++k) \
        acc[ai][bj][m][n] = __builtin_amdgcn_mfma_f32_16x16x32_bf16(Bt[n][k], At[m][k], acc[ai][bj][m][n], 0, 0, 0); __builtin_amdgcn_s_setprio(0); } while (0)
#define PG8_WAIT_V(n) asm volatile("s_waitcnt vmcnt(" #n ")" ::: "memory")
#define PG8_WAIT_L(n) asm volatile("s_waitcnt lgkmcnt(" #n ")" ::: "memory")
#define PG8_BAR __builtin_amdgcn_s_barrier()
#define PG8_SCHED __builtin_amdgcn_sched_barrier(0)
    Unit cur, nxt; int ui = 0;
    if (!S.next(0, cur)) return;
    f32x4 acc[2][2][4][2];
#pragma unroll
    for (int a = 0; a < 2; ++a)
#pragma unroll
        for (int b = 0; b < 2; ++b)
#pragma unroll
            for (int m = 0; m < 4; ++m)
#pragma unroll
                for (int n = 0; n < 2; ++n) acc[a][b][m][n] = (f32x4){0.f, 0.f, 0.f, 0.f};
    bf16x8 At[4][2], B0[2][2], B1[2][2];
    const char* cA = (const char*)g.A + (size_t)cur.pm * tstep; const char* cB = (const char*)g.Bt + (size_t)cur.pn * tstep;
    S.a_ready(cur);
    if constexpr (SP2) {
        PG8_STAGE(PG8_SB(0, 0), cB, voffB); PG8_STAGE(PG8_SB(0, 1), cB + hstep, voffB); PG8_STAGE(PG8_SA(0, 0), cA, voffA); PG8_STAGE(PG8_SA(0, 1), cA + hstep, voffA);
        if (wr == 1) PG8_BAR;
        PG8_WAIT_V(2); PG8_BAR;
        PG8_STAGE(PG8_SB(1, 0), cB + kstep, voffB); PG8_STAGE(PG8_SA(1, 0), cA + kstep, voffA); PG8_STAGE(PG8_SB(1, 1), cB + hstep + kstep, voffB);
        PG8_WAIT_V(6); PG8_BAR;
    } else {
        PG8_STAGE(PG8_SB(0, 0), cB, voffB); PG8_STAGE(PG8_SA(0, 0), cA, voffA); PG8_STAGE(PG8_SB(0, 1), cB + hstep, voffB); PG8_STAGE(PG8_SA(0, 1), cA + hstep, voffA);
        if (wr == 1) PG8_BAR;
        PG8_WAIT_V(4); PG8_BAR;
        PG8_STAGE(PG8_SB(1, 0), cB + kstep, voffB); PG8_STAGE(PG8_SA(1, 0), cA + kstep, voffA); PG8_STAGE(PG8_SB(1, 1), cB + hstep + kstep, voffB);
        PG8_WAIT_V(6); PG8_BAR;
    }
    for (;;) {
        const bool has_next = S.next(ui + 1, nxt);
        const char* nA = has_next ? (const char*)g.A + (size_t)nxt.pm * tstep : cA; const char* nB = has_next ? (const char*)g.Bt + (size_t)nxt.pn * tstep : cB;
        for (int t = 0; t < nt; t += 2) {
            const bool last = (t == nt - 2);
            const char* a1 = cA + (size_t)(t + 1) * kstep;
            const char* a2 = last ? nA : cA + (size_t)(t + 2) * kstep; const char* b2 = last ? nB : cB + (size_t)(t + 2) * kstep;
            const char* a3 = a2 + kstep; const char* b3 = b2 + kstep;
            if (last && has_next) S.a_ready(nxt);
            if constexpr (SP2) {
            PG8_LDB(B0, 0, 0); PG8_LDB(B1, 0, 1); PG8_SCHED; PG8_LDA(At, 0, 0); PG8_STAGE(PG8_SA(1, 1), a1 + hstep, voffA);
            PG8_WAIT_V(8); PG8_WAIT_L(0); PG8_BAR; PG8_MMA(0, 0, At, B0); PG8_MMA(0, 1, At, B1); PG8_BAR; PG8_SCHED;
            PG8_LDA(At, 0, 1); PG8_STAGE(PG8_SB(0, 0), b2, voffB); PG8_STAGE(PG8_SB(0, 1), b2 + hstep, voffB); PG8_STAGE(PG8_SA(0, 0), a2, voffA);
            PG8_WAIT_V(8); PG8_WAIT_L(0); PG8_BAR; PG8_MMA(1, 0, At, B0); PG8_MMA(1, 1, At, B1); PG8_BAR; PG8_SCHED;
            PG8_LDB(B0, 1, 0); PG8_LDB(B1, 1, 1); PG8_SCHED; PG8_LDA(At, 1, 0); PG8_STAGE(PG8_SA(0, 1), a2 + hstep, voffA);
            PG8_WAIT_V(8); PG8_WAIT_L(0); PG8_BAR; PG8_MMA(0, 0, At, B0); PG8_MMA(0, 1, At, B1); PG8_BAR; PG8_SCHED;
            PG8_LDA(At, 1, 1); PG8_STAGE(PG8_SB(1, 0), b3, voffB); PG8_STAGE(PG8_SB(1, 1), b3 + hstep, voffB); PG8_STAGE(PG8_SA(1, 0), a3, voffA);
            PG8_WAIT_V(8); PG8_WAIT_L(0); PG8_BAR; PG8_MMA(1, 0, At, B0); PG8_MMA(1, 1, At, B1); PG8_BAR; PG8_SCHED;
            } else {
            PG8_LDB(B0, 0, 0); PG8_SCHED; PG8_LDA(At, 0, 0); PG8_STAGE(PG8_SA(1, 1), a1 + hstep, voffA);
            PG8_WAIT_L(8); PG8_BAR; PG8_WAIT_L(0); PG8_MMA(0, 0, At, B0); PG8_BAR; PG8_SCHED;
            PG8_LDB(B1, 0, 1); PG8_STAGE(PG8_SB(0, 0), b2, voffB);
            PG8_BAR; PG8_WAIT_L(0); PG8_MMA(0, 1, At, B1); PG8_BAR;
            PG8_LDA(At, 0, 1); PG8_STAGE(PG8_SA(0, 0), a2, voffA);
            PG8_BAR; PG8_WAIT_L(0); PG8_MMA(1, 0, At, B0); PG8_BAR; PG8_SCHED;
            PG8_STAGE(PG8_SB(0, 1), b2 + hstep, voffB);
            PG8_WAIT_V(6); PG8_BAR; PG8_MMA(1, 1, At, B1); PG8_BAR;
            PG8_LDB(B0, 1, 0); PG8_SCHED; PG8_LDA(At, 1, 0); PG8_STAGE(PG8_SA(0, 1), a2 + hstep, voffA);
            PG8_WAIT_L(8); PG8_BAR; PG8_WAIT_L(0); PG8_MMA(0, 0, At, B0); PG8_BAR; PG8_SCHED;
            PG8_LDB(B1, 1, 1); PG8_STAGE(PG8_SB(1, 0), b3, voffB);
            PG8_BAR; PG8_WAIT_L(0); PG8_MMA(0, 1, At, B1); PG8_BAR;
            PG8_LDA(At, 1, 1); PG8_STAGE(PG8_SA(1, 0), a3, voffA);
            PG8_BAR; PG8_WAIT_L(0); PG8_MMA(1, 0, At, B0); PG8_BAR; PG8_SCHED;
            PG8_STAGE(PG8_SB(1, 1), b3 + hstep, voffB);
            PG8_WAIT_V(6); PG8_BAR; PG8_MMA(1, 1, At, B1); PG8_BAR;
            }
        }
        if constexpr (ALIGN_EPI) { if (wr == 0) PG8_BAR; }
        if constexpr (!Epi::AFTER_DRAIN) { E(acc, cur, wr, wc, fr, fq); S.done(cur); }
        if (!has_next) break;
#pragma unroll
        for (int a = 0; a < 2; ++a)
#pragma unroll
            for (int b = 0; b < 2; ++b)
#pragma unroll
                for (int m = 0; m < 4; ++m)
#pragma unroll
                    for (int n = 0; n < 2; ++n) acc[a][b][m][n] = (f32x4){0.f, 0.f, 0.f, 0.f};
        cur = nxt; cA = nA; cB = nB; ++ui;
        if constexpr (ALIGN_EPI) { if (wr == 1) PG8_BAR; }
    }
    PG8_WAIT_V(0);
    if constexpr (!ALIGN_EPI) { if (wr == 0) PG8_BAR; }
    PG8_BAR;
    if constexpr (Epi::AFTER_DRAIN) { E.fused(acc, cur, wr, wc, fr, fq, lds, wid, lane); S.done(cur); }
#undef PG8_SA
#undef PG8_SB
#undef PG8_STAGE
#undef PG8_LDA
#undef PG8_LDB
#undef PG8_MMA
#undef PG8_WAIT_V
#undef PG8_WAIT_L
#undef PG8_BAR
#undef PG8_SCHED
}
}
#define LAS __attribute__((address_space(3)))
#define DI __device__ __forceinline__
typedef unsigned short bf16;
typedef float f32x4 __attribute__((ext_vector_type(4)));
typedef float f32x16 __attribute__((ext_vector_type(16)));
typedef float f32x2 __attribute__((ext_vector_type(2)));
typedef unsigned u32x4 __attribute__((ext_vector_type(4)));
typedef unsigned u32x2 __attribute__((ext_vector_type(2)));
typedef short bf16x8 __attribute__((ext_vector_type(8)));
typedef short s16x4 __attribute__((ext_vector_type(4)));
typedef __bf16 bf16x2_t __attribute__((ext_vector_type(2)));

constexpr int NTHR = 512;
constexpr int DM = 1024, MPR = 16384, MVALID = 16512, MPAD = 16640, NZ = 3584, DIN = 3592, DFF = 2816, NU = 5632;
constexpr int SEQ = 8192;
constexpr float EPS = 1e-6f;
constexpr int LDS_BYTES = 147456 + 64;
constexpr size_t MiB = 1u << 20;
constexpr size_t WS_IG = 0, WS_LF = 512 * 1024, WS_BL = 1 * MiB, WS_AC = 1 * MiB + 8192, WS_MPREV = 1 * MiB + 16384, WS_NC = 2 * MiB, WS_NPREV = 3 * MiB;
constexpr size_t WS_BAR = 3 * MiB + 768 * 1024;
constexpr size_t WS_WIN = 4 * MiB, WS_WOUT = 11 * MiB + 512 * 1024, WS_WUP = 13 * MiB + 512 * 1024, WS_WDN = 24 * MiB + 512 * 1024;
constexpr size_t WS_ACT = 30 * MiB;
constexpr size_t WS_KC = 244 * MiB, WS_VC = 248 * MiB;
constexpr size_t WS_X16 = 63 * MiB;
constexpr size_t WS_R = 96 * MiB;
constexpr size_t WS_Z = WS_R, WS_SC = 210 * MiB;
constexpr size_t WS_MIX = WS_R;
constexpr size_t WS_UQ = WS_R, WS_G = 141 * MiB;
constexpr size_t WS_FFN = WS_R;
constexpr size_t WS_END = 256 * MiB;
static_assert(WS_Z + (size_t)MPAD * NZ * 2 <= WS_SC && WS_SC + (size_t)1056 * 32768 <= WS_KC && WS_X16 + (size_t)MVALID * DM * 2 <= WS_R, "ws stage 1");
static_assert(WS_UQ + (size_t)(MPAD / 4) * NU * 2 <= WS_G && WS_G + (size_t)MPAD * DFF * 2 <= WS_KC, "ws stage 3");
static_assert(WS_ACT + (size_t)MPAD * DM * 2 <= WS_X16 && WS_WDN + (size_t)DM * DFF * 2 <= WS_ACT, "ws fixed");
constexpr size_t O_X = 0, O_KP = 16908288, O_VP = O_KP + 1048576, O_CP = O_VP + 1048576, O_NP = O_CP + 262144, O_MP = O_NP + 2048, O_FP = O_MP + 16,
                 O_KS = O_FP + 45056, O_VS = O_KS + 131072, O_CS = O_VS + 131072, O_NS = O_CS + 1048576, O_MS = O_NS + 8192, O_FS = O_MS + 64, O_END = O_FS + 180224;

DI unsigned pk2(float lo, float hi) { f32x2 v = {lo, hi}; bf16x2_t b = __builtin_convertvector(v, bf16x2_t); return __builtin_bit_cast(unsigned, b); }
DI float bf2f(unsigned short b) { return __uint_as_float((unsigned)b << 16); }
DI float bflo(unsigned w) { return __uint_as_float(w << 16); }
DI float bfhi(unsigned w) { return __uint_as_float(w & 0xffff0000u); }
DI float wave_sum(float v) {
#pragma unroll
    for (int o = 1; o < 64; o <<= 1) v += __shfl_xor(v, o);
    return v;
}
DI float wave_max(float v) {
#pragma unroll
    for (int o = 1; o < 64; o <<= 1) v = fmaxf(v, __shfl_xor(v, o));
    return v;
}
#define MFMA32(a, b, c) __builtin_amdgcn_mfma_f32_32x32x16_bf16((a), (b), (c), 0, 0, 0)
DI s16x4 vtr(const LAS char* p) { return __builtin_bit_cast(s16x4, __builtin_amdgcn_ds_read_tr16_b64_v4i16((LAS s16x4*)p)); }
DI bf16x8 vtr2(const LAS char* p, int rows4_bytes) { s16x4 lo = vtr(p), hi = vtr(p + rows4_bytes); return __builtin_shufflevector(lo, hi, 0, 1, 2, 3, 4, 5, 6, 7); }
DI int crow(int i, int h) { return (i & 3) + 8 * (i >> 2) + 4 * h; }
DI bf16x8 pack8(const f32x16& x, int s) {
    u32x4 p; p.x = pk2(x[8 * s], x[8 * s + 1]); p.y = pk2(x[8 * s + 2], x[8 * s + 3]); p.z = pk2(x[8 * s + 4], x[8 * s + 5]); p.w = pk2(x[8 * s + 6], x[8 * s + 7]);
    return __builtin_bit_cast(bf16x8, p);
}
DI f32x16 zero16() { f32x16 z;
#pragma unroll
    for (int i = 0; i < 16; ++i) z[i] = 0.f; return z; }
#define LDS_FENCE() asm volatile("s_waitcnt lgkmcnt(0)" ::: "memory")

struct Args { const float* in[20]; float* out; unsigned char* ws; };
typedef const __attribute__((address_space(4))) Args* ArgsP;
DI ArgsP get_args() { ArgsP p = (ArgsP)__builtin_amdgcn_kernarg_segment_ptr(); asm volatile("" : "+s"(p)); return p; }
DI int get_bid() { int b = blockIdx.x; asm volatile("" : "+s"(b)); return b; }
DI int get_nb() { int b = gridDim.x; asm volatile("" : "+s"(b)); return b; }
DI int get_tid() { int t = threadIdx.x; asm volatile("" : "+v"(t)); return t; }

DI void transpose_item(const float* W, int ldw, int K, int nblk, bf16* WT, LAS float* scr, int item, int lane, bool perm_up = false, int cmax = (1 << 30)) {
    const int kb = item / nblk, nb = item % nblk, k0 = 64 * kb, n0 = 32 * nb;
    const int r0 = !perm_up ? n0 : (n0 < DFF ? 256 * (n0 >> 7) + (n0 & 127) : 256 * ((n0 - DFF) >> 7) + 128 + ((n0 - DFF) & 127));
    { int col0 = n0 + (lane & 7) * 4; col0 = col0 + 3 <= cmax ? col0 : cmax - 3;
      f32x4 v[8];
#pragma unroll
      for (int i = 0; i < 8; ++i) v[i] = *(const f32x4*)(W + (size_t)(k0 + 8 * i + (lane >> 3)) * ldw + col0);
#pragma unroll
      for (int i = 0; i < 8; ++i) { const int kk = 8 * i + (lane >> 3); LAS float* d = scr + kk * 33 + (lane & 7) * 4; d[0] = v[i].x; d[1] = v[i].y; d[2] = v[i].z; d[3] = v[i].w; } }
    LDS_FENCE();
    const int c = lane & 7;
#pragma unroll
    for (int j = 0; j < 4; ++j) { const int n = (lane >> 3) + 8 * j; const LAS float* s = scr + (8 * c) * 33 + n;
        u32x4 o; o.x = pk2(s[0 * 33], s[1 * 33]); o.y = pk2(s[2 * 33], s[3 * 33]); o.z = pk2(s[4 * 33], s[5 * 33]); o.w = pk2(s[6 * 33], s[7 * 33]);
        *(u32x4*)(WT + (size_t)(r0 + n) * K + k0 + 8 * c) = o; }
    LDS_FENCE();
}
DI void phase_convert(int l, LAS unsigned char* lds) {
    const ArgsP a = get_args(); const int tid = get_tid(), lane = tid & 63, wave = tid >> 6;
    LAS float* scr = (LAS float*)(lds + wave * 8448);
    const int gw = get_bid() * 8 + wave, NGW = get_nb() * 8;
    constexpr int I_IN = 16 * 113, I_OUT = 16 * 32, I_UP = 16 * 176, I_DN = 44 * 32;
    const float* win = a->in[9] + (size_t)l * DM * DIN; const float* wout = a->in[15] + (size_t)l * DM * DM;
    const float* wup = a->in[16] + (size_t)l * DM * NU; const float* wdn = a->in[19] + (size_t)l * DFF * DM;
    for (int it = gw; it < I_IN + I_OUT + I_UP + I_DN; it += NGW) {
        int r = it;
        if (r < I_IN) { transpose_item(win, DIN, DM, 113, (bf16*)(a->ws + WS_WIN), scr, r, lane, false, DIN - 1); continue; } r -= I_IN;
        if (r < I_OUT) { transpose_item(wout, DM, DM, 32, (bf16*)(a->ws + WS_WOUT), scr, r, lane); continue; } r -= I_OUT;
        if (r < I_UP) { transpose_item(wup, NU, DM, 176, (bf16*)(a->ws + WS_WUP), scr, r, lane, true); continue; } r -= I_UP;
        transpose_item(wdn, DM, DFF, 32, (bf16*)(a->ws + WS_WDN), scr, r, lane);
    }
    {   const int gt0 = get_bid() * NTHR + tid, gstep = get_nb() * NTHR;
        for (int it0 = gt0; it0 < 2 * 262144; it0 += 4 * gstep) {
            f32x4 x0[4], x1[4];
#pragma unroll
            for (int k = 0; k < 4; ++k) { const int it = it0 + k * gstep; if (it < 2 * 262144) { const int kv = it >> 18, e = (it & 262143) * 8; const float* src = a->in[2 + kv] + (size_t)l * 2097152 + e; x0[k] = *(const f32x4*)src; x1[k] = *(const f32x4*)(src + 4); } }
#pragma unroll
            for (int k = 0; k < 4; ++k) { const int it = it0 + k * gstep; if (it < 2 * 262144) { const int kv = it >> 18, e = (it & 262143) * 8;
                u32x4 w; w.x = pk2(x0[k].x, x0[k].y); w.y = pk2(x0[k].z, x0[k].w); w.z = pk2(x1[k].x, x1[k].y); w.w = pk2(x1[k].z, x1[k].w);
                *(u32x4*)((bf16*)(a->ws + (kv ? WS_VC : WS_KC)) + e) = w; } }
        } }
}

DI void phase_rows(LAS unsigned char* lds, bool first, const bf16* addsrc, const float* gadd, const float* gn, int gate_layer  , bool final) {
    const ArgsP a = get_args(); const int tid = get_tid(), lane = tid & 63, wave = tid >> 6;
    float* Y = a->out; bf16* X16 = (bf16*)(a->ws + WS_X16); bf16* ACT = (bf16*)(a->ws + WS_ACT);
    const int gw = get_bid() * 8 + wave, NGW = get_nb() * 8;
    float ga[16], gb[16];
#pragma unroll
    for (int j = 0; j < 2; ++j)
#pragma unroll
        for (int k = 0; k < 8; ++k) { ga[8 * j + k] = addsrc ? gadd[8 * lane + 512 * j + k] : 0.f; gb[8 * j + k] = gn ? gn[8 * lane + 512 * j + k] : 0.f; }
#define ROWS_LOAD(MM, VV, XX, FF) do { const int mm_ = (MM); \
        if (first) { const float* xr_ = mm_ < MPR ? a->in[0] + (size_t)mm_ * DM : a->in[1] + (size_t)(mm_ - MPR) * DM; \
            _Pragma("unroll") for (int j = 0; j < 2; ++j) { VV[2 * j] = *(const f32x4*)(xr_ + 8 * lane + 512 * j); VV[2 * j + 1] = *(const f32x4*)(xr_ + 8 * lane + 512 * j + 4); } } \
        else { _Pragma("unroll") for (int j = 0; j < 2; ++j) XX[j] = *(const u32x4*)(X16 + (size_t)mm_ * DM + 8 * lane + 512 * j); } \
        if (addsrc) { _Pragma("unroll") for (int j = 0; j < 2; ++j) FF[j] = *(const u32x4*)(addsrc + (size_t)mm_ * DM + 8 * lane + 512 * j); } } while (0)
    f32x4 vn[4], vn2[4]; u32x4 xn[2], fn[2], xn2[2], fn2[2];
#pragma unroll
    for (int j = 0; j < 4; ++j) { vn[j] = (f32x4){0.f, 0.f, 0.f, 0.f}; vn2[j] = vn[j]; }
#pragma unroll
    for (int j = 0; j < 2; ++j) { xn[j] = (u32x4){0u, 0u, 0u, 0u}; fn[j] = xn[j]; xn2[j] = xn[j]; fn2[j] = xn[j]; }
    if (gw < MVALID) ROWS_LOAD(gw, vn, xn, fn);
    if (gw + NGW < MVALID) ROWS_LOAD(gw + NGW, vn2, xn2, fn2);
    for (int m = gw; m < MVALID; m += NGW) {
        float v[16], f[16];
#pragma unroll
        for (int j = 0; j < 2; ++j) {
            if (first) {
#pragma unroll
                for (int k = 0; k < 4; ++k) { v[8 * j + k] = vn[2 * j][k]; v[8 * j + 4 + k] = vn[2 * j + 1][k]; }
            } else { v[8 * j] = bflo(xn[j].x); v[8 * j + 1] = bfhi(xn[j].x); v[8 * j + 2] = bflo(xn[j].y); v[8 * j + 3] = bfhi(xn[j].y); v[8 * j + 4] = bflo(xn[j].z); v[8 * j + 5] = bfhi(xn[j].z); v[8 * j + 6] = bflo(xn[j].w); v[8 * j + 7] = bfhi(xn[j].w); }
            f[8 * j] = bflo(fn[j].x); f[8 * j + 1] = bfhi(fn[j].x); f[8 * j + 2] = bflo(fn[j].y); f[8 * j + 3] = bfhi(fn[j].y); f[8 * j + 4] = bflo(fn[j].z); f[8 * j + 5] = bfhi(fn[j].z); f[8 * j + 6] = bflo(fn[j].w); f[8 * j + 7] = bfhi(fn[j].w);
        }
#pragma unroll
        for (int j = 0; j < 4; ++j) vn[j] = vn2[j];
#pragma unroll
        for (int j = 0; j < 2; ++j) { xn[j] = xn2[j]; fn[j] = fn2[j]; }
        if (m + 2 * NGW < MVALID) ROWS_LOAD(m + 2 * NGW, vn2, xn2, fn2);
        if (addsrc) {
            float s = 0.f;
#pragma unroll
            for (int k = 0; k < 16; ++k) s += f[k] * f[k];
            const float r = 1.0f / sqrtf(wave_sum(s) * (1.f / DM) + EPS);
#pragma unroll
            for (int k = 0; k < 16; ++k) v[k] = v[k] + f[k] * r * ga[k];
#pragma unroll
            for (int j = 0; j < 2; ++j) {
                if (final) { float* yp = Y + (size_t)m * DM + 8 * lane + 512 * j; *(f32x4*)yp = (f32x4){v[8 * j], v[8 * j + 1], v[8 * j + 2], v[8 * j + 3]}; *(f32x4*)(yp + 4) = (f32x4){v[8 * j + 4], v[8 * j + 5], v[8 * j + 6], v[8 * j + 7]}; }
                else { u32x4 o; o.x = pk2(v[8 * j], v[8 * j + 1]); o.y = pk2(v[8 * j + 2], v[8 * j + 3]); o.z = pk2(v[8 * j + 4], v[8 * j + 5]); o.w = pk2(v[8 * j + 6], v[8 * j + 7]); *(u32x4*)(X16 + (size_t)m * DM + 8 * lane + 512 * j) = o; } }
        }
        if (gn) {
            float s = 0.f;
#pragma unroll
            for (int k = 0; k < 16; ++k) s += v[k] * v[k];
            const float r = 1.0f / sqrtf(wave_sum(s) * (1.f / DM) + EPS);
#pragma unroll
            for (int j = 0; j < 2; ++j) { u32x4 o;
                o.x = pk2(v[8 * j] * r * gb[8 * j], v[8 * j + 1] * r * gb[8 * j + 1]); o.y = pk2(v[8 * j + 2] * r * gb[8 * j + 2], v[8 * j + 3] * r * gb[8 * j + 3]);
                o.z = pk2(v[8 * j + 4] * r * gb[8 * j + 4], v[8 * j + 5] * r * gb[8 * j + 5]); o.w = pk2(v[8 * j + 6] * r * gb[8 * j + 6], v[8 * j + 7] * r * gb[8 * j + 7]);
                *(u32x4*)(ACT + (size_t)m * DM + 8 * lane + 512 * j) = o; }
        }
    }
#undef ROWS_LOAD
}

DI void mini_gemm(LAS unsigned char* lds, const bf16* A, const bf16* Bt, int K, bf16* O) {
    const int tid = get_tid(), lane = tid & 63, wave = tid >> 6, fr = lane & 15, fq = lane >> 4;
    LAS float* red = (LAS float*)lds;
    const int ksl = K >> 3, k0 = wave * ksl, nks = ksl >> 5;
    for (int unit = get_bid(); unit < 256; unit += get_nb()) {
        const int rt = unit >> 5, ct = unit & 31;
        const bf16* ap = A + (size_t)(rt * 16 + fr) * K + k0 + 8 * fq;
        const bf16* bp0 = Bt + (size_t)(ct * 32 + fr) * K + k0 + 8 * fq; const bf16* bp1 = bp0 + (size_t)16 * K;
        f32x4 acc0 = {0.f, 0.f, 0.f, 0.f}, acc1 = {0.f, 0.f, 0.f, 0.f};
#pragma unroll 4
        for (int ks = 0; ks < nks; ++ks) { const bf16x8 av = *(const bf16x8*)(ap + 32 * ks), b0 = *(const bf16x8*)(bp0 + 32 * ks), b1 = *(const bf16x8*)(bp1 + 32 * ks);
            acc0 = __builtin_amdgcn_mfma_f32_16x16x32_bf16(av, b0, acc0, 0, 0, 0); acc1 = __builtin_amdgcn_mfma_f32_16x16x32_bf16(av, b1, acc1, 0, 0, 0); }
#pragma unroll
        for (int j = 0; j < 4; ++j) { red[(wave * 2 + 0) * 256 + j * 64 + lane] = acc0[j]; red[(wave * 2 + 1) * 256 + j * 64 + lane] = acc1[j]; }
        __syncthreads();
        { const int n = tid >> 8, idx = tid & 255, j = idx >> 6, ln = idx & 63; float s = 0.f;
#pragma unroll
          for (int w = 0; w < 8; ++w) s += red[(w * 2 + n) * 256 + idx];
          O[(size_t)(rt * 16 + 4 * (ln >> 4) + j) * DM + ct * 32 + 16 * n + (ln & 15)] = (bf16)(pk2(s, 0.f) & 0xffffu); }
        __syncthreads();
    }
}

constexpr int VP = 144;
DI void attn_step(const bf16x8 (&kf)[4], const bf16x8 (&qf)[4], f32x16 (&O)[2], float& mrun, float& lrun, const LAS float* tab, float bias_far, bool nearb, int dq  , int maskfrom  ,
                  const LAS char* vs, int kb, int h, int q4, int p4, int blk) {
    bf16x8 vf0[2], vf1[2];
#pragma unroll
    for (int dt = 0; dt < 2; ++dt) {
        vf0[dt] = vtr2(vs + (kb + 4 * h + q4) * VP + 2 * (32 * dt + 16 * blk) + 8 * p4, 8 * VP);
        vf1[dt] = vtr2(vs + (kb + 16 + 4 * h + q4) * VP + 2 * (32 * dt + 16 * blk) + 8 * p4, 8 * VP); }
    f32x16 S = zero16();
#pragma unroll
    for (int s = 0; s < 4; ++s) S = MFMA32(kf[s], qf[s], S);
    if (nearb) {
#pragma unroll
        for (int i = 0; i < 16; ++i) { int d = dq - ((i & 3) + 8 * (i >> 2)); d = d > 256 ? 256 : d; S[i] += tab[d + 63]; }
    } else {
        const float bfar = tab[319];
#pragma unroll
        for (int i = 0; i < 16; ++i) S[i] += bfar;
    }
    if (maskfrom < 64) {
#pragma unroll
        for (int i = 0; i < 16; ++i) if ((i & 3) + 8 * (i >> 2) + 4 * h >= maskfrom) S[i] = -1e30f;
    }
    float mx = S[0];
#pragma unroll
    for (int i = 1; i < 16; ++i) mx = fmaxf(mx, S[i]);
    mx = fmaxf(mx, __shfl_xor(mx, 32));
    const float mnew = fmaxf(mrun, mx), alpha = __builtin_amdgcn_exp2f(mrun - mnew);
    float rs = 0.f;
#pragma unroll
    for (int i = 0; i < 16; ++i) { S[i] = __builtin_amdgcn_exp2f(S[i] - mnew); rs += S[i]; }
    lrun = lrun * alpha + rs;
    if (__builtin_amdgcn_ballot_w64(mnew > mrun)) { O[0] *= alpha; O[1] *= alpha; }
    mrun = mnew;
    const bf16x8 pf0 = pack8(S, 0), pf1 = pack8(S, 1);
#pragma unroll
    for (int dt = 0; dt < 2; ++dt) { O[dt] = MFMA32(vf0[dt], pf0, O[dt]); O[dt] = MFMA32(vf1[dt], pf1, O[dt]); }
}
template <bool SAMPLE>
DI void attn_unit(int l, int bb, int c, int qhalf, LAS unsigned char* lds) {
    const ArgsP a = get_args(); const int tid = get_tid(), lane = tid & 63, hd = tid >> 6, r = lane & 31, h = lane >> 5;
    const int i16 = lane & 15, q4 = i16 >> 2, p4 = i16 & 3, blk = (lane >> 4) & 1;
    const bf16* Z = (const bf16*)(a->ws + WS_Z); bf16* ACT = (bf16*)(a->ws + WS_ACT);
    LAS char* vs = (LAS char*)(lds + hd * 9216);
    const LAS float* tab = (const LAS float*)(lds + 73728 + hd * 1280);
    LAS float* xs = (LAS float*)(lds + 73728 + 10240);
    const int qrow0 = SAMPLE ? MPR + bb * 16 : bb * SEQ + c * 64;
    const bf16* kc16 = (const bf16*)(a->ws + WS_KC) + (size_t)(bb * 8 + hd) * 512 * 64;
    const bf16* vc16 = (const bf16*)(a->ws + WS_VC) + (size_t)(bb * 8 + hd) * 512 * 64;
    bf16x8 qf[4];
    { const int qr = SAMPLE ? (r < 16 ? r : 15) : 32 * qhalf + r;
#pragma unroll
      for (int s = 0; s < 4; ++s) qf[s] = *(const bf16x8*)(Z + (size_t)(qrow0 + qr) * NZ + hd * 64 + 16 * s + 8 * h); }
    f32x16 O[2]; O[0] = zero16(); O[1] = zero16(); float mrun = -1e30f, lrun = 0.f;
    const float bias_far = tab[319];
    const int q = 32 * qhalf + r;
    const int jstart = SAMPLE ? 0 : (c >= 8 ? 0 : 8 - c);
#define ATT_SRC(J) const bf16* kb_; const bf16* vb_; int pitch_, rmax_; \
    if (SAMPLE && (J) < 8) { kb_ = kc16 + (size_t)(64 * (J)) * 64; vb_ = vc16 + (size_t)(64 * (J)) * 64; pitch_ = 64; rmax_ = 63; } \
    else if (SAMPLE) { kb_ = Z + (size_t)qrow0 * NZ + 512 + hd * 64; vb_ = kb_ + 512; pitch_ = NZ; rmax_ = 15; } \
    else { kb_ = Z + (size_t)(bb * SEQ + (c + (J) - 8) * 64) * NZ + 512 + hd * 64; vb_ = kb_ + 512; pitch_ = NZ; rmax_ = 63; }
#define ATT_LOADK(J, KS, KF) do { ATT_SRC(J) int kr_ = 32 * (KS) + r; kr_ = kr_ > rmax_ ? rmax_ : kr_; (void)vb_; \
    _Pragma("unroll") for (int s = 0; s < 4; ++s) KF[s] = *(const bf16x8*)(kb_ + (size_t)kr_ * pitch_ + 16 * s + 8 * h); } while (0)
#define ATT_LOADV(J, VR) do { ATT_SRC(J) (void)kb_; \
    _Pragma("unroll") for (int it = 0; it < 8; ++it) { int key_ = it * 8 + (lane >> 3); key_ = key_ > rmax_ ? rmax_ : key_; VR[it] = *(const u32x4*)(vb_ + (size_t)key_ * pitch_ + (lane & 7) * 8); } } while (0)
    bf16x8 kA[4], kB[4]; u32x4 vr[8];
    ATT_LOADK(jstart, 0, kA);
    ATT_LOADV(jstart, vr);
#pragma unroll 1
    for (int j = jstart; j < 9; ++j) {
        LDS_FENCE();
#pragma unroll
        for (int it = 0; it < 8; ++it) *(LAS u32x4*)(vs + (it * 8 + (lane >> 3)) * VP + (lane & 7) * 16) = vr[it];
        if (j < 8) ATT_LOADV(j + 1, vr);
        ATT_LOADK(j, 1, kB);
        LDS_FENCE();
        const bool nearb = j >= 4; const int mf = (SAMPLE && j == 8) ? 16 : 64;
        attn_step(kA, qf, O, mrun, lrun, tab, bias_far, nearb, 512 + q - (64 * j + 4 * h), mf, vs, 0, h, q4, p4, blk);
        if (j < 8) ATT_LOADK(j + 1, 0, kA);
        if (!(SAMPLE && j == 8)) attn_step(kB, qf, O, mrun, lrun, tab, bias_far, nearb, 512 + q - (64 * j + 32 + 4 * h), 64, vs, 32, h, q4, p4, blk);
    }
#undef ATT_SRC
#undef ATT_LOADK
#undef ATT_LOADV
    const float lt = lrun + __shfl_xor(lrun, 32); const float inv = 1.0f / lt; float ssq = 0.f;
#pragma unroll
    for (int dt = 0; dt < 2; ++dt) { O[dt] *= inv;
#pragma unroll
        for (int i = 0; i < 16; ++i) ssq += O[dt][i] * O[dt][i]; }
    ssq += __shfl_xor(ssq, 32);
    if (h == 0) xs[hd * 64 + 32 * qhalf + r] = ssq;
    __syncthreads();
    const float* gatt = a->in[13] + l * 512 + hd * 64;
    float tot = 0.f;
#pragma unroll
    for (int w = 0; w < 8; ++w) tot += xs[w * 64 + 32 * qhalf + r];
    const float rr = 1.0f / sqrtf(tot * (1.f / 512.f) + EPS);
    const bool ok = SAMPLE ? (r < 16) : true;
    bf16* orow = ACT + (size_t)(qrow0 + 32 * qhalf + r) * DM + hd * 64;
    if (ok) {
#pragma unroll
        for (int dt = 0; dt < 2; ++dt)
#pragma unroll
            for (int g = 0; g < 4; ++g) { const int e0 = 32 * dt + 8 * g + 4 * h; const f32x4 gv = *(const f32x4*)(gatt + e0);
                u32x2 o; o.x = pk2(O[dt][4 * g] * rr * gv.x, O[dt][4 * g + 1] * rr * gv.y); o.y = pk2(O[dt][4 * g + 2] * rr * gv.z, O[dt][4 * g + 3] * rr * gv.w);
                *(u32x2*)(orow + e0) = o; }
    }
    __syncthreads();
}

constexpr int MPB = 288;
DI void m1_item(bool sample, int bb, int c, LAS unsigned char* lds, int hp = -1  ) {
    const ArgsP a = get_args(); const int tid = get_tid(), lane = tid & 63, wave = tid >> 6, head = wave >> 1, half = wave & 1, r = lane & 31, h = lane >> 5;
    const int i16 = lane & 15, q4 = i16 >> 2, p4 = i16 & 3, blk = (lane >> 4) & 1;
    const bf16* Z = (const bf16*)(a->ws + WS_Z); const float* IG = (const float*)(a->ws + WS_IG); const float* LF = (const float*)(a->ws + WS_LF);
    bf16* SC = (bf16*)(a->ws + WS_SC);
    const int row0 = sample ? MPR + bb * 16 : bb * SEQ + c * 64;
    const int u = sample ? 1024 + bb * 4 + head : (bb * 4 + head) * 128 + c;
    const bool act = (hp < 0) || ((head >> 1) == hp);
    u32x4 st16[16];
#pragma unroll
    for (int it = 0; it < 16; ++it) { const int rr = it * 4 + (lane >> 4), ch = lane & 15; const int srow = row0 + (sample ? (rr < 16 ? rr : 15) : rr);
        st16[it] = *(const u32x4*)(Z + (size_t)srow * NZ + (half == 0 ? 2048 : 2560) + head * 128 + ch * 8); }
    const bool valid = sample ? (lane < 16) : true;
    const int rs = row0 + (sample ? (lane < 16 ? lane : 15) : lane);
    float b = valid ? LF[(size_t)rs * 4 + head] : 0.f; const float ig = valid ? IG[(size_t)rs * 4 + head] : -INFINITY;
#pragma unroll
    for (int o = 1; o < 64; o <<= 1) { const float t = __shfl_up(b, o); if (lane >= o) b += t; }
    const float av = ig - b; const float ac = wave_max(av); const float w = __expf(av - ac); const float bl = __shfl(b, 63);
    if (act && half == 0 && lane == 0) { ((float*)(a->ws + WS_BL))[u] = bl; ((float*)(a->ws + WS_AC))[u] = ac; }
    LAS char* kbase = (LAS char*)(lds + head * 36864); LAS char* vbase = kbase + 18432;
#pragma unroll
    for (int it = 0; it < 16; ++it) { const int rr = it * 4 + (lane >> 4), ch = lane & 15;
        const float wr = __shfl(w, rr); const u32x4 x = st16[it];
        if (half == 0) { u32x4 o;
            o.x = pk2(bflo(x.x) * wr, bfhi(x.x) * wr); o.y = pk2(bflo(x.y) * wr, bfhi(x.y) * wr); o.z = pk2(bflo(x.z) * wr, bfhi(x.z) * wr); o.w = pk2(bflo(x.w) * wr, bfhi(x.w) * wr);
            *(LAS u32x4*)(kbase + rr * MPB + ch * 16) = o; }
        else *(LAS u32x4*)(vbase + rr * MPB + ch * 16) = x;
    }
    __syncthreads();
    if (act) {
#pragma unroll
    for (int dh = 0; dh < 2; ++dh) {
        f32x16 acc[2][2];
#pragma unroll
        for (int di = 0; di < 2; ++di) { acc[di][0] = zero16(); acc[di][1] = zero16(); }
#pragma unroll
        for (int ks = 0; ks < 4; ++ks) {
            bf16x8 af[2], bfr[2];
#pragma unroll
            for (int di = 0; di < 2; ++di) af[di] = vtr2(kbase + (16 * ks + 8 * h + q4) * MPB + 2 * (32 * (2 * dh + di) + 16 * blk) + 8 * p4, 4 * MPB);
#pragma unroll
            for (int ei = 0; ei < 2; ++ei) bfr[ei] = vtr2(vbase + (16 * ks + 8 * h + q4) * MPB + 2 * (32 * (2 * half + ei) + 16 * blk) + 8 * p4, 4 * MPB);
#pragma unroll
            for (int di = 0; di < 2; ++di)
#pragma unroll
                for (int ei = 0; ei < 2; ++ei) acc[di][ei] = MFMA32(af[di], bfr[ei], acc[di][ei]);
        }
#pragma unroll
        for (int di = 0; di < 2; ++di)
#pragma unroll
            for (int ei = 0; ei < 2; ++ei)
#pragma unroll
                for (int g = 0; g < 4; ++g) { const int e = 32 * (2 * half + ei) + r, d0 = 32 * (2 * dh + di) + 8 * g + 4 * h;
                    u32x2 o; o.x = pk2(acc[di][ei][4 * g], acc[di][ei][4 * g + 1]); o.y = pk2(acc[di][ei][4 * g + 2], acc[di][ei][4 * g + 3]);
                    *(u32x2*)(SC + (size_t)u * 16384 + e * 128 + d0) = o; }
    }
    { const int d = half * 64 + lane; float s = 0.f;
#pragma unroll 8
      for (int sidx = 0; sidx < 64; ++sidx) s += bf2f(*(const LAS unsigned short*)(kbase + sidx * MPB + d * 2));
      ((float*)(a->ws + WS_NC))[(size_t)u * 128 + d] = s; }
    }
    __syncthreads();
}

DI void phase_c_pre(int l) {
    const ArgsP a = get_args(); const int tid = get_tid();
    const bf16* Z = (const bf16*)(a->ws + WS_Z);
    for (int it = get_bid() * NTHR + tid; it < 147456; it += get_nb() * NTHR) {
        int row, kv, cc; float* dst;
        if (it < 131072) { const int b = it >> 16, t = (it >> 7) & 511; kv = (it >> 6) & 1; cc = it & 63; row = b * SEQ + (SEQ - 512) + t;
            dst = a->out + (kv ? O_VP : O_KP) + ((size_t)((l * 2 + b) * 8 + (cc >> 3)) * 512 + t) * 64 + (cc & 7) * 8; }
        else { const int i2 = it - 131072; const int rr = i2 >> 7; kv = (i2 >> 6) & 1; cc = i2 & 63; row = MPR + rr; const int sb = rr >> 4, t = rr & 15;
            dst = a->out + (kv ? O_VS : O_KS) + ((size_t)((l * 8 + sb) * 8 + (cc >> 3)) * 16 + t) * 64 + (cc & 7) * 8; }
        const u32x4 x = *(const u32x4*)(Z + (size_t)row * NZ + 512 + kv * 512 + cc * 8);
        f32x4 o0 = {bflo(x.x), bfhi(x.x), bflo(x.y), bfhi(x.y)}, o1 = {bflo(x.z), bfhi(x.z), bflo(x.w), bfhi(x.w)};
        *(f32x4*)dst = o0; *(f32x4*)(dst + 4) = o1;
    }
}

DI void phase_m2(int l, LAS unsigned char* lds) {
    const ArgsP a = get_args(); const int tid = get_tid(), lane = tid & 63;
    bf16* SC = (bf16*)(a->ws + WS_SC); const float* BL = (const float*)(a->ws + WS_BL); const float* AC = (const float*)(a->ws + WS_AC);
    float* MPREV = (float*)(a->ws + WS_MPREV); const float* NC = (const float*)(a->ws + WS_NC); float* NPREV = (float*)(a->ws + WS_NPREV);
    LAS float* DEC = (LAS float*)lds; LAS float* SCL = DEC + 128;
    const int NTH = get_nb() * NTHR;
    for (int base = get_bid() * NTHR; base < 8 * 16384; base += NTH) {
        const int bh = base >> 14, el = (base & 16383) + tid; const bool doN = el < 128;
        __syncthreads();
        if (tid < 64) {
            float Fc = 0.f, gc = 0.f;
#pragma unroll
            for (int rd = 0; rd < 2; ++rd) {
                const int c = rd * 64 + lane, u = bh * 128 + c; const float bl = BL[u], ac = AC[u];
                float F = bl;
#pragma unroll
                for (int o = 1; o < 64; o <<= 1) { const float t = __shfl_up(F, o); if (lane >= o) F += t; }
                F += Fc;
                float Fm1 = __shfl_up(F, 1); if (lane == 0) Fm1 = Fc;
                float g = ac - Fm1;
#pragma unroll
                for (int o = 1; o < 64; o <<= 1) { const float t = __shfl_up(g, o); if (lane >= o) g = fmaxf(g, t); }
                g = fmaxf(g, gc);
                float gm1 = __shfl_up(g, 1); if (lane == 0) gm1 = gc;
                const float mprev = Fm1 + gm1, mnew = F + g;
                DEC[c] = expf(bl + mprev - mnew); SCL[c] = expf(bl + ac - mnew);
                if ((base & 16383) == 0) { MPREV[u] = mprev; if (c == 127) a->out[O_MP + l * 8 + bh] = mnew; }
                Fc = __shfl(F, 63); gc = __shfl(g, 63);
            }
        }
        __syncthreads();
        float C = 0.f, n = 0.f;
#pragma unroll 1
        for (int c0 = 0; c0 < 128; c0 += 32) {
            float s[32];
#pragma unroll
            for (int k = 0; k < 32; ++k) s[k] = bf2f(SC[(size_t)(bh * 128 + c0 + k) * 16384 + el]);
            if (doN) {
                float nc[32];
#pragma unroll
                for (int k = 0; k < 32; ++k) nc[k] = NC[(size_t)(bh * 128 + c0 + k) * 128 + el];
#pragma unroll
                for (int k = 0; k < 32; ++k) { NPREV[(size_t)(bh * 128 + c0 + k) * 128 + el] = n; n = DEC[c0 + k] * n + SCL[c0 + k] * nc[k]; }
            }
#pragma unroll
            for (int k = 0; k < 32; ++k) { SC[(size_t)(bh * 128 + c0 + k) * 16384 + el] = (bf16)(pk2(C, 0.f) & 0xffffu); C = DEC[c0 + k] * C + SCL[c0 + k] * s[k]; }
        }
        const int e = el >> 7, d = el & 127;
        a->out[O_CP + (size_t)(l * 8 + bh) * 16384 + d * 128 + e] = C;
        if (doN) a->out[O_NP + (size_t)(l * 8 + bh) * 128 + el] = n;
    }
}

DI void m3_item(int l, bool sample, int bb, int c, LAS unsigned char* lds, int hp = -1) {
    const ArgsP a = get_args(); const int tid = get_tid(), lane = tid & 63, wave = tid >> 6, head = wave >> 1, tt = wave & 1, r = lane & 31, h = lane >> 5;
    const int i16 = lane & 15, q4 = i16 >> 2, p4 = i16 & 3, blk = (lane >> 4) & 1;
    const bf16* Z = (const bf16*)(a->ws + WS_Z); const float* IG = (const float*)(a->ws + WS_IG); const float* LF = (const float*)(a->ws + WS_LF);
    const bf16* SC = (const bf16*)(a->ws + WS_SC); bf16* ACT = (bf16*)(a->ws + WS_ACT);
    const int row0 = sample ? MPR + bb * 16 : bb * SEQ + c * 64;
    const int u = sample ? 1024 + bb * 4 + head : (bb * 4 + head) * 128 + c;
    LAS char* vbase = (LAS char*)(lds + head * 18432);
    LAS float* AS = (LAS float*)(lds + 73728) + head * 64; LAS float* BS = (LAS float*)(lds + 73728 + 1024) + head * 64;
    LAS float* MT = (LAS float*)(lds + 73728 + 2048) + head * 64; LAS float* NP = (LAS float*)(lds + 73728 + 3072) + head * 128;
    const float mprev = ((const float*)(a->ws + WS_MPREV))[u];
    {
        const bool valid = sample ? (lane < 16) : true;
        const int rs = row0 + (sample ? (lane < 16 ? lane : 15) : lane);
        float b = valid ? LF[(size_t)rs * 4 + head] : 0.f; const float ig = valid ? IG[(size_t)rs * 4 + head] : -INFINITY;
#pragma unroll
        for (int o = 1; o < 64; o <<= 1) { const float t = __shfl_up(b, o); if (lane >= o) b += t; }
        const float av = ig - b; float cm = av;
#pragma unroll
        for (int o = 1; o < 64; o <<= 1) { const float t = __shfl_up(cm, o); if (lane >= o) cm = fmaxf(cm, t); }
        const float mt = b + fmaxf(mprev, cm);
        if (tt == 0) { AS[lane] = av; BS[lane] = b; MT[lane] = mt; const float* np = (const float*)(a->ws + WS_NPREV) + (size_t)u * 128; NP[lane] = np[lane]; NP[64 + lane] = np[64 + lane]; }
    }
#pragma unroll
    for (int hb = 0; hb < 2; ++hb) {
        u32x4 vst[4];
#pragma unroll
        for (int it = 0; it < 4; ++it) { const int idx = (4 * hb + it) * 128 + tt * 64 + lane; const int rr = idx >> 4, ch = idx & 15; const int srow = row0 + (sample ? (rr < 16 ? rr : 15) : rr);
            vst[it] = *(const u32x4*)(Z + (size_t)srow * NZ + 2560 + head * 128 + ch * 8); }
#pragma unroll
        for (int it = 0; it < 4; ++it) { const int idx = (4 * hb + it) * 128 + tt * 64 + lane; const int rr = idx >> 4, ch = idx & 15; *(LAS u32x4*)(vbase + rr * MPB + ch * 16) = vst[it]; }
    }
    const int t = 32 * tt + r;
    const int rowt = row0 + (sample ? (t < 16 ? t : 15) : t);
    bf16x8 qf[8];
#pragma unroll
    for (int s = 0; s < 8; ++s) qf[s] = *(const bf16x8*)(Z + (size_t)rowt * NZ + 1536 + head * 128 + 16 * s + 8 * h);
    bf16x8 scf[2][8], kf0[8];
#pragma unroll
    for (int et = 0; et < 2; ++et)
#pragma unroll
        for (int s = 0; s < 8; ++s) scf[et][s] = *(const bf16x8*)(SC + (size_t)u * 16384 + (32 * et + r) * 128 + 16 * s + 8 * h);
    { const int krow = row0 + (sample ? (r < 16 ? r : 15) : r);
#pragma unroll
      for (int s = 0; s < 8; ++s) kf0[s] = *(const bf16x8*)(Z + (size_t)krow * NZ + 2048 + head * 128 + 16 * s + 8 * h); }
    __syncthreads();
    if (!(sample && tt == 1) && ((hp < 0) || ((head >> 1) == hp))) {
        f32x16 acc[4];
#pragma unroll
        for (int et = 0; et < 2; ++et) { acc[et] = zero16();
#pragma unroll
            for (int s = 0; s < 8; ++s) acc[et] = MFMA32(scf[et][s], qf[s], acc[et]); }
#pragma unroll
        for (int et = 2; et < 4; ++et) { acc[et] = zero16();
#pragma unroll
            for (int s = 0; s < 8; ++s) { const bf16x8 af = *(const bf16x8*)(SC + (size_t)u * 16384 + (32 * et + r) * 128 + 16 * s + 8 * h); acc[et] = MFMA32(af, qf[s], acc[et]); } }
        const float bt = BS[t], mtt = MT[t]; const float wint = __expf(bt + mprev - mtt);
#pragma unroll
        for (int et = 0; et < 4; ++et) acc[et] *= wint;
        float qn = 0.f;
#pragma unroll
        for (int s = 0; s < 8; ++s)
#pragma unroll
            for (int jj = 0; jj < 8; ++jj) qn += bf2f((unsigned short)qf[s][jj]) * NP[16 * s + 8 * h + jj];
        qn += __shfl_xor(qn, 32);
        float den = wint * qn, denp = 0.f;
        u32x2 ogv[4][4];
#pragma unroll
        for (int et = 0; et < 4; ++et)
#pragma unroll
            for (int g = 0; g < 4; ++g) ogv[et][g] = *(const u32x2*)(Z + (size_t)rowt * NZ + 3072 + head * 128 + 32 * et + 8 * g + 4 * h);
        for (int st = 0; st <= tt; ++st) {
            f32x16 S = zero16();
            const int kr = 32 * st + r; const int krow = row0 + (sample ? (kr < 16 ? kr : 15) : kr);
            if (st == 0) {
#pragma unroll
                for (int s = 0; s < 8; ++s) S = MFMA32(kf0[s], qf[s], S);
            } else {
#pragma unroll
                for (int s = 0; s < 8; ++s) { const bf16x8 kf = *(const bf16x8*)(Z + (size_t)krow * NZ + 2048 + head * 128 + 16 * s + 8 * h); S = MFMA32(kf, qf[s], S); }
            }
#pragma unroll
            for (int i = 0; i < 16; ++i) { const int sl = 32 * st + (i & 3) + 8 * (i >> 2) + 4 * h; const float wgt = (sl <= t) ? __expf(bt + AS[sl] - mtt) : 0.f; S[i] *= wgt; denp += S[i]; }
            const bf16x8 pf0 = pack8(S, 0), pf1 = pack8(S, 1);
#pragma unroll
            for (int et = 0; et < 4; ++et) {
                const bf16x8 v0 = vtr2(vbase + (32 * st + 4 * h + q4) * MPB + 2 * (32 * et + 16 * blk) + 8 * p4, 8 * MPB);
                const bf16x8 v1 = vtr2(vbase + (32 * st + 16 + 4 * h + q4) * MPB + 2 * (32 * et + 16 * blk) + 8 * p4, 8 * MPB);
                acc[et] = MFMA32(v0, pf0, acc[et]); acc[et] = MFMA32(v1, pf1, acc[et]);
            }
        }
        den += denp + __shfl_xor(denp, 32);
        const float dd = fmaxf(fabsf(den), __expf(-mtt)); const float inv = 1.0f / dd;
        float ssq = 0.f;
#pragma unroll
        for (int et = 0; et < 4; ++et) { acc[et] *= inv;
#pragma unroll
            for (int i = 0; i < 16; ++i) ssq += acc[et][i] * acc[et][i]; }
        ssq += __shfl_xor(ssq, 32);
        const float rr = 1.0f / sqrtf(ssq * (1.f / 128.f) + EPS);
        const bool ok = sample ? (t < 16) : true;
        if (ok) {
            const float* gml = a->in[14] + l * 512 + head * 128;
#pragma unroll
            for (int et = 0; et < 4; ++et)
#pragma unroll
                for (int g = 0; g < 4; ++g) { const int e0 = 32 * et + 8 * g + 4 * h;
                    const u32x2 ob = ogv[et][g]; const f32x4 gm = *(const f32x4*)(gml + e0);
                    const float o0 = bflo(ob.x), o1 = bfhi(ob.x), o2 = bflo(ob.y), o3 = bfhi(ob.y);
                    const float y0 = acc[et][4 * g] * rr * gm.x * __builtin_amdgcn_rcpf(1.f + __expf(-o0)), y1 = acc[et][4 * g + 1] * rr * gm.y * __builtin_amdgcn_rcpf(1.f + __expf(-o1));
                    const float y2 = acc[et][4 * g + 2] * rr * gm.z * __builtin_amdgcn_rcpf(1.f + __expf(-o2)), y3 = acc[et][4 * g + 3] * rr * gm.w * __builtin_amdgcn_rcpf(1.f + __expf(-o3));
                    u32x2 o; o.x = pk2(y0, y1); o.y = pk2(y2, y3);
                    *(u32x2*)(ACT + (size_t)rowt * DM + 512 + head * 128 + e0) = o; }
        }
    }
    __syncthreads();
}
DI void sample_m2(int l, int sb, int hp, LAS unsigned char* lds) {
    const ArgsP a = get_args(); const int tid = get_tid();
    bf16* SC = (bf16*)(a->ws + WS_SC); const float* BL = (const float*)(a->ws + WS_BL); const float* AC = (const float*)(a->ws + WS_AC);
    float* MPREV = (float*)(a->ws + WS_MPREV); const float* NC = (const float*)(a->ws + WS_NC); float* NPREV = (float*)(a->ws + WS_NPREV);
    LAS float* Lc = (LAS float*)lds; LAS float* Ls = Lc + 128 * 129;
    for (int hh = 2 * hp; hh < 2 * hp + 2; ++hh) {
        const int su = sb * 4 + hh, u = 1024 + su;
        const float* c0p = a->in[4] + (size_t)(l * 32 + su) * 16384; bf16* scp = SC + (size_t)u * 16384; float* ocp = a->out + O_CS + (size_t)(l * 32 + su) * 16384;
        const float m0 = a->in[6][l * 32 + su];
        const float bl = BL[u], ac = AC[u]; const float mn = bl + fmaxf(m0, ac); const float dec = expf(bl + m0 - mn), sc = expf(bl + ac - mn);
#pragma unroll 1
        for (int i0 = 0; i0 < 32; i0 += 16) {
            float cv[16]; unsigned short sv[16];
#pragma unroll
            for (int ii = 0; ii < 16; ++ii) { const int idx = tid + (i0 + ii) * NTHR; cv[ii] = c0p[idx]; sv[ii] = scp[idx]; }
#pragma unroll
            for (int ii = 0; ii < 16; ++ii) { const int idx = tid + (i0 + ii) * NTHR; const int r = idx >> 7, q = idx & 127; Lc[r * 129 + q] = cv[ii]; Ls[r * 129 + q] = bf2f(sv[ii]); }
        }
        __syncthreads();
#pragma unroll
        for (int ii = 0; ii < 32; ++ii) { const int idx = tid + ii * NTHR; const int r = idx >> 7, q = idx & 127;
            scp[idx] = (bf16)(pk2(Lc[q * 129 + r], 0.f) & 0xffffu);
            ocp[idx] = dec * Lc[r * 129 + q] + sc * Ls[q * 129 + r]; }
        if (tid < 128) { const float n0 = a->in[5][(size_t)(l * 32 + su) * 128 + tid]; NPREV[(size_t)u * 128 + tid] = n0; a->out[O_NS + (size_t)(l * 32 + su) * 128 + tid] = dec * n0 + sc * NC[(size_t)u * 128 + tid]; }
        if (tid == 0) { MPREV[u] = m0; a->out[O_MS + l * 32 + su] = mn; }
        __syncthreads();
    }
}
#define BLOCK_MEM_SYNC() do { asm volatile("s_waitcnt vmcnt(0)" ::: "memory"); __syncthreads(); __builtin_amdgcn_fence(__ATOMIC_ACQUIRE, "agent"); asm volatile("s_waitcnt vmcnt(0)" ::: "memory"); } while (0)
DI void load_bias(int l, LAS unsigned char* lds) {
    const ArgsP a = get_args(); const int tid = get_tid();
    for (int e = tid; e < 8 * 320; e += NTHR) { const int hd = e / 320, i = e % 320; ((LAS float*)(lds + 73728))[hd * 320 + i] = a->in[12][(size_t)(l * 8 + hd) * 513 + 193 + i] * 1.4426950408889634f; }
    __syncthreads();
}
DI void phase_ce(int l, bool isE, LAS unsigned char* lds) {
    if (!isE) phase_c_pre(l);
    const int bid = get_bid(), nb = get_nb();
    const bool deal = (nb == 256);
    const int v = deal ? ((bid & 7) * 32 + (bid >> 3)) : bid;
    if (!isE) {
        for (int t = v; t < 16; t += nb) {
            m1_item(true, t >> 1, 0, lds, t & 1);
            BLOCK_MEM_SYNC();
            sample_m2(l, t >> 1, t & 1, lds);
            BLOCK_MEM_SYNC();
            m3_item(l, true, t >> 1, 0, lds, t & 1);
        }
    }
    int q_lo, q_hi, q_st, m_lo = 256, m_hi = 256, m_st = 1;
    if (deal) {
        if (isE) { q_lo = v; q_hi = v + 1; q_st = 1; }
        else { const int w = v - 16; q_lo = w < 0 ? 264 : (w * 264) / 240; q_hi = w < 0 ? 264 : ((w + 1) * 264) / 240; q_st = 1;
               const int r1 = 2 * w - q_lo; const bool one = (w >= 0) && (q_hi - q_lo == 1); if (one) { m_lo = (r1 * 256) / 216; m_hi = ((r1 + 1) * 256) / 216; } }
    } else { q_lo = isE ? 520 : bid; q_hi = 520; q_st = nb; if (!isE) { m_lo = bid; m_hi = 256; m_st = nb; } }
    if (q_lo < q_hi) load_bias(l, lds);
    const int npr = (deal && !isE) ? 256 : 512;
    for (int q = q_lo; q < q_hi && q < npr; q += q_st) { const int g = (deal && isE) ? 256 + q : q; attn_unit<false>(l, g >> 8, (g >> 1) & 127, g & 1, lds); }
    { int q0 = q_lo; if (q0 < npr) q0 += ((npr - q0 + q_st - 1) / q_st) * q_st;
      for (int q = q0; q < q_hi; q += q_st) attn_unit<true>(l, q - npr, 0, 0, lds); }
    __syncthreads();
    for (int t = m_lo; t < m_hi; t += m_st) m1_item(false, t >> 7, t & 127, lds);
    if (isE) for (int it = bid; it < 256; it += nb) m3_item(l, false, it >> 7, it & 127, lds);
}

DI float gelu_tanh(float x) { const float ee = __builtin_amdgcn_exp2f(x * (2.3022082f + 0.10294324f * x * x)); return x - x * __builtin_amdgcn_rcpf(ee + 1.f); }
DI void ld8(const bf16* p, float (&o)[8]) { const u32x4 x = *(const u32x4*)p; o[0] = bflo(x.x); o[1] = bfhi(x.x); o[2] = bflo(x.y); o[3] = bfhi(x.y); o[4] = bflo(x.z); o[5] = bfhi(x.z); o[6] = bflo(x.w); o[7] = bfhi(x.w); }
DI void ldf8(const float* p, float (&o)[8]) { const f32x4 x = *(const f32x4*)p, y = *(const f32x4*)(p + 4); o[0] = x.x; o[1] = x.y; o[2] = x.z; o[3] = x.w; o[4] = y.x; o[5] = y.y; o[6] = y.z; o[7] = y.w; }
DI void phase_fix(int l) {
    const ArgsP a = get_args(); const int gt = get_bid() * NTHR + get_tid(), NTH = get_nb() * NTHR;
    const bf16* UQ = (const bf16*)(a->ws + WS_UQ); bf16* G = (bf16*)(a->ws + WS_G);
    const float* wc = a->in[17] + (size_t)l * 3 * NU; const float* bc = a->in[18] + (size_t)l * NU;
    for (int item = gt; item < (MVALID / 16) * 352; item += NTH) {
        const int k = item / 352, cc = item % 352, j0 = cc * 8; const int m0 = 16 * k;
        const bool smp = m0 >= MPR; const bool bstart = smp ? true : ((m0 & (SEQ - 1)) == 0); const int sb = smp ? (m0 - MPR) >> 4 : 0;
        float w0g[8], w1g[8], w2g[8], bg[8], w0u[8], w1u[8], w2u[8], bu[8];
        ldf8(wc + j0, w0g); ldf8(wc + NU + j0, w1g); ldf8(wc + 2 * NU + j0, w2g); ldf8(bc + j0, bg);
        ldf8(wc + DFF + j0, w0u); ldf8(wc + NU + DFF + j0, w1u); ldf8(wc + 2 * NU + DFF + j0, w2u); ldf8(bc + DFF + j0, bu);
        float p2g[8], p1g[8], p2u[8], p1u[8], c0g[8], c0u[8], c1g[8], c1u[8];
        if (bstart) {
            if (smp) { const float* cb = a->in[7] + (size_t)((l * 8 + sb) * 2) * NU; ldf8(cb + j0, p2g); ldf8(cb + NU + j0, p1g); ldf8(cb + DFF + j0, p2u); ldf8(cb + NU + DFF + j0, p1u); }
            else {
#pragma unroll
                for (int q = 0; q < 8; ++q) { p2g[q] = 0.f; p1g[q] = 0.f; p2u[q] = 0.f; p1u[q] = 0.f; } }
        } else { const bf16* pq = UQ + (size_t)(4 * (k - 1) + 2) * NU; ld8(pq + j0, p2g); ld8(pq + NU + j0, p1g); ld8(pq + DFF + j0, p2u); ld8(pq + NU + DFF + j0, p1u); }
        const bf16* cq = UQ + (size_t)(4 * k) * NU; ld8(cq + j0, c0g); ld8(cq + DFF + j0, c0u); ld8(cq + NU + j0, c1g); ld8(cq + NU + DFF + j0, c1u);
        float o0[8], o1[8];
#pragma unroll
        for (int q = 0; q < 8; ++q) {
            o0[q] = gelu_tanh(bg[q] + p2g[q] * w0g[q] + p1g[q] * w1g[q] + c0g[q] * w2g[q]) * (bu[q] + p2u[q] * w0u[q] + p1u[q] * w1u[q] + c0u[q] * w2u[q]);
            o1[q] = gelu_tanh(bg[q] + p1g[q] * w0g[q] + c0g[q] * w1g[q] + c1g[q] * w2g[q]) * (bu[q] + p1u[q] * w0u[q] + c0u[q] * w1u[q] + c1u[q] * w2u[q]); }
        u32x4 ov; ov.x = pk2(o0[0], o0[1]); ov.y = pk2(o0[2], o0[3]); ov.z = pk2(o0[4], o0[5]); ov.w = pk2(o0[6], o0[7]);
        *(u32x4*)(G + (size_t)m0 * DFF + j0) = ov;
        ov.x = pk2(o1[0], o1[1]); ov.y = pk2(o1[2], o1[3]); ov.z = pk2(o1[4], o1[5]); ov.w = pk2(o1[6], o1[7]);
        *(u32x4*)(G + (size_t)(m0 + 1) * DFF + j0) = ov;
        const bool lastg = smp ? true : ((m0 & (SEQ - 1)) == SEQ - 16);
        if (lastg) {
            float* fo = smp ? a->out + O_FS + (size_t)((l * 8 + sb) * 2) * NU : a->out + O_FP + (size_t)((l * 2 + (m0 >> 13)) * 2) * NU;
            float e0[8], e1[8]; const bf16* lq = UQ + (size_t)(4 * k + 2) * NU;
            ld8(lq + j0, e0); ld8(lq + NU + j0, e1);
            *(f32x4*)(fo + j0) = (f32x4){e0[0], e0[1], e0[2], e0[3]}; *(f32x4*)(fo + j0 + 4) = (f32x4){e0[4], e0[5], e0[6], e0[7]};
            *(f32x4*)(fo + NU + j0) = (f32x4){e1[0], e1[1], e1[2], e1[3]}; *(f32x4*)(fo + NU + j0 + 4) = (f32x4){e1[4], e1[5], e1[6], e1[7]};
            ld8(lq + DFF + j0, e0); ld8(lq + NU + DFF + j0, e1);
            *(f32x4*)(fo + DFF + j0) = (f32x4){e0[0], e0[1], e0[2], e0[3]}; *(f32x4*)(fo + DFF + j0 + 4) = (f32x4){e0[4], e0[5], e0[6], e0[7]};
            *(f32x4*)(fo + NU + DFF + j0) = (f32x4){e1[0], e1[1], e1[2], e1[3]}; *(f32x4*)(fo + NU + DFF + j0 + 4) = (f32x4){e1[4], e1[5], e1[6], e1[7]};
        }
    }
}

#define XB_TMO      128
#define XB_XCNT(j)  (256  + 64 * (j))
#define XB_XSUB(j)  (1280 + 64 * (j))
#define XB_XGEN(j)  (2304 + 64 * (j))
#define XB_TOP      3328
#define XB_TOPGEN   3392
#define XCD_BAR_WORDS 3456
#define XB_SPIN_CAP (1u << 18)
__device__ __forceinline__ unsigned xb_ld(unsigned* p)              { return __hip_atomic_load(p, __ATOMIC_RELAXED, __HIP_MEMORY_SCOPE_AGENT); }
__device__ __forceinline__ unsigned xb_add(unsigned* p, unsigned v) { return __hip_atomic_fetch_add(p, v, __ATOMIC_RELAXED, __HIP_MEMORY_SCOPE_AGENT); }
__device__ __forceinline__ unsigned xb_xcc_id() { return (unsigned)__builtin_amdgcn_s_getreg((3 << 11) | 20) & 0xFu; }
#define XB_SPIN(cond, bar) do { unsigned _sp = 0; while (cond) { __builtin_amdgcn_s_sleep(1); \
    if ((++_sp & 255u) == 0u) { if (xb_ld(&(bar)[XB_TMO])) break; if (_sp > XB_SPIN_CAP) { atomicAdd(&(bar)[XB_TMO], 1u); break; } } } } while (0)

struct XcdBarrier {
    unsigned* bar; unsigned x;
    volatile LAS unsigned* st;
};

__device__ __forceinline__ XcdBarrier xcd_barrier_post(unsigned* bar, volatile LAS unsigned* st) {
    XcdBarrier b; b.bar = bar; b.x = xb_xcc_id(); b.st = st;
    if (threadIdx.x == 0) (void)xb_add(&bar[XB_XCNT(b.x)], 1u);
    return b;
}
__device__ __forceinline__ void xcd_barrier_complete(unsigned* bar, unsigned x, unsigned& nloc, unsigned& nx) {
    const unsigned G = gridDim.x * gridDim.y * gridDim.z;
    unsigned sum, cnt, mine, sp = 0u;
    for (;;) {
        sum = 0u; cnt = 0u; mine = 0u;
#pragma unroll
        for (unsigned j = 0; j < 16; ++j) { const unsigned c = xb_ld(&bar[XB_XCNT(j)]); sum += c; cnt += (c > 0u) ? 1u : 0u; mine = (j == x) ? c : mine; }
        if (sum == G) break;
        __builtin_amdgcn_s_sleep(1);
        if ((++sp & 255u) == 0u) { if (xb_ld(&bar[XB_TMO])) break; if (sp > XB_SPIN_CAP) { atomicAdd(&bar[XB_TMO], 1u); break; } }
    }
    nloc = mine > 0u ? mine : 1u; nx = cnt > 0u ? cnt : 1u;
}

__device__ __forceinline__ void xcd_barrier(const XcdBarrier& b) {
    asm volatile("s_waitcnt vmcnt(0)" ::: "memory");
    __syncthreads();
    if (threadIdx.x == 0) {
        unsigned* bar = b.bar;
        __builtin_amdgcn_s_waitcnt(0);
        unsigned nloc = b.st[0], nx = b.st[1];
        if (nloc == 0u) { xcd_barrier_complete(bar, b.x, nloc, nx); b.st[0] = nloc; b.st[1] = nx; }
        const unsigned old = xb_add(&bar[XB_XSUB(b.x)], 1u);
        const unsigned gen = old / nloc;
        if (old + 1u == (gen + 1u) * nloc) {
            __builtin_amdgcn_fence(__ATOMIC_RELEASE, "agent");
            asm volatile("s_waitcnt vmcnt(0)" ::: "memory");
            const unsigned og = xb_add(&bar[XB_TOP], 1u);
            const unsigned tg = og / nx;
            if (og + 1u == (tg + 1u) * nx) xb_add(&bar[XB_TOPGEN], 1u);
            else XB_SPIN(xb_ld(&bar[XB_TOPGEN]) == tg, bar);
            __builtin_amdgcn_fence(__ATOMIC_ACQUIRE, "agent");
            xb_add(&bar[XB_XGEN(b.x)], 1u);
            asm volatile("s_waitcnt vmcnt(0)" ::: "memory");
        } else {
            XB_SPIN(xb_ld(&bar[XB_XGEN(b.x)]) == gen, bar);
            __builtin_amdgcn_fence(__ATOMIC_ACQUIRE, "agent");
            asm volatile("s_waitcnt vmcnt(0)" ::: "memory");
        }
    }
    __syncthreads();
}


#ifndef PHMASK
#define PHMASK 0xffff
#endif
#ifndef REP_GEMM
#define REP_GEMM 1
#endif
#ifndef REP_C
#define REP_C 1
#endif
#ifndef REP_E
#define REP_E 1
#endif
#ifndef REP_SYNC
#define REP_SYNC 1
#endif
#ifndef REP_CONV
#define REP_CONV 1
#endif
__global__ void __launch_bounds__(NTHR, 2) fwd_mega(Args a_unused) {
    extern __shared__ __attribute__((aligned(16))) unsigned char lds_raw[];
    LAS unsigned char* lds0 = (LAS unsigned char*)lds_raw;
    cg::grid_group grid = cg::this_grid();
    volatile LAS unsigned* st = (volatile LAS unsigned*)(lds0 + 147456);
    if (threadIdx.x < 4) st[threadIdx.x] = 0u;
    __syncthreads();
    unsigned* barw = (unsigned*)(get_args()->ws + WS_BAR);
    if (blockIdx.x == 0) { for (int i = threadIdx.x; i < XCD_BAR_WORDS; i += NTHR) __hip_atomic_store(barw + i, 0u, __ATOMIC_RELAXED, __HIP_MEMORY_SCOPE_AGENT); }
    grid.sync();
    const XcdBarrier bar = xcd_barrier_post(barw, st);
#pragma nounroll
    for (int step = 0; step < 21; ++step) {
        const int l = step / 10, ph = (step == 20) ? 12 : step % 10;
        LAS unsigned char* lds = lds0; asm volatile("" : "+s"(lds));
        if (ph == 1 || ph == 5 || ph == 7 || ph == 9) {
            if (PHMASK & 4) {
            const ArgsP a = get_args(); unsigned char* ws = a->ws;
            const bf16* A; const bf16* Bt; void* O; int M, N, K, mode;
            if (ph == 1)       { A = (const bf16*)(ws + WS_ACT); Bt = (const bf16*)(ws + WS_WIN); O = ws + WS_Z; M = MPAD; N = NZ + 256; K = DM; mode = 1; }
            else if (ph == 5)  { A = (const bf16*)(ws + WS_ACT); Bt = (const bf16*)(ws + WS_WOUT); O = ws + WS_MIX; M = MPR; N = DM; K = DM; mode = 0; }
            else if (ph == 7)  { A = (const bf16*)(ws + WS_ACT); Bt = (const bf16*)(ws + WS_WUP); O = ws + WS_G; M = MPAD; N = NU; K = DM; mode = 3; }
            else               { A = (const bf16*)(ws + WS_G); Bt = (const bf16*)(ws + WS_WDN); O = ws + WS_FFN; M = MPR; N = DM; K = DFF; mode = 0; }
            pg8::EpiGen E{O, N, mode, ws + WS_UQ, a->in[17] + (size_t)l * 3 * NU, a->in[18] + (size_t)l * NU, (float*)(ws + WS_IG), (float*)(ws + WS_LF), a->in[10] + l * 4, a->in[11] + l * 4};
            pg8::Gemm g{A, Bt, M, N, K}; pg8::StaticOrder S; S.init(M, N, get_nb(), get_bid());
            pg8::gemm_phase<pg8::EpiGen, pg8::StaticOrder, true, true>(lds, g, S, E);
            if (ph == 5 || ph == 9) mini_gemm(lds, A + (size_t)MPR * K, Bt, K, (bf16*)O + (size_t)MPR * DM);
            }
        } else if (ph == 0 || ph == 6 || ph == 12) {
            if (ph == 0 && (PHMASK & 1)) { phase_convert(l, lds); __syncthreads(); }
            if (PHMASK & 2) {
            const ArgsP a = get_args();
            const float* ngl = a->in[8] + (size_t)l * 4 * DM;
            bool first; const bf16* addsrc; const float* gadd; const float* gn; int gl;
            if (ph == 0) { first = (l == 0); addsrc = (l == 0) ? nullptr : (const bf16*)(a->ws + WS_FFN); gadd = ngl - DM; gn = ngl; gl = -1; }
            else if (ph == 6) { first = (l == 0); addsrc = (const bf16*)(a->ws + WS_MIX); gadd = ngl + DM; gn = ngl + 2 * DM; gl = -1; }
            else { first = false; addsrc = (const bf16*)(a->ws + WS_FFN); gadd = a->in[8] + (size_t)7 * DM; gn = nullptr; gl = -1; }
            phase_rows(lds, first, addsrc, gadd, gn, gl, ph == 12);
            }
        } else if (ph == 2 || ph == 4) { if (PHMASK & 8) phase_ce(l, ph == 4, lds); }
        else if (ph == 3) { if (PHMASK & 16) phase_m2(l, lds); }
        else { if (PHMASK & 512) phase_fix(l); }
        if (step < 20) xcd_barrier(bar);
    }
}

extern "C" void kernel_launch(void* const* d_in, const int* in_sizes, int n_in, void* d_out, int out_size, void* d_ws, size_t ws_size, hipStream_t stream) {
    static int grid = 0;
    if (grid == 0) {
        if (n_in != 20 || (size_t)out_size != O_END || ws_size < WS_END) { fprintf(stderr, "kernel_launch: unexpected shapes: n_in %d out %d ws %zu\n", n_in, out_size, ws_size); grid = -1; return; }
        int dev = 0, cus = 0, per_cu = 0;
        (void)hipGetDevice(&dev);
        (void)hipDeviceGetAttribute(&cus, hipDeviceAttributeMultiprocessorCount, dev);
        (void)hipFuncSetAttribute((const void*)fwd_mega, hipFuncAttributeMaxDynamicSharedMemorySize, LDS_BYTES);
        (void)hipOccupancyMaxActiveBlocksPerMultiprocessor(&per_cu, (const void*)fwd_mega, NTHR, LDS_BYTES);
        if (per_cu < 1) per_cu = 1;
        grid = cus * per_cu;
    }
    if (grid < 0) return;
    Args a{};
    for (int i = 0; i < 20; ++i) a.in[i] = (const float*)d_in[i];
    a.out = (float*)d_out; a.ws = (unsigned char*)d_ws;
    void* args[] = {&a};
    hipError_t e = hipLaunchCooperativeKernel((const void*)fwd_mega, dim3(grid), dim3(NTHR), args, LDS_BYTES, stream);
    if (e != hipSuccess) fprintf(stderr, "cooperative launch failed: %s (grid %d)\n", hipGetErrorString(e), grid);
}
```

```cpp
#include <hip/hip_runtime.h>
#include <hip/hip_cooperative_groups.h>
#include <cstdio>
#include <cstdint>
#include <cmath>
namespace cg = cooperative_groups;

namespace pg8 {
#define PG8_LAS __attribute__((address_space(3)))
typedef unsigned short bf16_t;
typedef short bf16x8 __attribute__((ext_vector_type(8)));
typedef float f32x4 __attribute__((ext_vector_type(4)));
typedef unsigned u32x4 __attribute__((ext_vector_type(4)));
constexpr int BM = 256, BK = 64, HALF = 128, HTB = HALF * BK * 2  , STAGE_BYTES = 8 * HTB, NXCD = 8, WGM = 8;

__host__ __device__ __forceinline__ int lds_byte(int r, int c) { const int st = (r >> 4) * 2 + (c >> 5), rr = r & 15, cc = c & 31, ob = rr * 64 + cc * 2; return st * 1024 + (ob ^ (((ob >> 9) & 1) << 5)); }
__host__ __device__ __forceinline__ void stage_rc(int b, int& R, int& C) { const int st = b / 1024, sb = b % 1024, swz = sb ^ (((sb >> 9) & 1) << 5); R = (st >> 1) * 16 + swz / 64; C = (st & 1) * 32 + (swz % 64) / 2; }
__host__ __device__ __forceinline__ int perm32(int rho) { const int n = rho >> 4, i = rho & 15; return 8 * (i >> 2) + 4 * n + (i & 3); }

struct Unit { int pm, pn; };
struct Gemm { const bf16_t* A; const bf16_t* Bt; int M, N, K; };

struct StaticOrder {
    int nM, nN, nwg, G, c;
    __host__ __device__ void init(int M, int N, int G_, int c_) { nM = M / BM; nN = N / BM; nwg = nM * nN; G = G_; c = c_; }
    __host__ __device__ bool next(int i, Unit& u) const {
        const long L = (long)i * G + c; if (L >= nwg) return false;
        int wgid = (int)L; { const int q = nwg / NXCD, r = nwg % NXCD, xcd = wgid % NXCD, off = wgid / NXCD; wgid = (xcd < r ? xcd * (q + 1) : r * (q + 1) + (xcd - r) * q) + off; }
        const int nig = WGM * nN, gid = wgid / nig, fm = gid * WGM, gsz = (nM - fm) < WGM ? (nM - fm) : WGM;
        u.pm = fm + ((wgid % nig) % gsz); u.pn = (wgid % nig) / gsz; return true;
    }
    __device__ __forceinline__ void a_ready(const Unit&) const {}
    __device__ __forceinline__ void done(const Unit&) const {}
};

typedef float f32x2e __attribute__((ext_vector_type(2)));
typedef __bf16 bf16x2e __attribute__((ext_vector_type(2)));
__device__ __forceinline__ unsigned cvt_pk_bf16(float lo, float hi) { f32x2e v = {lo, hi}; bf16x2e b = __builtin_convertvector(v, bf16x2e); return __builtin_bit_cast(unsigned, b); }
__device__ __forceinline__ float gelu_t(float x) { const float ee = __builtin_amdgcn_exp2f(x * (2.3022082f + 0.10294324f * x * x)); return x - x * __builtin_amdgcn_rcpf(ee + 1.f); }
__device__ __forceinline__ float dpp_shr1(float v) { return __builtin_bit_cast(float, __builtin_amdgcn_update_dpp(0, __builtin_bit_cast(int, v), 0x111, 0xf, 0xf, true)); }
__device__ __forceinline__ float dpp_shr2(float v) { return __builtin_bit_cast(float, __builtin_amdgcn_update_dpp(0, __builtin_bit_cast(int, v), 0x112, 0xf, 0xf, true)); }
struct EpiGen {
    static constexpr bool PERM = true, AFTER_DRAIN = false;
    void* O; int ldc; int mode;
    void* O2; const float* cw; const float* cb;
    float* IGo; float* LFo; const float* bi; const float* bfg;
    __device__ __forceinline__ void operator()(const f32x4 (&acc)[2][2][4][2], const Unit& u, int wr, int wc, int fr, int fq) const {
        const int row0 = u.pm * BM + wr * 64 + fr; const int col0 = u.pn * BM + wc * 32 + 8 * fq;
        if (mode == 3) {
            const int f0 = u.pn * 128 + wc * 32 + 8 * fq;
#pragma unroll
            for (int n = 0; n < 2; ++n) {
                const int fn = f0 + 4 * n;
                const f32x4 w0g = *(const f32x4*)(cw + fn), w1g = *(const f32x4*)(cw + 5632 + fn), w2g = *(const f32x4*)(cw + 2 * 5632 + fn), bg = *(const f32x4*)(cb + fn);
                const f32x4 w0u = *(const f32x4*)(cw + 2816 + fn), w1u = *(const f32x4*)(cw + 5632 + 2816 + fn), w2u = *(const f32x4*)(cw + 2 * 5632 + 2816 + fn), bu = *(const f32x4*)(cb + 2816 + fn);
#pragma unroll
                for (int ai = 0; ai < 2; ++ai)
#pragma unroll
                    for (int m = 0; m < 4; ++m) { const int row = row0 + ai * HALF + m * 16;
                        float og[4];
#pragma unroll
                        for (int i = 0; i < 4; ++i) { const float ug = acc[ai][0][m][n][i], uu = acc[ai][1][m][n][i];
                            const float yg = bg[i] + dpp_shr2(ug) * w0g[i] + dpp_shr1(ug) * w1g[i] + ug * w2g[i];
                            const float yu = bu[i] + dpp_shr2(uu) * w0u[i] + dpp_shr1(uu) * w1u[i] + uu * w2u[i];
                            og[i] = gelu_t(yg) * yu; }
                        if (fr >= 2) { unsigned w0 = cvt_pk_bf16(og[0], og[1]), w1 = cvt_pk_bf16(og[2], og[3]);
                            unsigned* dst = (unsigned*)((bf16_t*)O + (size_t)row * 2816 + fn); dst[0] = w0; dst[1] = w1; } }
            }
            if (fr < 2 || fr >= 14) {
#pragma unroll
                for (int ai = 0; ai < 2; ++ai)
#pragma unroll
                    for (int m = 0; m < 4; ++m) { const int row = row0 + ai * HALF + m * 16;
                        bf16_t* q = (bf16_t*)O2 + (size_t)((row >> 4) * 4 + (fr < 2 ? fr : fr - 12)) * 5632 + f0;
                        u32x4 wg, wu; const f32x4 g0 = acc[ai][0][m][0], g1 = acc[ai][0][m][1], u0 = acc[ai][1][m][0], u1 = acc[ai][1][m][1];
                        wg.x = cvt_pk_bf16(g0[0], g0[1]); wg.y = cvt_pk_bf16(g0[2], g0[3]); wg.z = cvt_pk_bf16(g1[0], g1[1]); wg.w = cvt_pk_bf16(g1[2], g1[3]);
                        wu.x = cvt_pk_bf16(u0[0], u0[1]); wu.y = cvt_pk_bf16(u0[2], u0[3]); wu.z = cvt_pk_bf16(u1[0], u1[1]); wu.w = cvt_pk_bf16(u1[2], u1[3]);
                        *(u32x4*)q = wg; *(u32x4*)(q + 2816) = wu; }
            }
        } else if (mode == 2) {
#pragma unroll
            for (int ai = 0; ai < 2; ++ai)
#pragma unroll
                for (int m = 0; m < 4; ++m) { float* rowp = (float*)O + (size_t)(row0 + ai * HALF + m * 16) * ldc + col0;
#pragma unroll
                    for (int bj = 0; bj < 2; ++bj) { *(f32x4*)(rowp + bj * HALF) = acc[ai][bj][m][0]; *(f32x4*)(rowp + bj * HALF + 4) = acc[ai][bj][m][1]; } }
        } else if (mode == 1 && u.pn == 14) {
            if (wc == 0 && fq == 0) {
                const f32x4 bi4 = *(const f32x4*)bi, bf4 = *(const f32x4*)bfg;
#pragma unroll
                for (int ai = 0; ai < 2; ++ai)
#pragma unroll
                    for (int m = 0; m < 4; ++m) { const int row = row0 + ai * HALF + m * 16;
                        *(f32x4*)(IGo + (size_t)row * 4) = acc[ai][0][m][0] + bi4;
                        f32x4 x = acc[ai][0][m][1] + bf4, o;
#pragma unroll
                        for (int i = 0; i < 4; ++i) o[i] = fminf(x[i], 0.f) - log1pf(expf(-fabsf(x[i])));
                        *(f32x4*)(LFo + (size_t)row * 4) = o; }
            }
        } else {
            const int ldz = (mode == 1) ? 3584 : ldc;
            float sc = 1.f; if (mode == 1) { sc = (u.pn < 2) ? 0.18033688011112042f   : ((u.pn == 8 || u.pn == 9) ? 0.08838834764831845f : 1.f); }
#pragma unroll
            for (int ai = 0; ai < 2; ++ai)
#pragma unroll
                for (int m = 0; m < 4; ++m) { bf16_t* rowp = (bf16_t*)O + (size_t)(row0 + ai * HALF + m * 16) * ldz + col0;
#pragma unroll
                    for (int bj = 0; bj < 2; ++bj) { f32x4 v0 = acc[ai][bj][m][0] * sc, v1 = acc[ai][bj][m][1] * sc;
                        u32x4 w; w.x = cvt_pk_bf16(v0[0], v0[1]); w.y = cvt_pk_bf16(v0[2], v0[3]); w.z = cvt_pk_bf16(v1[0], v1[1]); w.w = cvt_pk_bf16(v1[2], v1[3]);
                        *(u32x4*)(rowp + bj * HALF) = w; } }
        }
    }
    __device__ __forceinline__ void fused(f32x4 (&acc)[2][2][4][2], const Unit& u, int wr, int wc, int fr, int fq, PG8_LAS unsigned char* lds, int wid, int lane) const {}
};
template <class Epi, class Sched, bool ALIGN_EPI = false, bool SP2 = false>
__device__ __forceinline__ void gemm_phase(PG8_LAS unsigned char* lds, const Gemm g, const Sched& S, const Epi& E) {
    int tid_ = threadIdx.x; asm volatile("" : "+v"(tid_)); const int tid = tid_, wid = __builtin_amdgcn_readfirstlane(tid >> 6), lane = tid & 63, wr = wid >> 2, wc = wid & 3, fr = lane & 15, fq = lane >> 4;
    const int K = g.K, nt = K / BK;
    unsigned voffA[2], voffB[2];
#pragma unroll
    for (int i = 0; i < 2; ++i) { int R, C; stage_rc(tid * 16 + i * 8192, R, C); const int Rb = Epi::PERM ? ((R & ~31) + perm32(R & 31)) : R;
        voffA[i] = (unsigned)(R * K + C) * 2u; voffB[i] = (unsigned)(Rb * K + C) * 2u; }
    const size_t kstep = (size_t)(BK * 2);
    const size_t hstep = (size_t)HALF * K * 2;
    const size_t tstep = 2 * hstep;
    const unsigned ldsw = (unsigned)wid * 1024u;
    const int aoff = lds_byte(wr * 64 + fr, fq * 8), boff = lds_byte(wc * 32 + fr, fq * 8);
#define PG8_SA(b, h) (((b) * 2 + (h)) * HTB)
#define PG8_SB(b, h) ((4 + (b) * 2 + (h)) * HTB)
#define PG8_STAGE(bufoff, gbase, voff) do { _Pragma("unroll") for (int _i = 0; _i < 2; ++_i) \
        __builtin_amdgcn_global_load_lds((const unsigned*)((const char*)(gbase) + (voff)[_i]), (PG8_LAS unsigned*)(lds + (bufoff) + ldsw + _i * 8192), 16, 0, 0); } while (0)
#define PG8_LDA(dst, b, h) do { _Pragma("unroll") for (int m = 0; m < 4; ++m) _Pragma("unroll") for (int k = 0; k < 2; ++k) dst[m][k] = *(const PG8_LAS bf16x8*)(lds + PG8_SA(b, h) + aoff + m * 2048 + k * 1024); } while (0)
#define PG8_LDB(dst, b, h) do { _Pragma("unroll") for (int n = 0; n < 2; ++n) _Pragma("unroll") for (int k = 0; k < 2; ++k) dst[n][k] = *(const PG8_LAS bf16x8*)(lds + PG8_SB(b, h) + boff + n * 2048 + k * 1024); } while (0)
#define PG8_MMA(ai, bj, At, Bt) do { __builtin_amdgcn_s_setprio(1); _Pragma("unroll") for (int m = 0; m < 4; ++m) _Pragma("unroll") for (int n = 0; n < 2; ++n) _Pragma("unroll") for (int k = 0; k < 2; ++k) \
        acc[ai][bj][m][n] = __builtin_amdgcn_mfma_f32_16x16x32_bf16(Bt[n][k], At[m][k], acc[ai][bj][m][n], 0, 0, 0); __builtin_amdgcn_s_setprio(0); } while (0)
#define PG8_WAIT_V(n) asm volatile("s_waitcnt vmcnt(" #n ")" ::: "memory")
#define PG8_WAIT_L(n) asm volatile("s_waitcnt lgkmcnt(" #n ")" ::: "memory")
#define PG8_BAR __builtin_amdgcn_s_barrier()
#define PG8_SCHED __builtin_amdgcn_sched_barrier(0)
    Unit cur, nxt; int ui = 0;
    if (!S.next(0, cur)) return;
    f32x4 acc[2][2][4][2];
#pragma unroll
    for (int a = 0; a < 2; ++a)
#pragma unroll
        for (int b = 0; b < 2; ++b)
#pragma unroll
            for (int m = 0; m < 4; ++m)
#pragma unroll
                for (int n = 0; n < 2; ++n) acc[a][b][m][n] = (f32x4){0.f, 0.f, 0.f, 0.f};
    bf16x8 At[4][2], B0[2][2], B1[2][2];
    const char* cA = (const char*)g.A + (size_t)cur.pm * tstep; const char* cB = (const char*)g.Bt + (size_t)cur.pn * tstep;
    S.a_ready(cur);
    if constexpr (SP2) {
        PG8_STAGE(PG8_SB(0, 0), cB, voffB); PG8_STAGE(PG8_SB(0, 1), cB + hstep, voffB); PG8_STAGE(PG8_SA(0, 0), cA, voffA); PG8_STAGE(PG8_SA(0, 1), cA + hstep, voffA);
        if (wr == 1) PG8_BAR;
        PG8_WAIT_V(2); PG8_BAR;
        PG8_STAGE(PG8_SB(1, 0), cB + kstep, voffB); PG8_STAGE(PG8_SA(1, 0), cA + kstep, voffA); PG8_STAGE(PG8_SB(1, 1), cB + hstep + kstep, voffB);
        PG8_WAIT_V(6); PG8_BAR;
    } else {
        PG8_STAGE(PG8_SB(0, 0), cB, voffB); PG8_STAGE(PG8_SA(0, 0), cA, voffA); PG8_STAGE(PG8_SB(0, 1), cB + hstep, voffB); PG8_STAGE(PG8_SA(0, 1), cA + hstep, voffA);
        if (wr == 1) PG8_BAR;
        PG8_WAIT_V(4); PG8_BAR;
        PG8_STAGE(PG8_SB(1, 0), cB + kstep, voffB); PG8_STAGE(PG8_SA(1, 0), cA + kstep, voffA); PG8_STAGE(PG8_SB(1, 1), cB + hstep + kstep, voffB);
        PG8_WAIT_V(6); PG8_BAR;
    }
    for (;;) {
        const bool has_next = S.next(ui + 1, nxt);
        const char* nA = has_next ? (const char*)g.A + (size_t)nxt.pm * tstep : cA; const char* nB = has_next ? (const char*)g.Bt + (size_t)nxt.pn * tstep : cB;
        for (int t = 0; t < nt; t += 2) {
            const bool last = (t == nt - 2);
            const char* a1 = cA + (size_t)(t + 1) * kstep;
            const char* a2 = last ? nA : cA + (size_t)(t + 2) * kstep; const char* b2 = last ? nB : cB + (size_t)(t + 2) * kstep;
            const char* a3 = a2 + kstep; const char* b3 = b2 + kstep;
            if (last && has_next) S.a_ready(nxt);
            if constexpr (SP2) {
            PG8_LDB(B0, 0, 0); PG8_LDB(B1, 0, 1); PG8_SCHED; PG8_LDA(At, 0, 0); PG8_STAGE(PG8_SA(1, 1), a1 + hstep, voffA);
            PG8_WAIT_V(8); PG8_WAIT_L(0); PG8_BAR; PG8_MMA(0, 0, At, B0); PG8_MMA(0, 1, At, B1); PG8_BAR; PG8_SCHED;
            PG8_LDA(At, 0, 1); PG8_STAGE(PG8_SB(0, 0), b2, voffB); PG8_STAGE(PG8_SB(0, 1), b2 + hstep, voffB); PG8_STAGE(PG8_SA(0, 0), a2, voffA);
            PG8_WAIT_V(8); PG8_WAIT_L(0); PG8_BAR; PG8_MMA(1, 0, At, B0); PG8_MMA(1, 1, At, B1); PG8_BAR; PG8_SCHED;
            PG8_LDB(B0, 1, 0); PG8_LDB(B1, 1, 1); PG8_SCHED; PG8_LDA(At, 1, 0); PG8_STAGE(PG8_SA(0, 1), a2 + hstep, voffA);
            PG8_WAIT_V(8); PG8_WAIT_L(0); PG8_BAR; PG8_MMA(0, 0, At, B0); PG8_MMA(0, 1, At, B1); PG8_BAR; PG8_SCHED;
            PG8_LDA(At, 1, 1); PG8_STAGE(PG8_SB(1, 0), b3, voffB); PG8_STAGE(PG8_SB(1, 1), b3 + hstep, voffB); PG8_STAGE(PG8_SA(1, 0), a3, voffA);
            PG8_WAIT_V(8); PG8_WAIT_L(0); PG8_BAR; PG8_MMA(1, 0, At, B0); PG8_MMA(1, 1, At, B1); PG8_BAR; PG8_SCHED;
            } else {
            PG8_LDB(B0, 0, 0); PG8_SCHED; PG8_LDA(At, 0, 0); PG8_STAGE(PG8_SA(1, 1), a1 + hstep, voffA);
            PG8_WAIT_L(8); PG8_BAR; PG8_WAIT_L(0); PG8_MMA(0, 0, At, B0); PG8_BAR; PG8_SCHED;
            PG8_LDB(B1, 0, 1); PG8_STAGE(PG8_SB(0, 0), b2, voffB);
            PG8_BAR; PG8_WAIT_L(0); PG8_MMA(0, 1, At, B1); PG8_BAR;
            PG8_LDA(At, 0, 1); PG8_STAGE(PG8_SA(0, 0), a2, voffA);
            PG8_BAR; PG8_WAIT_L(0); PG8_MMA(1, 0, At, B0); PG8_BAR; PG8_SCHED;
            PG8_STAGE(PG8_SB(0, 1), b2 + hstep, voffB);
            PG8_WAIT_V(6); PG8_BAR; PG8_MMA(1, 1, At, B1); PG8_BAR;
            PG8_LDB(B0, 1, 0); PG8_SCHED; PG8_LDA(At, 1, 0); PG8_STAGE(PG8_SA(0, 1), a2 + hstep, voffA);
            PG8_WAIT_L(8); PG8_BAR; PG8_WAIT_L(0); PG8_MMA(0, 0, At, B0); PG8_BAR; PG8_SCHED;
            PG8_LDB(B1, 1, 1); PG8_STAGE(PG8_SB(1, 0), b3, voffB);
            PG8_BAR; PG8_WAIT_L(0); PG8_MMA(0, 1, At, B1); PG8_BAR;
            PG8_LDA(At, 1, 1); PG8_STAGE(PG8_SA(1, 0), a3, voffA);
            PG8_BAR; PG8_WAIT_L(0); PG8_MMA(1, 0, At, B0); PG8_BAR; PG8_SCHED;
            PG8_STAGE(PG8_SB(1, 1), b3 + hstep, voffB);
            PG8_WAIT_V(6); PG8_BAR; PG8_MMA(1, 1, At, B1); PG8_BAR;
            }
        }
        if constexpr (ALIGN_EPI) { if (wr == 0) PG8_BAR; }
        if constexpr (!Epi::AFTER_DRAIN) { E(acc, cur, wr, wc, fr, fq); S.done(cur); }
        if (!has_next) break;
#pragma unroll
        for (int a = 0; a < 2; ++a)
#pragma unroll
            for (int b = 0; b < 2; ++b)
#pragma unroll
                for (int m = 0; m < 4; ++m)
#pragma unroll
                    for (int n = 0; n < 2; ++n) acc[a][b][m][n] = (f32x4){0.f, 0.f, 0.f, 0.f};
        cur = nxt; cA = nA; cB = nB; ++ui;
        if constexpr (ALIGN_EPI) { if (wr == 1) PG8_BAR; }
    }
    PG8_WAIT_V(0);
    if constexpr (!ALIGN_EPI) { if (wr == 0) PG8_BAR; }
    PG8_BAR;
    if constexpr (Epi::AFTER_DRAIN) { E.fused(acc, cur, wr, wc, fr, fq, lds, wid, lane); S.done(cur); }
#undef PG8_SA
#undef PG8_SB
#undef PG8_STAGE
#undef PG8_LDA
#undef PG8_LDB
#undef PG8_MMA
#undef PG8_WAIT_V
#undef PG8_WAIT_L
#undef PG8_BAR
#undef PG8_SCHED
}
}
#define LAS __attribute__((address_space(3)))
#define DI __device__ __forceinline__
typedef unsigned short bf16;
typedef float f32x4 __attribute__((ext_vector_type(4)));
typedef float f32x16 __attribute__((ext_vector_type(16)));
typedef float f32x2 __attribute__((ext_vector_type(2)));
typedef unsigned u32x4 __attribute__((ext_vector_type(4)));
typedef unsigned u32x2 __attribute__((ext_vector_type(2)));
typedef short bf16x8 __attribute__((ext_vector_type(8)));
typedef short s16x4 __attribute__((ext_vector_type(4)));
typedef __bf16 bf16x2_t __attribute__((ext_vector_type(2)));

constexpr int NTHR = 512;
constexpr int DM = 1024, MPR = 16384, MVALID = 16512, MPAD = 16640, NZ = 3584, DIN = 3592, DFF = 2816, NU = 5632;
constexpr int SEQ = 8192;
constexpr float EPS = 1e-6f;
constexpr int LDS_BYTES = 147456 + 64;
constexpr size_t MiB = 1u << 20;
constexpr size_t WS_IG = 0, WS_LF = 512 * 1024, WS_BL = 1 * MiB, WS_AC = 1 * MiB + 8192, WS_MPREV = 1 * MiB + 16384, WS_NC = 2 * MiB, WS_NPREV = 3 * MiB;
constexpr size_t WS_BAR = 3 * MiB + 768 * 1024;
constexpr size_t WS_WIN = 4 * MiB, WS_WOUT = 11 * MiB + 512 * 1024, WS_WUP = 13 * MiB + 512 * 1024, WS_WDN = 24 * MiB + 512 * 1024;
constexpr size_t WS_ACT = 30 * MiB;
constexpr size_t WS_KC = 244 * MiB, WS_VC = 248 * MiB;
constexpr size_t WS_X16 = 63 * MiB;
constexpr size_t WS_R = 96 * MiB;
constexpr size_t WS_Z = WS_R, WS_SC = 210 * MiB;
constexpr size_t WS_MIX = WS_R;
constexpr size_t WS_UQ = WS_R, WS_G = 141 * MiB;
constexpr size_t WS_FFN = WS_R;
constexpr size_t WS_END = 256 * MiB;
static_assert(WS_Z + (size_t)MPAD * NZ * 2 <= WS_SC && WS_SC + (size_t)1056 * 32768 <= WS_KC && WS_X16 + (size_t)MVALID * DM * 2 <= WS_R, "ws stage 1");
static_assert(WS_UQ + (size_t)(MPAD / 4) * NU * 2 <= WS_G && WS_G + (size_t)MPAD * DFF * 2 <= WS_KC, "ws stage 3");
static_assert(WS_ACT + (size_t)MPAD * DM * 2 <= WS_X16 && WS_WDN + (size_t)DM * DFF * 2 <= WS_ACT, "ws fixed");
constexpr size_t O_X = 0, O_KP = 16908288, O_VP = O_KP + 1048576, O_CP = O_VP + 1048576, O_NP = O_CP + 262144, O_MP = O_NP + 2048, O_FP = O_MP + 16,
                 O_KS = O_FP + 45056, O_VS = O_KS + 131072, O_CS = O_VS + 131072, O_NS = O_CS + 1048576, O_MS = O_NS + 8192, O_FS = O_MS + 64, O_END = O_FS + 180224;

DI unsigned pk2(float lo, float hi) { f32x2 v = {lo, hi}; bf16x2_t b = __builtin_convertvector(v, bf16x2_t); return __builtin_bit_cast(unsigned, b); }
DI float bf2f(unsigned short b) { return __uint_as_float((unsigned)b << 16); }
DI float bflo(unsigned w) { return __uint_as_float(w << 16); }
DI float bfhi(unsigned w) { return __uint_as_float(w & 0xffff0000u); }
DI float wave_sum(float v) {
#pragma unroll
    for (int o = 1; o < 64; o <<= 1) v += __shfl_xor(v, o);
    return v;
}
DI float wave_max(float v) {
#pragma unroll
    for (int o = 1; o < 64; o <<= 1) v = fmaxf(v, __shfl_xor(v, o));
    return v;
}
#define MFMA32(a, b, c) __builtin_amdgcn_mfma_f32_32x32x16_bf16((a), (b), (c), 0, 0, 0)
DI s16x4 vtr(const LAS char* p) { return __builtin_bit_cast(s16x4, __builtin_amdgcn_ds_read_tr16_b64_v4i16((LAS s16x4*)p)); }
DI bf16x8 vtr2(const LAS char* p, int rows4_bytes) { s16x4 lo = vtr(p), hi = vtr(p + rows4_bytes); return __builtin_shufflevector(lo, hi, 0, 1, 2, 3, 4, 5, 6, 7); }
DI int crow(int i, int h) { return (i & 3) + 8 * (i >> 2) + 4 * h; }
DI bf16x8 pack8(const f32x16& x, int s) {
    u32x4 p; p.x = pk2(x[8 * s], x[8 * s + 1]); p.y = pk2(x[8 * s + 2], x[8 * s + 3]); p.z = pk2(x[8 * s + 4], x[8 * s + 5]); p.w = pk2(x[8 * s + 6], x[8 * s + 7]);
    return __builtin_bit_cast(bf16x8, p);
}
DI f32x16 zero16() { f32x16 z;
#pragma unroll
    for (int i = 0; i < 16; ++i) z[i] = 0.f; return z; }
#define LDS_FENCE() asm volatile("s_waitcnt lgkmcnt(0)" ::: "memory")

struct Args { const float* in[20]; float* out; unsigned char* ws; };
typedef const __attribute__((address_space(4))) Args* ArgsP;
DI ArgsP get_args() { ArgsP p = (ArgsP)__builtin_amdgcn_kernarg_segment_ptr(); asm volatile("" : "+s"(p)); return p; }
DI int get_bid() { int b = blockIdx.x; asm volatile("" : "+s"(b)); return b; }
DI int get_nb() { int b = gridDim.x; asm volatile("" : "+s"(b)); return b; }
DI int get_tid() { int t = threadIdx.x; asm volatile("" : "+v"(t)); return t; }

DI void transpose_item(const float* W, int ldw, int K, int nblk, bf16* WT, LAS float* scr, int item, int lane, bool perm_up = false, int cmax = (1 << 30)) {
    const int kb = item / nblk, nb = item % nblk, k0 = 64 * kb, n0 = 32 * nb;
    const int r0 = !perm_up ? n0 : (n0 < DFF ? 256 * (n0 >> 7) + (n0 & 127) : 256 * ((n0 - DFF) >> 7) + 128 + ((n0 - DFF) & 127));
    { int col0 = n0 + (lane & 7) * 4; col0 = col0 + 3 <= cmax ? col0 : cmax - 3;
      f32x4 v[8];
#pragma unroll
      for (int i = 0; i < 8; ++i) v[i] = *(const f32x4*)(W + (size_t)(k0 + 8 * i + (lane >> 3)) * ldw + col0);
#pragma unroll
      for (int i = 0; i < 8; ++i) { const int kk = 8 * i + (lane >> 3); LAS float* d = scr + kk * 33 + (lane & 7) * 4; d[0] = v[i].x; d[1] = v[i].y; d[2] = v[i].z; d[3] = v[i].w; } }
    LDS_FENCE();
    const int c = lane & 7;
#pragma unroll
    for (int j = 0; j < 4; ++j) { const int n = (lane >> 3) + 8 * j; const LAS float* s = scr + (8 * c) * 33 + n;
        u32x4 o; o.x = pk2(s[0 * 33], s[1 * 33]); o.y = pk2(s[2 * 33], s[3 * 33]); o.z = pk2(s[4 * 33], s[5 * 33]); o.w = pk2(s[6 * 33], s[7 * 33]);
        *(u32x4*)(WT + (size_t)(r0 + n) * K + k0 + 8 * c) = o; }
    LDS_FENCE();
}
DI void phase_convert(int l, LAS unsigned char* lds) {
    const ArgsP a = get_args(); const int tid = get_tid(), lane = tid & 63, wave = tid >> 6;
    LAS float* scr = (LAS float*)(lds + wave * 8448);
    const int gw = get_bid() * 8 + wave, NGW = get_nb() * 8;
    constexpr int I_IN = 16 * 113, I_OUT = 16 * 32, I_UP = 16 * 176, I_DN = 44 * 32;
    const float* win = a->in[9] + (size_t)l * DM * DIN; const float* wout = a->in[15] + (size_t)l * DM * DM;
    const float* wup = a->in[16] + (size_t)l * DM * NU; const float* wdn = a->in[19] + (size_t)l * DFF * DM;
    for (int it = gw; it < I_IN + I_OUT + I_UP + I_DN; it += NGW) {
        int r = it;
        if (r < I_IN) { transpose_item(win, DIN, DM, 113, (bf16*)(a->ws + WS_WIN), scr, r, lane, false, DIN - 1); continue; } r -= I_IN;
        if (r < I_OUT) { transpose_item(wout, DM, DM, 32, (bf16*)(a->ws + WS_WOUT), scr, r, lane); continue; } r -= I_OUT;
        if (r < I_UP) { transpose_item(wup, NU, DM, 176, (bf16*)(a->ws + WS_WUP), scr, r, lane, true); continue; } r -= I_UP;
        transpose_item(wdn, DM, DFF, 32, (bf16*)(a->ws + WS_WDN), scr, r, lane);
    }
    {   const int gt0 = get_bid() * NTHR + tid, gstep = get_nb() * NTHR;
        for (int it0 = gt0; it0 < 2 * 262144; it0 += 4 * gstep) {
            f32x4 x0[4], x1[4];
#pragma unroll
            for (int k = 0; k < 4; ++k) { const int it = it0 + k * gstep; if (it < 2 * 262144) { const int kv = it >> 18, e = (it & 262143) * 8; const float* src = a->in[2 + kv] + (size_t)l * 2097152 + e; x0[k] = *(const f32x4*)src; x1[k] = *(const f32x4*)(src + 4); } }
#pragma unroll
            for (int k = 0; k < 4; ++k) { const int it = it0 + k * gstep; if (it < 2 * 262144) { const int kv = it >> 18, e = (it & 262143) * 8;
                u32x4 w; w.x = pk2(x0[k].x, x0[k].y); w.y = pk2(x0[k].z, x0[k].w); w.z = pk2(x1[k].x, x1[k].y); w.w = pk2(x1[k].z, x1[k].w);
                *(u32x4*)((bf16*)(a->ws + (kv ? WS_VC : WS_KC)) + e) = w; } }
        } }
}

DI void phase_rows(LAS unsigned char* lds, bool first, const bf16* addsrc, const float* gadd, const float* gn, int gate_layer  , bool final) {
    const ArgsP a = get_args(); const int tid = get_tid(), lane = tid & 63, wave = tid >> 6;
    float* Y = a->out; bf16* X16 = (bf16*)(a->ws + WS_X16); bf16* ACT = (bf16*)(a->ws + WS_ACT);
    const int gw = get_bid() * 8 + wave, NGW = get_nb() * 8;
    float ga[16], gb[16];
#pragma unroll
    for (int j = 0; j < 2; ++j)
#pragma unroll
        for (int k = 0; k < 8; ++k) { ga[8 * j + k] = addsrc ? gadd[8 * lane + 512 * j + k] : 0.f; gb[8 * j + k] = gn ? gn[8 * lane + 512 * j + k] : 0.f; }
#define ROWS_LOAD(MM, VV, XX, FF) do { const int mm_ = (MM); \
        if (first) { const float* xr_ = mm_ < MPR ? a->in[0] + (size_t)mm_ * DM : a->in[1] + (size_t)(mm_ - MPR) * DM; \
            _Pragma("unroll") for (int j = 0; j < 2; ++j) { VV[2 * j] = *(const f32x4*)(xr_ + 8 * lane + 512 * j); VV[2 * j + 1] = *(const f32x4*)(xr_ + 8 * lane + 512 * j + 4); } } \
        else { _Pragma("unroll") for (int j = 0; j < 2; ++j) XX[j] = *(const u32x4*)(X16 + (size_t)mm_ * DM + 8 * lane + 512 * j); } \
        if (addsrc) { _Pragma("unroll") for (int j = 0; j < 2; ++j) FF[j] = *(const u32x4*)(addsrc + (size_t)mm_ * DM + 8 * lane + 512 * j); } } while (0)
    f32x4 vn[4], vn2[4]; u32x4 xn[2], fn[2], xn2[2], fn2[2];
#pragma unroll
    for (int j = 0; j < 4; ++j) { vn[j] = (f32x4){0.f, 0.f, 0.f, 0.f}; vn2[j] = vn[j]; }
#pragma unroll
    for (int j = 0; j < 2; ++j) { xn[j] = (u32x4){0u, 0u, 0u, 0u}; fn[j] = xn[j]; xn2[j] = xn[j]; fn2[j] = xn[j]; }
    if (gw < MVALID) ROWS_LOAD(gw, vn, xn, fn);
    if (gw + NGW < MVALID) ROWS_LOAD(gw + NGW, vn2, xn2, fn2);
    for (int m = gw; m < MVALID; m += NGW) {
        float v[16], f[16];
#pragma unroll
        for (int j = 0; j < 2; ++j) {
            if (first) {
#pragma unroll
                for (int k = 0; k < 4; ++k) { v[8 * j + k] = vn[2 * j][k]; v[8 * j + 4 + k] = vn[2 * j + 1][k]; }
            } else { v[8 * j] = bflo(xn[j].x); v[8 * j + 1] = bfhi(xn[j].x); v[8 * j + 2] = bflo(xn[j].y); v[8 * j + 3] = bfhi(xn[j].y); v[8 * j + 4] = bflo(xn[j].z); v[8 * j + 5] = bfhi(xn[j].z); v[8 * j + 6] = bflo(xn[j].w); v[8 * j + 7] = bfhi(xn[j].w); }
            f[8 * j] = bflo(fn[j].x); f[8 * j + 1] = bfhi(fn[j].x); f[8 * j + 2] = bflo(fn[j].y); f[8 * j + 3] = bfhi(fn[j].y); f[8 * j + 4] = bflo(fn[j].z); f[8 * j + 5] = bfhi(fn[j].z); f[8 * j + 6] = bflo(fn[j].w); f[8 * j + 7] = bfhi(fn[j].w);
        }
#pragma unroll
        for (int j = 0; j < 4; ++j) vn[j] = vn2[j];
#pragma unroll
        for (int j = 0; j < 2; ++j) { xn[j] = xn2[j]; fn[j] = fn2[j]; }
        if (m + 2 * NGW < MVALID) ROWS_LOAD(m + 2 * NGW, vn2, xn2, fn2);
        if (addsrc) {
            float s = 0.f;
#pragma unroll
            for (int k = 0; k < 16; ++k) s += f[k] * f[k];
            const float r = 1.0f / sqrtf(wave_sum(s) * (1.f / DM) + EPS);
#pragma unroll
            for (int k = 0; k < 16; ++k) v[k] = v[k] + f[k] * r * ga[k];
#pragma unroll
            for (int j = 0; j < 2; ++j) {
                if (final) { float* yp = Y + (size_t)m * DM + 8 * lane + 512 * j; *(f32x4*)yp = (f32x4){v[8 * j], v[8 * j + 1], v[8 * j + 2], v[8 * j + 3]}; *(f32x4*)(yp + 4) = (f32x4){v[8 * j + 4], v[8 * j + 5], v[8 * j + 6], v[8 * j + 7]}; }
                else { u32x4 o; o.x = pk2(v[8 * j], v[8 * j + 1]); o.y = pk2(v[8 * j + 2], v[8 * j + 3]); o.z = pk2(v[8 * j + 4], v[8 * j + 5]); o.w = pk2(v[8 * j + 6], v[8 * j + 7]); *(u32x4*)(X16 + (size_t)m * DM + 8 * lane + 512 * j) = o; } }
        }
        if (gn) {
            float s = 0.f;
#pragma unroll
            for (int k = 0; k < 16; ++k) s += v[k] * v[k];
            const float r = 1.0f / sqrtf(wave_sum(s) * (1.f / DM) + EPS);
#pragma unroll
            for (int j = 0; j < 2; ++j) { u32x4 o;
                o.x = pk2(v[8 * j] * r * gb[8 * j], v[8 * j + 1] * r * gb[8 * j + 1]); o.y = pk2(v[8 * j + 2] * r * gb[8 * j + 2], v[8 * j + 3] * r * gb[8 * j + 3]);
                o.z = pk2(v[8 * j + 4] * r * gb[8 * j + 4], v[8 * j + 5] * r * gb[8 * j + 5]); o.w = pk2(v[8 * j + 6] * r * gb[8 * j + 6], v[8 * j + 7] * r * gb[8 * j + 7]);
                *(u32x4*)(ACT + (size_t)m * DM + 8 * lane + 512 * j) = o; }
        }
    }
#undef ROWS_LOAD
}

DI void mini_gemm(LAS unsigned char* lds, const bf16* A, const bf16* Bt, int K, bf16* O) {
    const int tid = get_tid(), lane = tid & 63, wave = tid >> 6, fr = lane & 15, fq = lane >> 4;
    LAS float* red = (LAS float*)lds;
    const int ksl = K >> 3, k0 = wave * ksl, nks = ksl >> 5;
    for (int unit = get_bid(); unit < 256; unit += get_nb()) {
        const int rt = unit >> 5, ct = unit & 31;
        const bf16* ap = A + (size_t)(rt * 16 + fr) * K + k0 + 8 * fq;
        const bf16* bp0 = Bt + (size_t)(ct * 32 + fr) * K + k0 + 8 * fq; const bf16* bp1 = bp0 + (size_t)16 * K;
        f32x4 acc0 = {0.f, 0.f, 0.f, 0.f}, acc1 = {0.f, 0.f, 0.f, 0.f};
#pragma unroll 4
        for (int ks = 0; ks < nks; ++ks) { const bf16x8 av = *(const bf16x8*)(ap + 32 * ks), b0 = *(const bf16x8*)(bp0 + 32 * ks), b1 = *(const bf16x8*)(bp1 + 32 * ks);
            acc0 = __builtin_amdgcn_mfma_f32_16x16x32_bf16(av, b0, acc0, 0, 0, 0); acc1 = __builtin_amdgcn_mfma_f32_16x16x32_bf16(av, b1, acc1, 0, 0, 0); }
#pragma unroll
        for (int j = 0; j < 4; ++j) { red[(wave * 2 + 0) * 256 + j * 64 + lane] = acc0[j]; red[(wave * 2 + 1) * 256 + j * 64 + lane] = acc1[j]; }
        __syncthreads();
        { const int n = tid >> 8, idx = tid & 255, j = idx >> 6, ln = idx & 63; float s = 0.f;
#pragma unroll
          for (int w = 0; w < 8; ++w) s += red[(w * 2 + n) * 256 + idx];
          O[(size_t)(rt * 16 + 4 * (ln >> 4) + j) * DM + ct * 32 + 16 * n + (ln & 15)] = (bf16)(pk2(s, 0.f) & 0xffffu); }
        __syncthreads();
    }
}

constexpr int VP = 144;
DI void attn_step(const bf16x8 (&kf)[4], const bf16x8 (&qf)[4], f32x16 (&O)[2], float& mrun, float& lrun, const LAS float* tab, float bias_far, bool nearb, int dq  , int maskfrom  ,
                  const LAS char* vs, int kb, int h, int q4, int p4, int blk) {
    bf16x8 vf0[2], vf1[2];
#pragma unroll
    for (int dt = 0; dt < 2; ++dt) {
        vf0[dt] = vtr2(vs + (kb + 4 * h + q4) * VP + 2 * (32 * dt + 16 * blk) + 8 * p4, 8 * VP);
        vf1[dt] = vtr2(vs + (kb + 16 + 4 * h + q4) * VP + 2 * (32 * dt + 16 * blk) + 8 * p4, 8 * VP); }
    f32x16 S = zero16();
#pragma unroll
    for (int s = 0; s < 4; ++s) S = MFMA32(kf[s], qf[s], S);
    if (nearb) {
#pragma unroll
        for (int i = 0; i < 16; ++i) { int d = dq - ((i & 3) + 8 * (i >> 2)); d = d > 256 ? 256 : d; S[i] += tab[d + 63]; }
    } else {
#pragma unroll
        for (int i = 0; i < 16; ++i) S[i] += bias_far;
    }
    if (maskfrom < 64) {
#pragma unroll
        for (int i = 0; i < 16; ++i) if ((i & 3) + 8 * (i >> 2) + 4 * h >= maskfrom) S[i] = -1e30f;
    }
    float mx = S[0];
#pragma unroll
    for (int i = 1; i < 16; ++i) mx = fmaxf(mx, S[i]);
    mx = fmaxf(mx, __shfl_xor(mx, 32));
    const float mnew = fmaxf(mrun, mx), alpha = __builtin_amdgcn_exp2f(mrun - mnew);
    float rs = 0.f;
#pragma unroll
    for (int i = 0; i < 16; ++i) { S[i] = __builtin_amdgcn_exp2f(S[i] - mnew); rs += S[i]; }
    lrun = lrun * alpha + rs;
    if (__builtin_amdgcn_ballot_w64(mnew > mrun)) { O[0] *= alpha; O[1] *= alpha; }
    mrun = mnew;
    const bf16x8 pf0 = pack8(S, 0), pf1 = pack8(S, 1);
#pragma unroll
    for (int dt = 0; dt < 2; ++dt) { O[dt] = MFMA32(vf0[dt], pf0, O[dt]); O[dt] = MFMA32(vf1[dt], pf1, O[dt]); }
}
template <bool SAMPLE>
DI void attn_unit(int l, int bb, int c, int qhalf, LAS unsigned char* lds) {
    const ArgsP a = get_args(); const int tid = get_tid(), lane = tid & 63, hd = tid >> 6, r = lane & 31, h = lane >> 5;
    const int i16 = lane & 15, q4 = i16 >> 2, p4 = i16 & 3, blk = (lane >> 4) & 1;
    const bf16* Z = (const bf16*)(a->ws + WS_Z); bf16* ACT = (bf16*)(a->ws + WS_ACT);
    LAS char* vs = (LAS char*)(lds + hd * 9216);
    const LAS float* tab = (const LAS float*)(lds + 73728 + hd * 1280);
    LAS float* xs = (LAS float*)(lds + 73728 + 10240);
    const int qrow0 = SAMPLE ? MPR + bb * 16 : bb * SEQ + c * 64;
    const bf16* kc16 = (const bf16*)(a->ws + WS_KC) + (size_t)(bb * 8 + hd) * 512 * 64;
    const bf16* vc16 = (const bf16*)(a->ws + WS_VC) + (size_t)(bb * 8 + hd) * 512 * 64;
    bf16x8 qf[4];
    { const int qr = SAMPLE ? (r < 16 ? r : 15) : 32 * qhalf + r;
#pragma unroll
      for (int s = 0; s < 4; ++s) qf[s] = *(const bf16x8*)(Z + (size_t)(qrow0 + qr) * NZ + hd * 64 + 16 * s + 8 * h); }
    f32x16 O[2]; O[0] = zero16(); O[1] = zero16(); float mrun = -1e30f, lrun = 0.f;
    const float bias_far = tab[319];
    const int q = 32 * qhalf + r;
    const int jstart = SAMPLE ? 0 : (c >= 8 ? 0 : 8 - c);
#define ATT_SRC(J) const bf16* kb_; const bf16* vb_; int pitch_, rmax_; \
    if (SAMPLE && (J) < 8) { kb_ = kc16 + (size_t)(64 * (J)) * 64; vb_ = vc16 + (size_t)(64 * (J)) * 64; pitch_ = 64; rmax_ = 63; } \
    else if (SAMPLE) { kb_ = Z + (size_t)qrow0 * NZ + 512 + hd * 64; vb_ = kb_ + 512; pitch_ = NZ; rmax_ = 15; } \
    else { kb_ = Z + (size_t)(bb * SEQ + (c + (J) - 8) * 64) * NZ + 512 + hd * 64; vb_ = kb_ + 512; pitch_ = NZ; rmax_ = 63; }
#define ATT_LOADK(J, KS, KF) do { ATT_SRC(J) int kr_ = 32 * (KS) + r; kr_ = kr_ > rmax_ ? rmax_ : kr_; (void)vb_; \
    _Pragma("unroll") for (int s = 0; s < 4; ++s) KF[s] = *(const bf16x8*)(kb_ + (size_t)kr_ * pitch_ + 16 * s + 8 * h); } while (0)
#define ATT_LOADV(J, VR) do { ATT_SRC(J) (void)kb_; \
    _Pragma("unroll") for (int it = 0; it < 8; ++it) { int key_ = it * 8 + (lane >> 3); key_ = key_ > rmax_ ? rmax_ : key_; VR[it] = *(const u32x4*)(vb_ + (size_t)key_ * pitch_ + (lane & 7) * 8); } } while (0)
    bf16x8 kA[4], kB[4]; u32x4 vr[8];
    ATT_LOADK(jstart, 0, kA);
    ATT_LOADV(jstart, vr);
#pragma unroll 1
    for (int j = jstart; j < 9; ++j) {
        LDS_FENCE();
#pragma unroll
        for (int it = 0; it < 8; ++it) *(LAS u32x4*)(vs + (it * 8 + (lane >> 3)) * VP + (lane & 7) * 16) = vr[it];
        if (j < 8) ATT_LOADV(j + 1, vr);
        ATT_LOADK(j, 1, kB);
        LDS_FENCE();
        const bool nearb = j >= 4; const int mf = (SAMPLE && j == 8) ? 16 : 64;
        attn_step(kA, qf, O, mrun, lrun, tab, bias_far, nearb, 512 + q - (64 * j + 4 * h), mf, vs, 0, h, q4, p4, blk);
        if (j < 8) ATT_LOADK(j + 1, 0, kA);
        if (!(SAMPLE && j == 8)) attn_step(kB, qf, O, mrun, lrun, tab, bias_far, nearb, 512 + q - (64 * j + 32 + 4 * h), 64, vs, 32, h, q4, p4, blk);
    }
#undef ATT_SRC
#undef ATT_LOADK
#undef ATT_LOADV
    const float lt = lrun + __shfl_xor(lrun, 32); const float inv = 1.0f / lt; float ssq = 0.f;
#pragma unroll
    for (int dt = 0; dt < 2; ++dt) { O[dt] *= inv;
#pragma unroll
        for (int i = 0; i < 16; ++i) ssq += O[dt][i] * O[dt][i]; }
    ssq += __shfl_xor(ssq, 32);
    if (h == 0) xs[hd * 64 + 32 * qhalf + r] = ssq;
    __syncthreads();
    const float* gatt = a->in[13] + l * 512 + hd * 64;
    float tot = 0.f;
#pragma unroll
    for (int w = 0; w < 8; ++w) tot += xs[w * 64 + 32 * qhalf + r];
    const float rr = 1.0f / sqrtf(tot * (1.f / 512.f) + EPS);
    const bool ok = SAMPLE ? (r < 16) : true;
    bf16* orow = ACT + (size_t)(qrow0 + 32 * qhalf + r) * DM + hd * 64;
    if (ok) {
#pragma unroll
        for (int dt = 0; dt < 2; ++dt)
#pragma unroll
            for (int g = 0; g < 4; ++g) { const int e0 = 32 * dt + 8 * g + 4 * h; const f32x4 gv = *(const f32x4*)(gatt + e0);
                u32x2 o; o.x = pk2(O[dt][4 * g] * rr * gv.x, O[dt][4 * g + 1] * rr * gv.y); o.y = pk2(O[dt][4 * g + 2] * rr * gv.z, O[dt][4 * g + 3] * rr * gv.w);
                *(u32x2*)(orow + e0) = o; }
    }
    __syncthreads();
}

constexpr int MPB = 288;
DI void m1_item(bool sample, int bb, int c, LAS unsigned char* lds, int hp = -1  ) {
    const ArgsP a = get_args(); const int tid = get_tid(), lane = tid & 63, wave = tid >> 6, head = wave >> 1, half = wave & 1, r = lane & 31, h = lane >> 5;
    const int i16 = lane & 15, q4 = i16 >> 2, p4 = i16 & 3, blk = (lane >> 4) & 1;
    const bf16* Z = (const bf16*)(a->ws + WS_Z); const float* IG = (const float*)(a->ws + WS_IG); const float* LF = (const float*)(a->ws + WS_LF);
    bf16* SC = (bf16*)(a->ws + WS_SC);
    const int row0 = sample ? MPR + bb * 16 : bb * SEQ + c * 64;
    const int u = sample ? 1024 + bb * 4 + head : (bb * 4 + head) * 128 + c;
    const bool act = (hp < 0) || ((head >> 1) == hp);
    u32x4 st16[16];
#pragma unroll
    for (int it = 0; it < 16; ++it) { const int rr = it * 4 + (lane >> 4), ch = lane & 15; const int srow = row0 + (sample ? (rr < 16 ? rr : 15) : rr);
        st16[it] = *(const u32x4*)(Z + (size_t)srow * NZ + (half == 0 ? 2048 : 2560) + head * 128 + ch * 8); }
    const bool valid = sample ? (lane < 16) : true;
    const int rs = row0 + (sample ? (lane < 16 ? lane : 15) : lane);
    float b = valid ? LF[(size_t)rs * 4 + head] : 0.f; const float ig = valid ? IG[(size_t)rs * 4 + head] : -INFINITY;
#pragma unroll
    for (int o = 1; o < 64; o <<= 1) { const float t = __shfl_up(b, o); if (lane >= o) b += t; }
    const float av = ig - b; const float ac = wave_max(av); const float w = __expf(av - ac); const float bl = __shfl(b, 63);
    if (act && half == 0 && lane == 0) { ((float*)(a->ws + WS_BL))[u] = bl; ((float*)(a->ws + WS_AC))[u] = ac; }
    LAS char* kbase = (LAS char*)(lds + head * 36864); LAS char* vbase = kbase + 18432;
#pragma unroll
    for (int it = 0; it < 16; ++it) { const int rr = it * 4 + (lane >> 4), ch = lane & 15;
        const float wr = __shfl(w, rr); const u32x4 x = st16[it];
        if (half == 0) { u32x4 o;
            o.x = pk2(bflo(x.x) * wr, bfhi(x.x) * wr); o.y = pk2(bflo(x.y) * wr, bfhi(x.y) * wr); o.z = pk2(bflo(x.z) * wr, bfhi(x.z) * wr); o.w = pk2(bflo(x.w) * wr, bfhi(x.w) * wr);
            *(LAS u32x4*)(kbase + rr * MPB + ch * 16) = o; }
        else *(LAS u32x4*)(vbase + rr * MPB + ch * 16) = x;
    }
    __syncthreads();
    if (act) {
#pragma unroll
    for (int dh = 0; dh < 2; ++dh) {
        f32x16 acc[2][2];
#pragma unroll
        for (int di = 0; di < 2; ++di) { acc[di][0] = zero16(); acc[di][1] = zero16(); }
#pragma unroll
        for (int ks = 0; ks < 4; ++ks) {
            bf16x8 af[2], bfr[2];
#pragma unroll
            for (int di = 0; di < 2; ++di) af[di] = vtr2(kbase + (16 * ks + 8 * h + q4) * MPB + 2 * (32 * (2 * dh + di) + 16 * blk) + 8 * p4, 4 * MPB);
#pragma unroll
            for (int ei = 0; ei < 2; ++ei) bfr[ei] = vtr2(vbase + (16 * ks + 8 * h + q4) * MPB + 2 * (32 * (2 * half + ei) + 16 * blk) + 8 * p4, 4 * MPB);
#pragma unroll
            for (int di = 0; di < 2; ++di)
#pragma unroll
                for (int ei = 0; ei < 2; ++ei) acc[di][ei] = MFMA32(af[di], bfr[ei], acc[di][ei]);
        }
#pragma unroll
        for (int di = 0; di < 2; ++di)
#pragma unroll
            for (int ei = 0; ei < 2; ++ei)
#pragma unroll
                for (int g = 0; g < 4; ++g) { const int e = 32 * (2 * half + ei) + r, d0 = 32 * (2 * dh + di) + 8 * g + 4 * h;
                    u32x2 o; o.x = pk2(acc[di][ei][4 * g], acc[di][ei][4 * g + 1]); o.y = pk2(acc[di][ei][4 * g + 2], acc[di][ei][4 * g + 3]);
                    *(u32x2*)(SC + (size_t)u * 16384 + e * 128 + d0) = o; }
    }
    { const int d = half * 64 + lane; float s = 0.f;
#pragma unroll 8
      for (int sidx = 0; sidx < 64; ++sidx) s += bf2f(*(const LAS unsigned short*)(kbase + sidx * MPB + d * 2));
      ((float*)(a->ws + WS_NC))[(size_t)u * 128 + d] = s; }
    }
    __syncthreads();
}

DI void phase_c_pre(int l) {
    const ArgsP a = get_args(); const int tid = get_tid();
    const bf16* Z = (const bf16*)(a->ws + WS_Z);
    for (int it = get_bid() * NTHR + tid; it < 147456; it += get_nb() * NTHR) {
        int row, kv, cc; float* dst;
        if (it < 131072) { const int b = it >> 16, t = (it >> 7) & 511; kv = (it >> 6) & 1; cc = it & 63; row = b * SEQ + (SEQ - 512) + t;
            dst = a->out + (kv ? O_VP : O_KP) + ((size_t)((l * 2 + b) * 8 + (cc >> 3)) * 512 + t) * 64 + (cc & 7) * 8; }
        else { const int i2 = it - 131072; const int rr = i2 >> 7; kv = (i2 >> 6) & 1; cc = i2 & 63; row = MPR + rr; const int sb = rr >> 4, t = rr & 15;
            dst = a->out + (kv ? O_VS : O_KS) + ((size_t)((l * 8 + sb) * 8 + (cc >> 3)) * 16 + t) * 64 + (cc & 7) * 8; }
        const u32x4 x = *(const u32x4*)(Z + (size_t)row * NZ + 512 + kv * 512 + cc * 8);
        f32x4 o0 = {bflo(x.x), bfhi(x.x), bflo(x.y), bfhi(x.y)}, o1 = {bflo(x.z), bfhi(x.z), bflo(x.w), bfhi(x.w)};
        *(f32x4*)dst = o0; *(f32x4*)(dst + 4) = o1;
    }
}

DI void phase_m2(int l, LAS unsigned char* lds) {
    const ArgsP a = get_args(); const int tid = get_tid(), lane = tid & 63;
    bf16* SC = (bf16*)(a->ws + WS_SC); const float* BL = (const float*)(a->ws + WS_BL); const float* AC = (const float*)(a->ws + WS_AC);
    float* MPREV = (float*)(a->ws + WS_MPREV); const float* NC = (const float*)(a->ws + WS_NC); float* NPREV = (float*)(a->ws + WS_NPREV);
    LAS float* DEC = (LAS float*)lds; LAS float* SCL = DEC + 128;
    const int NTH = get_nb() * NTHR;
    for (int base = get_bid() * NTHR; base < 8 * 16384; base += NTH) {
        const int bh = base >> 14, el = (base & 16383) + tid; const bool doN = el < 128;
        __syncthreads();
        if (tid < 64) {
            float Fc = 0.f, gc = 0.f;
#pragma unroll
            for (int rd = 0; rd < 2; ++rd) {
                const int c = rd * 64 + lane, u = bh * 128 + c; const float bl = BL[u], ac = AC[u];
                float F = bl;
#pragma unroll
                for (int o = 1; o < 64; o <<= 1) { const float t = __shfl_up(F, o); if (lane >= o) F += t; }
                F += Fc;
                float Fm1 = __shfl_up(F, 1); if (lane == 0) Fm1 = Fc;
                float g = ac - Fm1;
#pragma unroll
                for (int o = 1; o < 64; o <<= 1) { const float t = __shfl_up(g, o); if (lane >= o) g = fmaxf(g, t); }
                g = fmaxf(g, gc);
                float gm1 = __shfl_up(g, 1); if (lane == 0) gm1 = gc;
                const float mprev = Fm1 + gm1, mnew = F + g;
                DEC[c] = expf(bl + mprev - mnew); SCL[c] = expf(bl + ac - mnew);
                if ((base & 16383) == 0) { MPREV[u] = mprev; if (c == 127) a->out[O_MP + l * 8 + bh] = mnew; }
                Fc = __shfl(F, 63); gc = __shfl(g, 63);
            }
        }
        __syncthreads();
        float C = 0.f, n = 0.f;
#pragma unroll 1
        for (int c0 = 0; c0 < 128; c0 += 32) {
            float s[32];
#pragma unroll
            for (int k = 0; k < 32; ++k) s[k] = bf2f(SC[(size_t)(bh * 128 + c0 + k) * 16384 + el]);
            if (doN) {
                float nc[32];
#pragma unroll
                for (int k = 0; k < 32; ++k) nc[k] = NC[(size_t)(bh * 128 + c0 + k) * 128 + el];
#pragma unroll
                for (int k = 0; k < 32; ++k) { NPREV[(size_t)(bh * 128 + c0 + k) * 128 + el] = n; n = DEC[c0 + k] * n + SCL[c0 + k] * nc[k]; }
            }
#pragma unroll
            for (int k = 0; k < 32; ++k) { SC[(size_t)(bh * 128 + c0 + k) * 16384 + el] = (bf16)(pk2(C, 0.f) & 0xffffu); C = DEC[c0 + k] * C + SCL[c0 + k] * s[k]; }
        }
        const int e = el >> 7, d = el & 127;
        a->out[O_CP + (size_t)(l * 8 + bh) * 16384 + d * 128 + e] = C;
        if (doN) a->out[O_NP + (size_t)(l * 8 + bh) * 128 + el] = n;
    }
}

DI void m3_item(int l, bool sample, int bb, int c, LAS unsigned char* lds, int hp = -1) {
    const ArgsP a = get_args(); const int tid = get_tid(), lane = tid & 63, wave = tid >> 6, head = wave >> 1, tt = wave & 1, r = lane & 31, h = lane >> 5;
    const int i16 = lane & 15, q4 = i16 >> 2, p4 = i16 & 3, blk = (lane >> 4) & 1;
    const bf16* Z = (const bf16*)(a->ws + WS_Z); const float* IG = (const float*)(a->ws + WS_IG); const float* LF = (const float*)(a->ws + WS_LF);
    const bf16* SC = (const bf16*)(a->ws + WS_SC); bf16* ACT = (bf16*)(a->ws + WS_ACT);
    const int row0 = sample ? MPR + bb * 16 : bb * SEQ + c * 64;
    const int u = sample ? 1024 + bb * 4 + head : (bb * 4 + head) * 128 + c;
    LAS char* vbase = (LAS char*)(lds + head * 18432);
    LAS float* AS = (LAS float*)(lds + 73728) + head * 64; LAS float* BS = (LAS float*)(lds + 73728 + 1024) + head * 64;
    LAS float* MT = (LAS float*)(lds + 73728 + 2048) + head * 64; LAS float* NP = (LAS float*)(lds + 73728 + 3072) + head * 128;
    const float mprev = ((const float*)(a->ws + WS_MPREV))[u];
    {
        const bool valid = sample ? (lane < 16) : true;
        const int rs = row0 + (sample ? (lane < 16 ? lane : 15) : lane);
        float b = valid ? LF[(size_t)rs * 4 + head] : 0.f; const float ig = valid ? IG[(size_t)rs * 4 + head] : -INFINITY;
#pragma unroll
        for (int o = 1; o < 64; o <<= 1) { const float t = __shfl_up(b, o); if (lane >= o) b += t; }
        const float av = ig - b; float cm = av;
#pragma unroll
        for (int o = 1; o < 64; o <<= 1) { const float t = __shfl_up(cm, o); if (lane >= o) cm = fmaxf(cm, t); }
        const float mt = b + fmaxf(mprev, cm);
        if (tt == 0) { AS[lane] = av; BS[lane] = b; MT[lane] = mt; const float* np = (const float*)(a->ws + WS_NPREV) + (size_t)u * 128; NP[lane] = np[lane]; NP[64 + lane] = np[64 + lane]; }
    }
#pragma unroll
    for (int hb = 0; hb < 2; ++hb) {
        u32x4 vst[4];
#pragma unroll
        for (int it = 0; it < 4; ++it) { const int idx = (4 * hb + it) * 128 + tt * 64 + lane; const int rr = idx >> 4, ch = idx & 15; const int srow = row0 + (sample ? (rr < 16 ? rr : 15) : rr);
            vst[it] = *(const u32x4*)(Z + (size_t)srow * NZ + 2560 + head * 128 + ch * 8); }
#pragma unroll
        for (int it = 0; it < 4; ++it) { const int idx = (4 * hb + it) * 128 + tt * 64 + lane; const int rr = idx >> 4, ch = idx & 15; *(LAS u32x4*)(vbase + rr * MPB + ch * 16) = vst[it]; }
    }
    const int t = 32 * tt + r;
    const int rowt = row0 + (sample ? (t < 16 ? t : 15) : t);
    bf16x8 qf[8];
#pragma unroll
    for (int s = 0; s < 8; ++s) qf[s] = *(const bf16x8*)(Z + (size_t)rowt * NZ + 1536 + head * 128 + 16 * s + 8 * h);
    bf16x8 scf[2][8], kf0[8];
#pragma unroll
    for (int et = 0; et < 2; ++et)
#pragma unroll
        for (int s = 0; s < 8; ++s) scf[et][s] = *(const bf16x8*)(SC + (size_t)u * 16384 + (32 * et + r) * 128 + 16 * s + 8 * h);
    { const int krow = row0 + (sample ? (r < 16 ? r : 15) : r);
#pragma unroll
      for (int s = 0; s < 8; ++s) kf0[s] = *(const bf16x8*)(Z + (size_t)krow * NZ + 2048 + head * 128 + 16 * s + 8 * h); }
    __syncthreads();
    if (!(sample && tt == 1) && ((hp < 0) || ((head >> 1) == hp))) {
        f32x16 acc[4];
#pragma unroll
        for (int et = 0; et < 2; ++et) { acc[et] = zero16();
#pragma unroll
            for (int s = 0; s < 8; ++s) acc[et] = MFMA32(scf[et][s], qf[s], acc[et]); }
#pragma unroll
        for (int et = 2; et < 4; ++et) { acc[et] = zero16();
#pragma unroll
            for (int s = 0; s < 8; ++s) { const bf16x8 af = *(const bf16x8*)(SC + (size_t)u * 16384 + (32 * et + r) * 128 + 16 * s + 8 * h); acc[et] = MFMA32(af, qf[s], acc[et]); } }
        const float bt = BS[t], mtt = MT[t]; const float wint = __expf(bt + mprev - mtt);
#pragma unroll
        for (int et = 0; et < 4; ++et) acc[et] *= wint;
        float qn = 0.f;
#pragma unroll
        for (int s = 0; s < 8; ++s)
#pragma unroll
            for (int jj = 0; jj < 8; ++jj) qn += bf2f((unsigned short)qf[s][jj]) * NP[16 * s + 8 * h + jj];
        qn += __shfl_xor(qn, 32);
        float den = wint * qn, denp = 0.f;
        u32x2 ogv[4][4];
#pragma unroll
        for (int et = 0; et < 4; ++et)
#pragma unroll
            for (int g = 0; g < 4; ++g) ogv[et][g] = *(const u32x2*)(Z + (size_t)rowt * NZ + 3072 + head * 128 + 32 * et + 8 * g + 4 * h);
        for (int st = 0; st <= tt; ++st) {
            f32x16 S = zero16();
            const int kr = 32 * st + r; const int krow = row0 + (sample ? (kr < 16 ? kr : 15) : kr);
            if (st == 0) {
#pragma unroll
                for (int s = 0; s < 8; ++s) S = MFMA32(kf0[s], qf[s], S);
            } else {
#pragma unroll
                for (int s = 0; s < 8; ++s) { const bf16x8 kf = *(const bf16x8*)(Z + (size_t)krow * NZ + 2048 + head * 128 + 16 * s + 8 * h); S = MFMA32(kf, qf[s], S); }
            }
#pragma unroll
            for (int i = 0; i < 16; ++i) { const int sl = 32 * st + (i & 3) + 8 * (i >> 2) + 4 * h; const float wgt = (sl <= t) ? __expf(bt + AS[sl] - mtt) : 0.f; S[i] *= wgt; denp += S[i]; }
            const bf16x8 pf0 = pack8(S, 0), pf1 = pack8(S, 1);
#pragma unroll
            for (int et = 0; et < 4; ++et) {
                const bf16x8 v0 = vtr2(vbase + (32 * st + 4 * h + q4) * MPB + 2 * (32 * et + 16 * blk) + 8 * p4, 8 * MPB);
                const bf16x8 v1 = vtr2(vbase + (32 * st + 16 + 4 * h + q4) * MPB + 2 * (32 * et + 16 * blk) + 8 * p4, 8 * MPB);
                acc[et] = MFMA32(v0, pf0, acc[et]); acc[et] = MFMA32(v1, pf1, acc[et]);
            }
        }
        den += denp + __shfl_xor(denp, 32);
        const float dd = fmaxf(fabsf(den), __expf(-mtt)); const float inv = 1.0f / dd;
        float ssq = 0.f;
#pragma unroll
        for (int et = 0; et < 4; ++et) { acc[et] *= inv;
#pragma unroll
            for (int i = 0; i < 16; ++i) ssq += acc[et][i] * acc[et][i]; }
        ssq += __shfl_xor(ssq, 32);
        const float rr = 1.0f / sqrtf(ssq * (1.f / 128.f) + EPS);
        const bool ok = sample ? (t < 16) : true;
        if (ok) {
            const float* gml = a->in[14] + l * 512 + head * 128;
#pragma unroll
            for (int et = 0; et < 4; ++et)
#pragma unroll
                for (int g = 0; g < 4; ++g) { const int e0 = 32 * et + 8 * g + 4 * h;
                    const u32x2 ob = ogv[et][g]; const f32x4 gm = *(const f32x4*)(gml + e0);
                    const float o0 = bflo(ob.x), o1 = bfhi(ob.x), o2 = bflo(ob.y), o3 = bfhi(ob.y);
                    const float y0 = acc[et][4 * g] * rr * gm.x * __builtin_amdgcn_rcpf(1.f + __expf(-o0)), y1 = acc[et][4 * g + 1] * rr * gm.y * __builtin_amdgcn_rcpf(1.f + __expf(-o1));
                    const float y2 = acc[et][4 * g + 2] * rr * gm.z * __builtin_amdgcn_rcpf(1.f + __expf(-o2)), y3 = acc[et][4 * g + 3] * rr * gm.w * __builtin_amdgcn_rcpf(1.f + __expf(-o3));
                    u32x2 o; o.x = pk2(y0, y1); o.y = pk2(y2, y3);
                    *(u32x2*)(ACT + (size_t)rowt * DM + 512 + head * 128 + e0) = o; }
        }
    }
    __syncthreads();
}
DI void sample_m2(int l, int sb, int hp, LAS unsigned char* lds) {
    const ArgsP a = get_args(); const int tid = get_tid();
    bf16* SC = (bf16*)(a->ws + WS_SC); const float* BL = (const float*)(a->ws + WS_BL); const float* AC = (const float*)(a->ws + WS_AC);
    float* MPREV = (float*)(a->ws + WS_MPREV); const float* NC = (const float*)(a->ws + WS_NC); float* NPREV = (float*)(a->ws + WS_NPREV);
    LAS float* Lc = (LAS float*)lds; LAS float* Ls = Lc + 128 * 129;
    for (int hh = 2 * hp; hh < 2 * hp + 2; ++hh) {
        const int su = sb * 4 + hh, u = 1024 + su;
        const float* c0p = a->in[4] + (size_t)(l * 32 + su) * 16384; bf16* scp = SC + (size_t)u * 16384; float* ocp = a->out + O_CS + (size_t)(l * 32 + su) * 16384;
        const float m0 = a->in[6][l * 32 + su];
        const float bl = BL[u], ac = AC[u]; const float mn = bl + fmaxf(m0, ac); const float dec = expf(bl + m0 - mn), sc = expf(bl + ac - mn);
#pragma unroll 1
        for (int i0 = 0; i0 < 32; i0 += 16) {
            float cv[16]; unsigned short sv[16];
#pragma unroll
            for (int ii = 0; ii < 16; ++ii) { const int idx = tid + (i0 + ii) * NTHR; cv[ii] = c0p[idx]; sv[ii] = scp[idx]; }
#pragma unroll
            for (int ii = 0; ii < 16; ++ii) { const int idx = tid + (i0 + ii) * NTHR; const int r = idx >> 7, q = idx & 127; Lc[r * 129 + q] = cv[ii]; Ls[r * 129 + q] = bf2f(sv[ii]); }
        }
        __syncthreads();
#pragma unroll
        for (int ii = 0; ii < 32; ++ii) { const int idx = tid + ii * NTHR; const int r = idx >> 7, q = idx & 127;
            scp[idx] = (bf16)(pk2(Lc[q * 129 + r], 0.f) & 0xffffu);
            ocp[idx] = dec * Lc[r * 129 + q] + sc * Ls[q * 129 + r]; }
        if (tid < 128) { const float n0 = a->in[5][(size_t)(l * 32 + su) * 128 + tid]; NPREV[(size_t)u * 128 + tid] = n0; a->out[O_NS + (size_t)(l * 32 + su) * 128 + tid] = dec * n0 + sc * NC[(size_t)u * 128 + tid]; }
        if (tid == 0) { MPREV[u] = m0; a->out[O_MS + l * 32 + su] = mn; }
        __syncthreads();
    }
}
#define BLOCK_MEM_SYNC() do { asm volatile("s_waitcnt vmcnt(0)" ::: "memory"); __syncthreads(); __builtin_amdgcn_fence(__ATOMIC_ACQUIRE, "agent"); asm volatile("s_waitcnt vmcnt(0)" ::: "memory"); } while (0)
DI void load_bias(int l, LAS unsigned char* lds) {
    const ArgsP a = get_args(); const int tid = get_tid();
    for (int e = tid; e < 8 * 320; e += NTHR) { const int hd = e / 320, i = e % 320; ((LAS float*)(lds + 73728))[hd * 320 + i] = a->in[12][(size_t)(l * 8 + hd) * 513 + 193 + i] * 1.4426950408889634f; }
    __syncthreads();
}
DI void phase_c(int l, LAS unsigned char* lds) {
    phase_c_pre(l);
    const int bid = get_bid(), nb = get_nb();
    const bool deal = (nb == 256);
    const int v = deal ? ((bid & 7) * 32 + (bid >> 3)) : bid;
    for (int t = v; t < 16; t += nb) {
        m1_item(true, t >> 1, 0, lds, t & 1);
        BLOCK_MEM_SYNC();
        sample_m2(l, t >> 1, t & 1, lds);
        BLOCK_MEM_SYNC();
        m3_item(l, true, t >> 1, 0, lds, t & 1);
    }
    int p_lo, p_hi, p_st, m_lo, m_hi, m_st;
    if (deal) { const int w = v - 16; p_lo = w < 0 ? 520 : (w * 520) / 240; p_hi = w < 0 ? 520 : ((w + 1) * 520) / 240; p_st = 1;
                const int r2 = 3 * w - p_lo; const bool two = (w >= 0) && (p_hi - p_lo == 2); m_lo = two ? (r2 * 256) / 200 : 256; m_hi = two ? ((r2 + 1) * 256) / 200 : 256; m_st = 1; }
    else { p_lo = bid; p_hi = 520; p_st = nb; m_lo = bid; m_hi = 256; m_st = nb; }
    if (p_lo < p_hi) load_bias(l, lds);
    for (int p = p_lo; p < p_hi; p += p_st) {
        if (p >= 512) attn_unit<true>(l, p - 512, 0, 0, lds);
        else attn_unit<false>(l, p >> 8, (p >> 1) & 127, p & 1, lds);
    }
    __syncthreads();
    for (int t = m_lo; t < m_hi; t += m_st) m1_item(false, t >> 7, t & 127, lds);
}
DI void phase_e(int l, LAS unsigned char* lds) {
    for (int it = get_bid(); it < 256; it += get_nb()) m3_item(l, false, it >> 7, it & 127, lds);
}

DI float gelu_tanh(float x) { const float ee = __builtin_amdgcn_exp2f(x * (2.3022082f + 0.10294324f * x * x)); return x - x * __builtin_amdgcn_rcpf(ee + 1.f); }
DI void ld8(const bf16* p, float (&o)[8]) { const u32x4 x = *(const u32x4*)p; o[0] = bflo(x.x); o[1] = bfhi(x.x); o[2] = bflo(x.y); o[3] = bfhi(x.y); o[4] = bflo(x.z); o[5] = bfhi(x.z); o[6] = bflo(x.w); o[7] = bfhi(x.w); }
DI void ldf8(const float* p, float (&o)[8]) { const f32x4 x = *(const f32x4*)p, y = *(const f32x4*)(p + 4); o[0] = x.x; o[1] = x.y; o[2] = x.z; o[3] = x.w; o[4] = y.x; o[5] = y.y; o[6] = y.z; o[7] = y.w; }
DI void phase_fix(int l) {
    const ArgsP a = get_args(); const int gt = get_bid() * NTHR + get_tid(), NTH = get_nb() * NTHR;
    const bf16* UQ = (const bf16*)(a->ws + WS_UQ); bf16* G = (bf16*)(a->ws + WS_G);
    const float* wc = a->in[17] + (size_t)l * 3 * NU; const float* bc = a->in[18] + (size_t)l * NU;
    for (int item = gt; item < (MVALID / 16) * 352; item += NTH) {
        const int k = item / 352, cc = item % 352, j0 = cc * 8; const int m0 = 16 * k;
        const bool smp = m0 >= MPR; const bool bstart = smp ? true : ((m0 & (SEQ - 1)) == 0); const int sb = smp ? (m0 - MPR) >> 4 : 0;
        float w0g[8], w1g[8], w2g[8], bg[8], w0u[8], w1u[8], w2u[8], bu[8];
        ldf8(wc + j0, w0g); ldf8(wc + NU + j0, w1g); ldf8(wc + 2 * NU + j0, w2g); ldf8(bc + j0, bg);
        ldf8(wc + DFF + j0, w0u); ldf8(wc + NU + DFF + j0, w1u); ldf8(wc + 2 * NU + DFF + j0, w2u); ldf8(bc + DFF + j0, bu);
        float p2g[8], p1g[8], p2u[8], p1u[8], c0g[8], c0u[8], c1g[8], c1u[8];
        if (bstart) {
            if (smp) { const float* cb = a->in[7] + (size_t)((l * 8 + sb) * 2) * NU; ldf8(cb + j0, p2g); ldf8(cb + NU + j0, p1g); ldf8(cb + DFF + j0, p2u); ldf8(cb + NU + DFF + j0, p1u); }
            else {
#pragma unroll
                for (int q = 0; q < 8; ++q) { p2g[q] = 0.f; p1g[q] = 0.f; p2u[q] = 0.f; p1u[q] = 0.f; } }
        } else { const bf16* pq = UQ + (size_t)(4 * (k - 1) + 2) * NU; ld8(pq + j0, p2g); ld8(pq + NU + j0, p1g); ld8(pq + DFF + j0, p2u); ld8(pq + NU + DFF + j0, p1u); }
        const bf16* cq = UQ + (size_t)(4 * k) * NU; ld8(cq + j0, c0g); ld8(cq + DFF + j0, c0u); ld8(cq + NU + j0, c1g); ld8(cq + NU + DFF + j0, c1u);
        float o0[8], o1[8];
#pragma unroll
        for (int q = 0; q < 8; ++q) {
            o0[q] = gelu_tanh(bg[q] + p2g[q] * w0g[q] + p1g[q] * w1g[q] + c0g[q] * w2g[q]) * (bu[q] + p2u[q] * w0u[q] + p1u[q] * w1u[q] + c0u[q] * w2u[q]);
            o1[q] = gelu_tanh(bg[q] + p1g[q] * w0g[q] + c0g[q] * w1g[q] + c1g[q] * w2g[q]) * (bu[q] + p1u[q] * w0u[q] + c0u[q] * w1u[q] + c1u[q] * w2u[q]); }
        u32x4 ov; ov.x = pk2(o0[0], o0[1]); ov.y = pk2(o0[2], o0[3]); ov.z = pk2(o0[4], o0[5]); ov.w = pk2(o0[6], o0[7]);
        *(u32x4*)(G + (size_t)m0 * DFF + j0) = ov;
        ov.x = pk2(o1[0], o1[1]); ov.y = pk2(o1[2], o1[3]); ov.z = pk2(o1[4], o1[5]); ov.w = pk2(o1[6], o1[7]);
        *(u32x4*)(G + (size_t)(m0 + 1) * DFF + j0) = ov;
        const bool lastg = smp ? true : ((m0 & (SEQ - 1)) == SEQ - 16);
        if (lastg) {
            float* fo = smp ? a->out + O_FS + (size_t)((l * 8 + sb) * 2) * NU : a->out + O_FP + (size_t)((l * 2 + (m0 >> 13)) * 2) * NU;
            float e0[8], e1[8]; const bf16* lq = UQ + (size_t)(4 * k + 2) * NU;
            ld8(lq + j0, e0); ld8(lq + NU + j0, e1);
            *(f32x4*)(fo + j0) = (f32x4){e0[0], e0[1], e0[2], e0[3]}; *(f32x4*)(fo + j0 + 4) = (f32x4){e0[4], e0[5], e0[6], e0[7]};
            *(f32x4*)(fo + NU + j0) = (f32x4){e1[0], e1[1], e1[2], e1[3]}; *(f32x4*)(fo + NU + j0 + 4) = (f32x4){e1[4], e1[5], e1[6], e1[7]};
            ld8(lq + DFF + j0, e0); ld8(lq + NU + DFF + j0, e1);
            *(f32x4*)(fo + DFF + j0) = (f32x4){e0[0], e0[1], e0[2], e0[3]}; *(f32x4*)(fo + DFF + j0 + 4) = (f32x4){e0[4], e0[5], e0[6], e0[7]};
            *(f32x4*)(fo + NU + DFF + j0) = (f32x4){e1[0], e1[1], e1[2], e1[3]}; *(f32x4*)(fo + NU + DFF + j0 + 4) = (f32x4){e1[4], e1[5], e1[6], e1[7]};
        }
    }
}

#define XB_TMO      128
#define XB_XCNT(j)  (256  + 64 * (j))
#define XB_XSUB(j)  (1280 + 64 * (j))
#define XB_XGEN(j)  (2304 + 64 * (j))
#define XB_TOP      3328
#define XB_TOPGEN   3392
#define XCD_BAR_WORDS 3456
#define XB_SPIN_CAP (1u << 18)
__device__ __forceinline__ unsigned xb_ld(unsigned* p)              { return __hip_atomic_load(p, __ATOMIC_RELAXED, __HIP_MEMORY_SCOPE_AGENT); }
__device__ __forceinline__ unsigned xb_add(unsigned* p, unsigned v) { return __hip_atomic_fetch_add(p, v, __ATOMIC_RELAXED, __HIP_MEMORY_SCOPE_AGENT); }
__device__ __forceinline__ unsigned xb_xcc_id() { return (unsigned)__builtin_amdgcn_s_getreg((3 << 11) | 20) & 0xFu; }
#define XB_SPIN(cond, bar) do { unsigned _sp = 0; while (cond) { __builtin_amdgcn_s_sleep(1); \
    if ((++_sp & 255u) == 0u) { if (xb_ld(&(bar)[XB_TMO])) break; if (_sp > XB_SPIN_CAP) { atomicAdd(&(bar)[XB_TMO], 1u); break; } } } } while (0)

struct XcdBarrier {
    unsigned* bar; unsigned x;
    volatile LAS unsigned* st;
};

__device__ __forceinline__ XcdBarrier xcd_barrier_post(unsigned* bar, volatile LAS unsigned* st) {
    XcdBarrier b; b.bar = bar; b.x = xb_xcc_id(); b.st = st;
    if (threadIdx.x == 0) (void)xb_add(&bar[XB_XCNT(b.x)], 1u);
    return b;
}
__device__ __forceinline__ void xcd_barrier_complete(unsigned* bar, unsigned x, unsigned& nloc, unsigned& nx) {
    const unsigned G = gridDim.x * gridDim.y * gridDim.z;
    unsigned sum, cnt, mine, sp = 0u;
    for (;;) {
        sum = 0u; cnt = 0u; mine = 0u;
#pragma unroll
        for (unsigned j = 0; j < 16; ++j) { const unsigned c = xb_ld(&bar[XB_XCNT(j)]); sum += c; cnt += (c > 0u) ? 1u : 0u; mine = (j == x) ? c : mine; }
        if (sum == G) break;
        __builtin_amdgcn_s_sleep(1);
        if ((++sp & 255u) == 0u) { if (xb_ld(&bar[XB_TMO])) break; if (sp > XB_SPIN_CAP) { atomicAdd(&bar[XB_TMO], 1u); break; } }
    }
    nloc = mine > 0u ? mine : 1u; nx = cnt > 0u ? cnt : 1u;
}

__device__ __forceinline__ void xcd_barrier(const XcdBarrier& b) {
    asm volatile("s_waitcnt vmcnt(0)" ::: "memory");
    __syncthreads();
    if (threadIdx.x == 0) {
        unsigned* bar = b.bar;
        __builtin_amdgcn_s_waitcnt(0);
        unsigned nloc = b.st[0], nx = b.st[1];
        if (nloc == 0u) { xcd_barrier_complete(bar, b.x, nloc, nx); b.st[0] = nloc; b.st[1] = nx; }
        const unsigned old = xb_add(&bar[XB_XSUB(b.x)], 1u);
        const unsigned gen = old / nloc;
        if (old + 1u == (gen + 1u) * nloc) {
            __builtin_amdgcn_fence(__ATOMIC_RELEASE, "agent");
            asm volatile("s_waitcnt vmcnt(0)" ::: "memory");
            const unsigned og = xb_add(&bar[XB_TOP], 1u);
            const unsigned tg = og / nx;
            if (og + 1u == (tg + 1u) * nx) xb_add(&bar[XB_TOPGEN], 1u);
            else XB_SPIN(xb_ld(&bar[XB_TOPGEN]) == tg, bar);
            __builtin_amdgcn_fence(__ATOMIC_ACQUIRE, "agent");
            xb_add(&bar[XB_XGEN(b.x)], 1u);
            asm volatile("s_waitcnt vmcnt(0)" ::: "memory");
        } else {
            XB_SPIN(xb_ld(&bar[XB_XGEN(b.x)]) == gen, bar);
            __builtin_amdgcn_fence(__ATOMIC_ACQUIRE, "agent");
            asm volatile("s_waitcnt vmcnt(0)" ::: "memory");
        }
    }
    __syncthreads();
}


#ifndef PHMASK
#define PHMASK 0xffff
#endif
#ifndef REP_GEMM
#define REP_GEMM 1
#endif
#ifndef REP_C
#define REP_C 1
#endif
#ifndef REP_E
#define REP_E 1
#endif
#ifndef REP_SYNC
#define REP_SYNC 1
#endif
#ifndef REP_CONV
#define REP_CONV 1
#endif
__global__ void __launch_bounds__(NTHR, 2) fwd_mega(Args a_unused) {
    extern __shared__ __attribute__((aligned(16))) unsigned char lds_raw[];
    LAS unsigned char* lds0 = (LAS unsigned char*)lds_raw;
    cg::grid_group grid = cg::this_grid();
    volatile LAS unsigned* st = (volatile LAS unsigned*)(lds0 + 147456);
    if (threadIdx.x < 4) st[threadIdx.x] = 0u;
    __syncthreads();
    unsigned* barw = (unsigned*)(get_args()->ws + WS_BAR);
    if (blockIdx.x == 0) { for (int i = threadIdx.x; i < XCD_BAR_WORDS; i += NTHR) __hip_atomic_store(barw + i, 0u, __ATOMIC_RELAXED, __HIP_MEMORY_SCOPE_AGENT); }
    grid.sync();
    const XcdBarrier bar = xcd_barrier_post(barw, st);
#pragma nounroll
    for (int step = 0; step < 21; ++step) {
        const int l = step / 10, ph = (step == 20) ? 12 : step % 10;
        LAS unsigned char* lds = lds0; asm volatile("" : "+s"(lds));
        if (ph == 1 || ph == 5 || ph == 7 || ph == 9) {
            if (PHMASK & 4) {
            const ArgsP a = get_args(); unsigned char* ws = a->ws;
            const bf16* A; const bf16* Bt; void* O; int M, N, K, mode;
            if (ph == 1)       { A = (const bf16*)(ws + WS_ACT); Bt = (const bf16*)(ws + WS_WIN); O = ws + WS_Z; M = MPAD; N = NZ + 256; K = DM; mode = 1; }
            else if (ph == 5)  { A = (const bf16*)(ws + WS_ACT); Bt = (const bf16*)(ws + WS_WOUT); O = ws + WS_MIX; M = MPR; N = DM; K = DM; mode = 0; }
            else if (ph == 7)  { A = (const bf16*)(ws + WS_ACT); Bt = (const bf16*)(ws + WS_WUP); O = ws + WS_G; M = MPAD; N = NU; K = DM; mode = 3; }
            else               { A = (const bf16*)(ws + WS_G); Bt = (const bf16*)(ws + WS_WDN); O = ws + WS_FFN; M = MPR; N = DM; K = DFF; mode = 0; }
            pg8::EpiGen E{O, N, mode, ws + WS_UQ, a->in[17] + (size_t)l * 3 * NU, a->in[18] + (size_t)l * NU, (float*)(ws + WS_IG), (float*)(ws + WS_LF), a->in[10] + l * 4, a->in[11] + l * 4};
            pg8::Gemm g{A, Bt, M, N, K}; pg8::StaticOrder S; S.init(M, N, get_nb(), get_bid());
            pg8::gemm_phase<pg8::EpiGen, pg8::StaticOrder, true, true>(lds, g, S, E);
            if (ph == 5 || ph == 9) mini_gemm(lds, A + (size_t)MPR * K, Bt, K, (bf16*)O + (size_t)MPR * DM);
            }
        } else if (ph == 0 || ph == 6 || ph == 12) {
            if (ph == 0 && (PHMASK & 1)) { phase_convert(l, lds); __syncthreads(); }
            if (PHMASK & 2) {
            const ArgsP a = get_args();
            const float* ngl = a->in[8] + (size_t)l * 4 * DM;
            bool first; const bf16* addsrc; const float* gadd; const float* gn; int gl;
            if (ph == 0) { first = (l == 0); addsrc = (l == 0) ? nullptr : (const bf16*)(a->ws + WS_FFN); gadd = ngl - DM; gn = ngl; gl = -1; }
            else if (ph == 6) { first = (l == 0); addsrc = (const bf16*)(a->ws + WS_MIX); gadd = ngl + DM; gn = ngl + 2 * DM; gl = -1; }
            else { first = false; addsrc = (const bf16*)(a->ws + WS_FFN); gadd = a->in[8] + (size_t)7 * DM; gn = nullptr; gl = -1; }
            phase_rows(lds, first, addsrc, gadd, gn, gl, ph == 12);
            }
        } else if (ph == 2) { if (PHMASK & 8) phase_c(l, lds); }
        else if (ph == 3) { if (PHMASK & 16) phase_m2(l, lds); }
        else if (ph == 4) { if (PHMASK & 32) phase_e(l, lds); }
        else { if (PHMASK & 512) phase_fix(l); }
        if (step < 20) xcd_barrier(bar);
    }
}

extern "C" void kernel_launch(void* const* d_in, const int* in_sizes, int n_in, void* d_out, int out_size, void* d_ws, size_t ws_size, hipStream_t stream) {
    static int grid = 0;
    if (grid == 0) {
        if (n_in != 20 || (size_t)out_size != O_END || ws_size < WS_END) { fprintf(stderr, "kernel_launch: unexpected shapes: n_in %d out %d ws %zu\n", n_in, out_size, ws_size); grid = -1; return; }
        int dev = 0, cus = 0, per_cu = 0;
        (void)hipGetDevice(&dev);
        (void)hipDeviceGetAttribute(&cus, hipDeviceAttributeMultiprocessorCount, dev);
        (void)hipFuncSetAttribute((const void*)fwd_mega, hipFuncAttributeMaxDynamicSharedMemorySize, LDS_BYTES);
        (void)hipOccupancyMaxActiveBlocksPerMultiprocessor(&per_cu, (const void*)fwd_mega, NTHR, LDS_BYTES);
        if (per_cu < 1) per_cu = 1;
        grid = cus * per_cu;
    }
    if (grid < 0) return;
    Args a{};
    for (int i = 0; i < 20; ++i) a.in[i] = (const float*)d_in[i];
    a.out = (float*)d_out; a.ws = (unsigned char*)d_ws;
    void* args[] = {&a};
    hipError_t e = hipLaunchCooperativeKernel((const void*)fwd_mega, dim3(grid), dim3(NTHR), args, LDS_BYTES, stream);
    if (e != hipSuccess) fprintf(stderr, "cooperative launch failed: %s (grid %d)\n", hipGetErrorString(e), grid);
}
```

```cpp
#include <hip/hip_runtime.h>
#include <hip/hip_cooperative_groups.h>
#include <cstdio>
#include <cstdint>
#include <cmath>
namespace cg = cooperative_groups;

namespace pg8 {
#define PG8_LAS __attribute__((address_space(3)))
typedef unsigned short bf16_t;
typedef short bf16x8 __attribute__((ext_vector_type(8)));
typedef float f32x4 __attribute__((ext_vector_type(4)));
typedef unsigned u32x4 __attribute__((ext_vector_type(4)));
constexpr int BM = 256, BK = 64, HALF = 128, HTB = HALF * BK * 2  , STAGE_BYTES = 8 * HTB, NXCD = 8, WGM = 8;

__host__ __device__ __forceinline__ int lds_byte(int r, int c) { const int st = (r >> 4) * 2 + (c >> 5), rr = r & 15, cc = c & 31, ob = rr * 64 + cc * 2; return st * 1024 + (ob ^ (((ob >> 9) & 1) << 5)); }
__host__ __device__ __forceinline__ void stage_rc(int b, int& R, int& C) { const int st = b / 1024, sb = b % 1024, swz = sb ^ (((sb >> 9) & 1) << 5); R = (st >> 1) * 16 + swz / 64; C = (st & 1) * 32 + (swz % 64) / 2; }
__host__ __device__ __forceinline__ int perm32(int rho) { const int n = rho >> 4, i = rho & 15; return 8 * (i >> 2) + 4 * n + (i & 3); }

struct Unit { int pm, pn; };
struct Gemm { const bf16_t* A; const bf16_t* Bt; int M, N, K; };

struct StaticOrder {
    int nM, nN, nwg, G, c;
    __host__ __device__ void init(int M, int N, int G_, int c_) { nM = M / BM; nN = N / BM; nwg = nM * nN; G = G_; c = c_; }
    __host__ __device__ bool next(int i, Unit& u) const {
        const long L = (long)i * G + c; if (L >= nwg) return false;
        int wgid = (int)L; { const int q = nwg / NXCD, r = nwg % NXCD, xcd = wgid % NXCD, off = wgid / NXCD; wgid = (xcd < r ? xcd * (q + 1) : r * (q + 1) + (xcd - r) * q) + off; }
        const int nig = WGM * nN, gid = wgid / nig, fm = gid * WGM, gsz = (nM - fm) < WGM ? (nM - fm) : WGM;
        u.pm = fm + ((wgid % nig) % gsz); u.pn = (wgid % nig) / gsz; return true;
    }
    __device__ __forceinline__ void a_ready(const Unit&) const {}
    __device__ __forceinline__ void done(const Unit&) const {}
};

typedef float f32x2e __attribute__((ext_vector_type(2)));
typedef __bf16 bf16x2e __attribute__((ext_vector_type(2)));
__device__ __forceinline__ unsigned cvt_pk_bf16(float lo, float hi) { f32x2e v = {lo, hi}; bf16x2e b = __builtin_convertvector(v, bf16x2e); return __builtin_bit_cast(unsigned, b); }
__device__ __forceinline__ float gelu_t(float x) { const float ee = __builtin_amdgcn_exp2f(x * (2.3022082f + 0.10294324f * x * x)); return x - x * __builtin_amdgcn_rcpf(ee + 1.f); }
__device__ __forceinline__ float dpp_shr1(float v) { return __builtin_bit_cast(float, __builtin_amdgcn_update_dpp(0, __builtin_bit_cast(int, v), 0x111, 0xf, 0xf, true)); }
__device__ __forceinline__ float dpp_shr2(float v) { return __builtin_bit_cast(float, __builtin_amdgcn_update_dpp(0, __builtin_bit_cast(int, v), 0x112, 0xf, 0xf, true)); }
struct EpiGen {
    static constexpr bool PERM = true, AFTER_DRAIN = false;
    void* O; int ldc; int mode;
    void* O2; const float* cw; const float* cb;
    float* IGo; float* LFo; const float* bi; const float* bfg;
    __device__ __forceinline__ void operator()(const f32x4 (&acc)[2][2][4][2], const Unit& u, int wr, int wc, int fr, int fq) const {
        const int row0 = u.pm * BM + wr * 64 + fr; const int col0 = u.pn * BM + wc * 32 + 8 * fq;
        if (mode == 3) {
            const int f0 = u.pn * 128 + wc * 32 + 8 * fq;
#pragma unroll
            for (int n = 0; n < 2; ++n) {
                const int fn = f0 + 4 * n;
                const f32x4 w0g = *(const f32x4*)(cw + fn), w1g = *(const f32x4*)(cw + 5632 + fn), w2g = *(const f32x4*)(cw + 2 * 5632 + fn), bg = *(const f32x4*)(cb + fn);
                const f32x4 w0u = *(const f32x4*)(cw + 2816 + fn), w1u = *(const f32x4*)(cw + 5632 + 2816 + fn), w2u = *(const f32x4*)(cw + 2 * 5632 + 2816 + fn), bu = *(const f32x4*)(cb + 2816 + fn);
#pragma unroll
                for (int ai = 0; ai < 2; ++ai)
#pragma unroll
                    for (int m = 0; m < 4; ++m) { const int row = row0 + ai * HALF + m * 16;
                        float og[4];
#pragma unroll
                        for (int i = 0; i < 4; ++i) { const float ug = acc[ai][0][m][n][i], uu = acc[ai][1][m][n][i];
                            const float yg = bg[i] + dpp_shr2(ug) * w0g[i] + dpp_shr1(ug) * w1g[i] + ug * w2g[i];
                            const float yu = bu[i] + dpp_shr2(uu) * w0u[i] + dpp_shr1(uu) * w1u[i] + uu * w2u[i];
                            og[i] = gelu_t(yg) * yu; }
                        if (fr >= 2) { unsigned w0 = cvt_pk_bf16(og[0], og[1]), w1 = cvt_pk_bf16(og[2], og[3]);
                            unsigned* dst = (unsigned*)((bf16_t*)O + (size_t)row * 2816 + fn); dst[0] = w0; dst[1] = w1; } }
            }
            if (fr < 2 || fr >= 14) {
#pragma unroll
                for (int ai = 0; ai < 2; ++ai)
#pragma unroll
                    for (int m = 0; m < 4; ++m) { const int row = row0 + ai * HALF + m * 16;
                        bf16_t* q = (bf16_t*)O2 + (size_t)((row >> 4) * 4 + (fr < 2 ? fr : fr - 12)) * 5632 + f0;
                        u32x4 wg, wu; const f32x4 g0 = acc[ai][0][m][0], g1 = acc[ai][0][m][1], u0 = acc[ai][1][m][0], u1 = acc[ai][1][m][1];
                        wg.x = cvt_pk_bf16(g0[0], g0[1]); wg.y = cvt_pk_bf16(g0[2], g0[3]); wg.z = cvt_pk_bf16(g1[0], g1[1]); wg.w = cvt_pk_bf16(g1[2], g1[3]);
                        wu.x = cvt_pk_bf16(u0[0], u0[1]); wu.y = cvt_pk_bf16(u0[2], u0[3]); wu.z = cvt_pk_bf16(u1[0], u1[1]); wu.w = cvt_pk_bf16(u1[2], u1[3]);
                        *(u32x4*)q = wg; *(u32x4*)(q + 2816) = wu; }
            }
        } else if (mode == 2) {
#pragma unroll
            for (int ai = 0; ai < 2; ++ai)
#pragma unroll
                for (int m = 0; m < 4; ++m) { float* rowp = (float*)O + (size_t)(row0 + ai * HALF + m * 16) * ldc + col0;
#pragma unroll
                    for (int bj = 0; bj < 2; ++bj) { *(f32x4*)(rowp + bj * HALF) = acc[ai][bj][m][0]; *(f32x4*)(rowp + bj * HALF + 4) = acc[ai][bj][m][1]; } }
        } else if (mode == 1 && u.pn == 14) {
            if (wc == 0 && fq == 0) {
                const f32x4 bi4 = *(const f32x4*)bi, bf4 = *(const f32x4*)bfg;
#pragma unroll
                for (int ai = 0; ai < 2; ++ai)
#pragma unroll
                    for (int m = 0; m < 4; ++m) { const int row = row0 + ai * HALF + m * 16;
                        *(f32x4*)(IGo + (size_t)row * 4) = acc[ai][0][m][0] + bi4;
                        f32x4 x = acc[ai][0][m][1] + bf4, o;
#pragma unroll
                        for (int i = 0; i < 4; ++i) o[i] = fminf(x[i], 0.f) - log1pf(expf(-fabsf(x[i])));
                        *(f32x4*)(LFo + (size_t)row * 4) = o; }
            }
        } else {
            const int ldz = (mode == 1) ? 3584 : ldc;
            float sc = 1.f; if (mode == 1) { sc = (u.pn < 2) ? 0.18033688011112042f   : ((u.pn == 8 || u.pn == 9) ? 0.08838834764831845f : 1.f); }
#pragma unroll
            for (int ai = 0; ai < 2; ++ai)
#pragma unroll
                for (int m = 0; m < 4; ++m) { bf16_t* rowp = (bf16_t*)O + (size_t)(row0 + ai * HALF + m * 16) * ldz + col0;
#pragma unroll
                    for (int bj = 0; bj < 2; ++bj) { f32x4 v0 = acc[ai][bj][m][0] * sc, v1 = acc[ai][bj][m][1] * sc;
                        u32x4 w; w.x = cvt_pk_bf16(v0[0], v0[1]); w.y = cvt_pk_bf16(v0[2], v0[3]); w.z = cvt_pk_bf16(v1[0], v1[1]); w.w = cvt_pk_bf16(v1[2], v1[3]);
                        *(u32x4*)(rowp + bj * HALF) = w; } }
        }
    }
    __device__ __forceinline__ void fused(f32x4 (&acc)[2][2][4][2], const Unit& u, int wr, int wc, int fr, int fq, PG8_LAS unsigned char* lds, int wid, int lane) const {}
};
template <class Epi, class Sched, bool ALIGN_EPI = false, bool SP2 = false>
__device__ __forceinline__ void gemm_phase(PG8_LAS unsigned char* lds, const Gemm g, const Sched& S, const Epi& E) {
    int tid_ = threadIdx.x; asm volatile("" : "+v"(tid_)); const int tid = tid_, wid = __builtin_amdgcn_readfirstlane(tid >> 6), lane = tid & 63, wr = wid >> 2, wc = wid & 3, fr = lane & 15, fq = lane >> 4;
    const int K = g.K, nt = K / BK;
    unsigned voffA[2], voffB[2];
#pragma unroll
    for (int i = 0; i < 2; ++i) { int R, C; stage_rc(tid * 16 + i * 8192, R, C); const int Rb = Epi::PERM ? ((R & ~31) + perm32(R & 31)) : R;
        voffA[i] = (unsigned)(R * K + C) * 2u; voffB[i] = (unsigned)(Rb * K + C) * 2u; }
    const size_t kstep = (size_t)(BK * 2);
    const size_t hstep = (size_t)HALF * K * 2;
    const size_t tstep = 2 * hstep;
    const unsigned ldsw = (unsigned)wid * 1024u;
    const int aoff = lds_byte(wr * 64 + fr, fq * 8), boff = lds_byte(wc * 32 + fr, fq * 8);
#define PG8_SA(b, h) (((b) * 2 + (h)) * HTB)
#define PG8_SB(b, h) ((4 + (b) * 2 + (h)) * HTB)
#define PG8_STAGE(bufoff, gbase, voff) do { _Pragma("unroll") for (int _i = 0; _i < 2; ++_i) \
        __builtin_amdgcn_global_load_lds((const unsigned*)((const char*)(gbase) + (voff)[_i]), (PG8_LAS unsigned*)(lds + (bufoff) + ldsw + _i * 8192), 16, 0, 0); } while (0)
#define PG8_LDA(dst, b, h) do { _Pragma("unroll") for (int m = 0; m < 4; ++m) _Pragma("unroll") for (int k = 0; k < 2; ++k) dst[m][k] = *(const PG8_LAS bf16x8*)(lds + PG8_SA(b, h) + aoff + m * 2048 + k * 1024); } while (0)
#define PG8_LDB(dst, b, h) do { _Pragma("unroll") for (int n = 0; n < 2; ++n) _Pragma("unroll") for (int k = 0; k < 2; ++k) dst[n][k] = *(const PG8_LAS bf16x8*)(lds + PG8_SB(b, h) + boff + n * 2048 + k * 1024); } while (0)
#define PG8_MMA(ai, bj, At, Bt) do { __builtin_amdgcn_s_setprio(1); _Pragma("unroll") for (int m = 0; m < 4; ++m) _Pragma("unroll") for (int n = 0; n < 2; ++n) _Pragma("unroll") for (int k = 0; k < 2; ++k) \
        acc[ai][bj][m][n] = __builtin_amdgcn_mfma_f32_16x16x32_bf16(Bt[n][k], At[m][k], acc[ai][bj][m][n], 0, 0, 0); __builtin_amdgcn_s_setprio(0); } while (0)
#define PG8_WAIT_V(n) asm volatile("s_waitcnt vmcnt(" #n ")" ::: "memory")
#define PG8_WAIT_L(n) asm volatile("s_waitcnt lgkmcnt(" #n ")" ::: "memory")
#define PG8_BAR __builtin_amdgcn_s_barrier()
#define PG8_SCHED __builtin_amdgcn_sched_barrier(0)
    Unit cur, nxt; int ui = 0;
    if (!S.next(0, cur)) return;
    f32x4 acc[2][2][4][2];
#pragma unroll
    for (int a = 0; a < 2; ++a)
#pragma unroll
        for (int b = 0; b < 2; ++b)
#pragma unroll
            for (int m = 0; m < 4; ++m)
#pragma unroll
                for (int n = 0; n < 2; ++n) acc[a][b][m][n] = (f32x4){0.f, 0.f, 0.f, 0.f};
    bf16x8 At[4][2], B0[2][2], B1[2][2];
    const char* cA = (const char*)g.A + (size_t)cur.pm * tstep; const char* cB = (const char*)g.Bt + (size_t)cur.pn * tstep;
    S.a_ready(cur);
    if constexpr (SP2) {
        PG8_STAGE(PG8_SB(0, 0), cB, voffB); PG8_STAGE(PG8_SB(0, 1), cB + hstep, voffB); PG8_STAGE(PG8_SA(0, 0), cA, voffA); PG8_STAGE(PG8_SA(0, 1), cA + hstep, voffA);
        if (wr == 1) PG8_BAR;
        PG8_WAIT_V(2); PG8_BAR;
        PG8_STAGE(PG8_SB(1, 0), cB + kstep, voffB); PG8_STAGE(PG8_SA(1, 0), cA + kstep, voffA); PG8_STAGE(PG8_SB(1, 1), cB + hstep + kstep, voffB);
        PG8_WAIT_V(6); PG8_BAR;
    } else {
        PG8_STAGE(PG8_SB(0, 0), cB, voffB); PG8_STAGE(PG8_SA(0, 0), cA, voffA); PG8_STAGE(PG8_SB(0, 1), cB + hstep, voffB); PG8_STAGE(PG8_SA(0, 1), cA + hstep, voffA);
        if (wr == 1) PG8_BAR;
        PG8_WAIT_V(4); PG8_BAR;
        PG8_STAGE(PG8_SB(1, 0), cB + kstep, voffB); PG8_STAGE(PG8_SA(1, 0), cA + kstep, voffA); PG8_STAGE(PG8_SB(1, 1), cB + hstep + kstep, voffB);
        PG8_WAIT_V(6); PG8_BAR;
    }
    for (;;) {
        const bool has_next = S.next(ui + 1, nxt);
        const char* nA = has_next ? (const char*)g.A + (size_t)nxt.pm * tstep : cA; const char* nB = has_next ? (const char*)g.Bt + (size_t)nxt.pn * tstep : cB;
        for (int t = 0; t < nt; t += 2) {
            const bool last = (t == nt - 2);
            const char* a1 = cA + (size_t)(t + 1) * kstep;
            const char* a2 = last ? nA : cA + (size_t)(t + 2) * kstep; const char* b2 = last ? nB : cB + (size_t)(t + 2) * kstep;
            const char* a3 = a2 + kstep; const char* b3 = b2 + kstep;
            if (last && has_next) S.a_ready(nxt);
            if constexpr (SP2) {
            PG8_LDB(B0, 0, 0); PG8_LDB(B1, 0, 1); PG8_SCHED; PG8_LDA(At, 0, 0); PG8_STAGE(PG8_SA(1, 1), a1 + hstep, voffA);
            PG8_WAIT_V(8); PG8_WAIT_L(0); PG8_BAR; PG8_MMA(0, 0, At, B0); PG8_MMA(0, 1, At, B1); PG8_BAR; PG8_SCHED;
            PG8_LDA(At, 0, 1); PG8_STAGE(PG8_SB(0, 0), b2, voffB); PG8_STAGE(PG8_SB(0, 1), b2 + hstep, voffB); PG8_STAGE(PG8_SA(0, 0), a2, voffA);
            PG8_WAIT_V(8); PG8_WAIT_L(0); PG8_BAR; PG8_MMA(1, 0, At, B0); PG8_MMA(1, 1, At, B1); PG8_BAR; PG8_SCHED;
            PG8_LDB(B0, 1, 0); PG8_LDB(B1, 1, 1); PG8_SCHED; PG8_LDA(At, 1, 0); PG8_STAGE(PG8_SA(0, 1), a2 + hstep, voffA);
            PG8_WAIT_V(8); PG8_WAIT_L(0); PG8_BAR; PG8_MMA(0, 0, At, B0); PG8_MMA(0, 1, At, B1); PG8_BAR; PG8_SCHED;
            PG8_LDA(At, 1, 1); PG8_STAGE(PG8_SB(1, 0), b3, voffB); PG8_STAGE(PG8_SB(1, 1), b3 + hstep, voffB); PG8_STAGE(PG8_SA(1, 0), a3, voffA);
            PG8_WAIT_V(8); PG8_WAIT_L(0); PG8_BAR; PG8_MMA(1, 0, At, B0); PG8_MMA(1, 1, At, B1); PG8_BAR; PG8_SCHED;
            } else {
            PG8_LDB(B0, 0, 0); PG8_SCHED; PG8_LDA(At, 0, 0); PG8_STAGE(PG8_SA(1, 1), a1 + hstep, voffA);
            PG8_WAIT_L(8); PG8_BAR; PG8_WAIT_L(0); PG8_MMA(0, 0, At, B0); PG8_BAR; PG8_SCHED;
            PG8_LDB(B1, 0, 1); PG8_STAGE(PG8_SB(0, 0), b2, voffB);
            PG8_BAR; PG8_WAIT_L(0); PG8_MMA(0, 1, At, B1); PG8_BAR;
            PG8_LDA(At, 0, 1); PG8_STAGE(PG8_SA(0, 0), a2, voffA);
            PG8_BAR; PG8_WAIT_L(0); PG8_MMA(1, 0, At, B0); PG8_BAR; PG8_SCHED;
            PG8_STAGE(PG8_SB(0, 1), b2 + hstep, voffB);
            PG8_WAIT_V(6); PG8_BAR; PG8_MMA(1, 1, At, B1); PG8_BAR;
            PG8_LDB(B0, 1, 0); PG8_SCHED; PG8_LDA(At, 1, 0); PG8_STAGE(PG8_SA(0, 1), a2 + hstep, voffA);
            PG8_WAIT_L(8); PG8_BAR; PG8_WAIT_L(0); PG8_MMA(0, 0, At, B0); PG8_BAR; PG8_SCHED;
            PG8_LDB(B1, 1, 1); PG8_STAGE(PG8_SB(1, 0), b3, voffB);
            PG8_BAR; PG8_WAIT_L(0); PG8_MMA(0, 1, At, B1); PG8_BAR;
            PG8_LDA(At, 1, 1); PG8_STAGE(PG8_SA(1, 0), a3, voffA);
            PG8_BAR; PG8_WAIT_L(0); PG8_MMA(1, 0, At, B0); PG8_BAR; PG8_SCHED;
            PG8_STAGE(PG8_SB(1, 1), b3 + hstep, voffB);
            PG8_WAIT_V(6); PG8_BAR; PG8_MMA(1, 1, At, B1); PG8_BAR;
            }
        }
        if constexpr (ALIGN_EPI) { if (wr == 0) PG8_BAR; }
        if constexpr (!Epi::AFTER_DRAIN) { E(acc, cur, wr, wc, fr, fq); S.done(cur); }
        if (!has_next) break;
#pragma unroll
        for (int a = 0; a < 2; ++a)
#pragma unroll
            for (int b = 0; b < 2; ++b)
#pragma unroll
                for (int m = 0; m < 4; ++m)
#pragma unroll
                    for (int n = 0; n < 2; ++n) acc[a][b][m][n] = (f32x4){0.f, 0.f, 0.f, 0.f};
        cur = nxt; cA = nA; cB = nB; ++ui;
        if constexpr (ALIGN_EPI) { if (wr == 1) PG8_BAR; }
    }
    PG8_WAIT_V(0);
    if constexpr (!ALIGN_EPI) { if (wr == 0) PG8_BAR; }
    PG8_BAR;
    if constexpr (Epi::AFTER_DRAIN) { E.fused(acc, cur, wr, wc, fr, fq, lds, wid, lane); S.done(cur); }
#undef PG8_SA
#undef PG8_SB
#undef PG8_STAGE
#undef PG8_LDA
#undef PG8_LDB
#undef PG8_MMA
#undef PG8_WAIT_V
#undef PG8_WAIT_L
#undef PG8_BAR
#undef PG8_SCHED
}
}
#define LAS __attribute__((address_space(3)))
#define DI __device__ __forceinline__
typedef unsigned short bf16;
typedef float f32x4 __attribute__((ext_vector_type(4)));
typedef float f32x16 __attribute__((ext_vector_type(16)));
typedef float f32x2 __attribute__((ext_vector_type(2)));
typedef unsigned u32x4 __attribute__((ext_vector_type(4)));
typedef unsigned u32x2 __attribute__((ext_vector_type(2)));
typedef short bf16x8 __attribute__((ext_vector_type(8)));
typedef short s16x4 __attribute__((ext_vector_type(4)));
typedef __bf16 bf16x2_t __attribute__((ext_vector_type(2)));

constexpr int NTHR = 512;
constexpr int DM = 1024, MPR = 16384, MVALID = 16512, MPAD = 16640, NZ = 3584, DIN = 3592, DFF = 2816, NU = 5632;
constexpr int SEQ = 8192;
constexpr float EPS = 1e-6f;
constexpr int LDS_BYTES = 147456 + 64;
constexpr size_t MiB = 1u << 20;
constexpr size_t WS_IG = 0, WS_LF = 512 * 1024, WS_BL = 1 * MiB, WS_AC = 1 * MiB + 8192, WS_MPREV = 1 * MiB + 16384, WS_NC = 2 * MiB, WS_NPREV = 3 * MiB;
constexpr size_t WS_BAR = 3 * MiB + 768 * 1024;
constexpr size_t WS_WIN = 4 * MiB, WS_WOUT = 11 * MiB + 512 * 1024, WS_WUP = 13 * MiB + 512 * 1024, WS_WDN = 24 * MiB + 512 * 1024;
constexpr size_t WS_ACT = 30 * MiB;
constexpr size_t WS_KC = 244 * MiB, WS_VC = 248 * MiB;
constexpr size_t WS_X16 = 63 * MiB;
constexpr size_t WS_R = 96 * MiB;
constexpr size_t WS_Z = WS_R, WS_SC = 210 * MiB;
constexpr size_t WS_MIX = WS_R;
constexpr size_t WS_UQ = WS_R, WS_G = 141 * MiB;
constexpr size_t WS_FFN = WS_R;
constexpr size_t WS_END = 256 * MiB;
static_assert(WS_Z + (size_t)MPAD * NZ * 2 <= WS_SC && WS_SC + (size_t)1056 * 32768 <= WS_KC && WS_X16 + (size_t)MVALID * DM * 2 <= WS_R, "ws stage 1");
static_assert(WS_UQ + (size_t)(MPAD / 4) * NU * 2 <= WS_G && WS_G + (size_t)MPAD * DFF * 2 <= WS_KC, "ws stage 3");
static_assert(WS_ACT + (size_t)MPAD * DM * 2 <= WS_X16 && WS_WDN + (size_t)DM * DFF * 2 <= WS_ACT, "ws fixed");
constexpr size_t O_X = 0, O_KP = 16908288, O_VP = O_KP + 1048576, O_CP = O_VP + 1048576, O_NP = O_CP + 262144, O_MP = O_NP + 2048, O_FP = O_MP + 16,
                 O_KS = O_FP + 45056, O_VS = O_KS + 131072, O_CS = O_VS + 131072, O_NS = O_CS + 1048576, O_MS = O_NS + 8192, O_FS = O_MS + 64, O_END = O_FS + 180224;

DI unsigned pk2(float lo, float hi) { f32x2 v = {lo, hi}; bf16x2_t b = __builtin_convertvector(v, bf16x2_t); return __builtin_bit_cast(unsigned, b); }
DI float bf2f(unsigned short b) { return __uint_as_float((unsigned)b << 16); }
DI float bflo(unsigned w) { return __uint_as_float(w << 16); }
DI float bfhi(unsigned w) { return __uint_as_float(w & 0xffff0000u); }
DI float wave_sum(float v) {
#pragma unroll
    for (int o = 1; o < 64; o <<= 1) v += __shfl_xor(v, o);
    return v;
}
DI float wave_max(float v) {
#pragma unroll
    for (int o = 1; o < 64; o <<= 1) v = fmaxf(v, __shfl_xor(v, o));
    return v;
}
#define MFMA32(a, b, c) __builtin_amdgcn_mfma_f32_32x32x16_bf16((a), (b), (c), 0, 0, 0)
DI s16x4 vtr(const LAS char* p) { return __builtin_bit_cast(s16x4, __builtin_amdgcn_ds_read_tr16_b64_v4i16((LAS s16x4*)p)); }
DI bf16x8 vtr2(const LAS char* p, int rows4_bytes) { s16x4 lo = vtr(p), hi = vtr(p + rows4_bytes); return __builtin_shufflevector(lo, hi, 0, 1, 2, 3, 4, 5, 6, 7); }
DI int crow(int i, int h) { return (i & 3) + 8 * (i >> 2) + 4 * h; }
DI bf16x8 pack8(const f32x16& x, int s) {
    u32x4 p; p.x = pk2(x[8 * s], x[8 * s + 1]); p.y = pk2(x[8 * s + 2], x[8 * s + 3]); p.z = pk2(x[8 * s + 4], x[8 * s + 5]); p.w = pk2(x[8 * s + 6], x[8 * s + 7]);
    return __builtin_bit_cast(bf16x8, p);
}
DI f32x16 zero16() { f32x16 z;
#pragma unroll
    for (int i = 0; i < 16; ++i) z[i] = 0.f; return z; }
#define LDS_FENCE() asm volatile("s_waitcnt lgkmcnt(0)" ::: "memory")

struct Args { const float* in[20]; float* out; unsigned char* ws; };
typedef const __attribute__((address_space(4))) Args* ArgsP;
DI ArgsP get_args() { ArgsP p = (ArgsP)__builtin_amdgcn_kernarg_segment_ptr(); asm volatile("" : "+s"(p)); return p; }
DI int get_bid() { int b = blockIdx.x; asm volatile("" : "+s"(b)); return b; }
DI int get_nb() { int b = gridDim.x; asm volatile("" : "+s"(b)); return b; }
DI int get_tid() { int t = threadIdx.x; asm volatile("" : "+v"(t)); return t; }

DI void transpose_item(const float* W, int ldw, int K, int nblk, bf16* WT, LAS float* scr, int item, int lane, bool perm_up = false, int cmax = (1 << 30)) {
    const int kb = item / nblk, nb = item % nblk, k0 = 64 * kb, n0 = 32 * nb;
    const int r0 = !perm_up ? n0 : (n0 < DFF ? 256 * (n0 >> 7) + (n0 & 127) : 256 * ((n0 - DFF) >> 7) + 128 + ((n0 - DFF) & 127));
    { int col0 = n0 + (lane & 7) * 4; col0 = col0 + 3 <= cmax ? col0 : cmax - 3;
      f32x4 v[8];
#pragma unroll
      for (int i = 0; i < 8; ++i) v[i] = __builtin_nontemporal_load((const f32x4*)(W + (size_t)(k0 + 8 * i + (lane >> 3)) * ldw + col0));
#pragma unroll
      for (int i = 0; i < 8; ++i) { const int kk = 8 * i + (lane >> 3); LAS float* d = scr + kk * 33 + (lane & 7) * 4; d[0] = v[i].x; d[1] = v[i].y; d[2] = v[i].z; d[3] = v[i].w; } }
    LDS_FENCE();
    const int c = lane & 7;
#pragma unroll
    for (int j = 0; j < 4; ++j) { const int n = (lane >> 3) + 8 * j; const LAS float* s = scr + (8 * c) * 33 + n;
        u32x4 o; o.x = pk2(s[0 * 33], s[1 * 33]); o.y = pk2(s[2 * 33], s[3 * 33]); o.z = pk2(s[4 * 33], s[5 * 33]); o.w = pk2(s[6 * 33], s[7 * 33]);
        *(u32x4*)(WT + (size_t)(r0 + n) * K + k0 + 8 * c) = o; }
    LDS_FENCE();
}
DI void phase_convert(int l, LAS unsigned char* lds) {
    const ArgsP a = get_args(); const int tid = get_tid(), lane = tid & 63, wave = tid >> 6;
    LAS float* scr = (LAS float*)(lds + wave * 8448);
    const int gw = get_bid() * 8 + wave, NGW = get_nb() * 8;
    constexpr int I_IN = 16 * 113, I_OUT = 16 * 32, I_UP = 16 * 176, I_DN = 44 * 32;
    const float* win = a->in[9] + (size_t)l * DM * DIN; const float* wout = a->in[15] + (size_t)l * DM * DM;
    const float* wup = a->in[16] + (size_t)l * DM * NU; const float* wdn = a->in[19] + (size_t)l * DFF * DM;
    for (int it = gw; it < I_IN + I_OUT + I_UP + I_DN; it += NGW) {
        int r = it;
        if (r < I_IN) { transpose_item(win, DIN, DM, 113, (bf16*)(a->ws + WS_WIN), scr, r, lane, false, DIN - 1); continue; } r -= I_IN;
        if (r < I_OUT) { transpose_item(wout, DM, DM, 32, (bf16*)(a->ws + WS_WOUT), scr, r, lane); continue; } r -= I_OUT;
        if (r < I_UP) { transpose_item(wup, NU, DM, 176, (bf16*)(a->ws + WS_WUP), scr, r, lane, true); continue; } r -= I_UP;
        transpose_item(wdn, DM, DFF, 32, (bf16*)(a->ws + WS_WDN), scr, r, lane);
    }
    {   const int gt0 = get_bid() * NTHR + tid, gstep = get_nb() * NTHR;
        for (int it0 = gt0; it0 < 2 * 262144; it0 += 4 * gstep) {
            f32x4 x0[4], x1[4];
#pragma unroll
            for (int k = 0; k < 4; ++k) { const int it = it0 + k * gstep; if (it < 2 * 262144) { const int kv = it >> 18, e = (it & 262143) * 8; const float* src = a->in[2 + kv] + (size_t)l * 2097152 + e; x0[k] = __builtin_nontemporal_load((const f32x4*)src); x1[k] = __builtin_nontemporal_load((const f32x4*)(src + 4)); } }
#pragma unroll
            for (int k = 0; k < 4; ++k) { const int it = it0 + k * gstep; if (it < 2 * 262144) { const int kv = it >> 18, e = (it & 262143) * 8;
                u32x4 w; w.x = pk2(x0[k].x, x0[k].y); w.y = pk2(x0[k].z, x0[k].w); w.z = pk2(x1[k].x, x1[k].y); w.w = pk2(x1[k].z, x1[k].w);
                *(u32x4*)((bf16*)(a->ws + (kv ? WS_VC : WS_KC)) + e) = w; } }
        } }
}

DI void phase_rows(LAS unsigned char* lds, bool first, const bf16* addsrc, const float* gadd, const float* gn, int gate_layer  , bool final) {
    const ArgsP a = get_args(); const int tid = get_tid(), lane = tid & 63, wave = tid >> 6;
    float* Y = a->out; bf16* X16 = (bf16*)(a->ws + WS_X16); bf16* ACT = (bf16*)(a->ws + WS_ACT);
    const int gw = get_bid() * 8 + wave, NGW = get_nb() * 8;
    float ga[16], gb[16];
#pragma unroll
    for (int j = 0; j < 2; ++j)
#pragma unroll
        for (int k = 0; k < 8; ++k) { ga[8 * j + k] = addsrc ? gadd[8 * lane + 512 * j + k] : 0.f; gb[8 * j + k] = gn ? gn[8 * lane + 512 * j + k] : 0.f; }
#define ROWS_LOAD(MM, VV, XX, FF) do { const int mm_ = (MM); \
        if (first) { const float* xr_ = mm_ < MPR ? a->in[0] + (size_t)mm_ * DM : a->in[1] + (size_t)(mm_ - MPR) * DM; \
            _Pragma("unroll") for (int j = 0; j < 2; ++j) { VV[2 * j] = *(const f32x4*)(xr_ + 8 * lane + 512 * j); VV[2 * j + 1] = *(const f32x4*)(xr_ + 8 * lane + 512 * j + 4); } } \
        else { _Pragma("unroll") for (int j = 0; j < 2; ++j) XX[j] = *(const u32x4*)(X16 + (size_t)mm_ * DM + 8 * lane + 512 * j); } \
        if (addsrc) { _Pragma("unroll") for (int j = 0; j < 2; ++j) FF[j] = *(const u32x4*)(addsrc + (size_t)mm_ * DM + 8 * lane + 512 * j); } } while (0)
    f32x4 vn[4], vn2[4]; u32x4 xn[2], fn[2], xn2[2], fn2[2];
#pragma unroll
    for (int j = 0; j < 4; ++j) { vn[j] = (f32x4){0.f, 0.f, 0.f, 0.f}; vn2[j] = vn[j]; }
#pragma unroll
    for (int j = 0; j < 2; ++j) { xn[j] = (u32x4){0u, 0u, 0u, 0u}; fn[j] = xn[j]; xn2[j] = xn[j]; fn2[j] = xn[j]; }
    if (gw < MVALID) ROWS_LOAD(gw, vn, xn, fn);
    if (gw + NGW < MVALID) ROWS_LOAD(gw + NGW, vn2, xn2, fn2);
    for (int m = gw; m < MVALID; m += NGW) {
        float v[16], f[16];
#pragma unroll
        for (int j = 0; j < 2; ++j) {
            if (first) {
#pragma unroll
                for (int k = 0; k < 4; ++k) { v[8 * j + k] = vn[2 * j][k]; v[8 * j + 4 + k] = vn[2 * j + 1][k]; }
            } else { v[8 * j] = bflo(xn[j].x); v[8 * j + 1] = bfhi(xn[j].x); v[8 * j + 2] = bflo(xn[j].y); v[8 * j + 3] = bfhi(xn[j].y); v[8 * j + 4] = bflo(xn[j].z); v[8 * j + 5] = bfhi(xn[j].z); v[8 * j + 6] = bflo(xn[j].w); v[8 * j + 7] = bfhi(xn[j].w); }
            f[8 * j] = bflo(fn[j].x); f[8 * j + 1] = bfhi(fn[j].x); f[8 * j + 2] = bflo(fn[j].y); f[8 * j + 3] = bfhi(fn[j].y); f[8 * j + 4] = bflo(fn[j].z); f[8 * j + 5] = bfhi(fn[j].z); f[8 * j + 6] = bflo(fn[j].w); f[8 * j + 7] = bfhi(fn[j].w);
        }
#pragma unroll
        for (int j = 0; j < 4; ++j) vn[j] = vn2[j];
#pragma unroll
        for (int j = 0; j < 2; ++j) { xn[j] = xn2[j]; fn[j] = fn2[j]; }
        if (m + 2 * NGW < MVALID) ROWS_LOAD(m + 2 * NGW, vn2, xn2, fn2);
        if (addsrc) {
            float s = 0.f;
#pragma unroll
            for (int k = 0; k < 16; ++k) s += f[k] * f[k];
            const float r = 1.0f / sqrtf(wave_sum(s) * (1.f / DM) + EPS);
#pragma unroll
            for (int k = 0; k < 16; ++k) v[k] = v[k] + f[k] * r * ga[k];
#pragma unroll
            for (int j = 0; j < 2; ++j) {
                if (final) { float* yp = Y + (size_t)m * DM + 8 * lane + 512 * j; __builtin_nontemporal_store((f32x4){v[8 * j], v[8 * j + 1], v[8 * j + 2], v[8 * j + 3]}, (f32x4*)yp); __builtin_nontemporal_store((f32x4){v[8 * j + 4], v[8 * j + 5], v[8 * j + 6], v[8 * j + 7]}, (f32x4*)(yp + 4)); }
                else { u32x4 o; o.x = pk2(v[8 * j], v[8 * j + 1]); o.y = pk2(v[8 * j + 2], v[8 * j + 3]); o.z = pk2(v[8 * j + 4], v[8 * j + 5]); o.w = pk2(v[8 * j + 6], v[8 * j + 7]); *(u32x4*)(X16 + (size_t)m * DM + 8 * lane + 512 * j) = o; } }
        }
        if (gn) {
            float s = 0.f;
#pragma unroll
            for (int k = 0; k < 16; ++k) s += v[k] * v[k];
            const float r = 1.0f / sqrtf(wave_sum(s) * (1.f / DM) + EPS);
#pragma unroll
            for (int j = 0; j < 2; ++j) { u32x4 o;
                o.x = pk2(v[8 * j] * r * gb[8 * j], v[8 * j + 1] * r * gb[8 * j + 1]); o.y = pk2(v[8 * j + 2] * r * gb[8 * j + 2], v[8 * j + 3] * r * gb[8 * j + 3]);
                o.z = pk2(v[8 * j + 4] * r * gb[8 * j + 4], v[8 * j + 5] * r * gb[8 * j + 5]); o.w = pk2(v[8 * j + 6] * r * gb[8 * j + 6], v[8 * j + 7] * r * gb[8 * j + 7]);
                *(u32x4*)(ACT + (size_t)m * DM + 8 * lane + 512 * j) = o; }
        }
    }
#undef ROWS_LOAD
}

DI void mini_gemm(LAS unsigned char* lds, const bf16* A, const bf16* Bt, int K, bf16* O) {
    const int tid = get_tid(), lane = tid & 63, wave = tid >> 6, fr = lane & 15, fq = lane >> 4;
    LAS float* red = (LAS float*)lds;
    const int ksl = K >> 3, k0 = wave * ksl, nks = ksl >> 5;
    for (int unit = get_bid(); unit < 256; unit += get_nb()) {
        const int rt = unit >> 5, ct = unit & 31;
        const bf16* ap = A + (size_t)(rt * 16 + fr) * K + k0 + 8 * fq;
        const bf16* bp0 = Bt + (size_t)(ct * 32 + fr) * K + k0 + 8 * fq; const bf16* bp1 = bp0 + (size_t)16 * K;
        f32x4 acc0 = {0.f, 0.f, 0.f, 0.f}, acc1 = {0.f, 0.f, 0.f, 0.f};
#pragma unroll 4
        for (int ks = 0; ks < nks; ++ks) { const bf16x8 av = *(const bf16x8*)(ap + 32 * ks), b0 = *(const bf16x8*)(bp0 + 32 * ks), b1 = *(const bf16x8*)(bp1 + 32 * ks);
            acc0 = __builtin_amdgcn_mfma_f32_16x16x32_bf16(av, b0, acc0, 0, 0, 0); acc1 = __builtin_amdgcn_mfma_f32_16x16x32_bf16(av, b1, acc1, 0, 0, 0); }
#pragma unroll
        for (int j = 0; j < 4; ++j) { red[(wave * 2 + 0) * 256 + j * 64 + lane] = acc0[j]; red[(wave * 2 + 1) * 256 + j * 64 + lane] = acc1[j]; }
        __syncthreads();
        { const int n = tid >> 8, idx = tid & 255, j = idx >> 6, ln = idx & 63; float s = 0.f;
#pragma unroll
          for (int w = 0; w < 8; ++w) s += red[(w * 2 + n) * 256 + idx];
          O[(size_t)(rt * 16 + 4 * (ln >> 4) + j) * DM + ct * 32 + 16 * n + (ln & 15)] = (bf16)(pk2(s, 0.f) & 0xffffu); }
        __syncthreads();
    }
}

constexpr int VP = 144;
DI void attn_step(const bf16x8 (&kf)[4], const bf16x8 (&qf)[4], f32x16 (&O)[2], float& mrun, float& lrun, const LAS float* tab, float bias_far, bool nearb, int dq  , int maskfrom  ,
                  const LAS char* vs, int kb, int h, int q4, int p4, int blk) {
    bf16x8 vf0[2], vf1[2];
#pragma unroll
    for (int dt = 0; dt < 2; ++dt) {
        vf0[dt] = vtr2(vs + (kb + 4 * h + q4) * VP + 2 * (32 * dt + 16 * blk) + 8 * p4, 8 * VP);
        vf1[dt] = vtr2(vs + (kb + 16 + 4 * h + q4) * VP + 2 * (32 * dt + 16 * blk) + 8 * p4, 8 * VP); }
    f32x16 S = zero16();
#pragma unroll
    for (int s = 0; s < 4; ++s) S = MFMA32(kf[s], qf[s], S);
    if (nearb) {
#pragma unroll
        for (int i = 0; i < 16; ++i) { int d = dq - ((i & 3) + 8 * (i >> 2)); d = d > 256 ? 256 : d; S[i] += tab[d + 63]; }
    } else {
#pragma unroll
        for (int i = 0; i < 16; ++i) S[i] += bias_far;
    }
    if (maskfrom < 64) {
#pragma unroll
        for (int i = 0; i < 16; ++i) if ((i & 3) + 8 * (i >> 2) + 4 * h >= maskfrom) S[i] = -1e30f;
    }
    float mx = S[0];
#pragma unroll
    for (int i = 1; i < 16; ++i) mx = fmaxf(mx, S[i]);
    mx = fmaxf(mx, __shfl_xor(mx, 32));
    const float mnew = fmaxf(mrun, mx), alpha = __builtin_amdgcn_exp2f(mrun - mnew);
    float rs = 0.f;
#pragma unroll
    for (int i = 0; i < 16; ++i) { S[i] = __builtin_amdgcn_exp2f(S[i] - mnew); rs += S[i]; }
    lrun = lrun * alpha + rs;
    if (__builtin_amdgcn_ballot_w64(mnew > mrun)) { O[0] *= alpha; O[1] *= alpha; }
    mrun = mnew;
    const bf16x8 pf0 = pack8(S, 0), pf1 = pack8(S, 1);
#pragma unroll
    for (int dt = 0; dt < 2; ++dt) { O[dt] = MFMA32(vf0[dt], pf0, O[dt]); O[dt] = MFMA32(vf1[dt], pf1, O[dt]); }
}
template <bool SAMPLE>
DI void attn_unit(int l, int bb, int c, int qhalf, LAS unsigned char* lds) {
    const ArgsP a = get_args(); const int tid = get_tid(), lane = tid & 63, hd = tid >> 6, r = lane & 31, h = lane >> 5;
    const int i16 = lane & 15, q4 = i16 >> 2, p4 = i16 & 3, blk = (lane >> 4) & 1;
    const bf16* Z = (const bf16*)(a->ws + WS_Z); bf16* ACT = (bf16*)(a->ws + WS_ACT);
    LAS char* vs = (LAS char*)(lds + hd * 9216);
    const LAS float* tab = (const LAS float*)(lds + 73728 + hd * 1280);
    LAS float* xs = (LAS float*)(lds + 73728 + 10240);
    const int qrow0 = SAMPLE ? MPR + bb * 16 : bb * SEQ + c * 64;
    const bf16* kc16 = (const bf16*)(a->ws + WS_KC) + (size_t)(bb * 8 + hd) * 512 * 64;
    const bf16* vc16 = (const bf16*)(a->ws + WS_VC) + (size_t)(bb * 8 + hd) * 512 * 64;
    bf16x8 qf[4];
    { const int qr = SAMPLE ? (r < 16 ? r : 15) : 32 * qhalf + r;
#pragma unroll
      for (int s = 0; s < 4; ++s) qf[s] = *(const bf16x8*)(Z + (size_t)(qrow0 + qr) * NZ + hd * 64 + 16 * s + 8 * h); }
    f32x16 O[2]; O[0] = zero16(); O[1] = zero16(); float mrun = -1e30f, lrun = 0.f;
    const float bias_far = tab[319];
    const int q = 32 * qhalf + r;
    const int jstart = SAMPLE ? 0 : (c >= 8 ? 0 : 8 - c);
#define ATT_SRC(J) const bf16* kb_; const bf16* vb_; int pitch_, rmax_; \
    if (SAMPLE && (J) < 8) { kb_ = kc16 + (size_t)(64 * (J)) * 64; vb_ = vc16 + (size_t)(64 * (J)) * 64; pitch_ = 64; rmax_ = 63; } \
    else if (SAMPLE) { kb_ = Z + (size_t)qrow0 * NZ + 512 + hd * 64; vb_ = kb_ + 512; pitch_ = NZ; rmax_ = 15; } \
    else { kb_ = Z + (size_t)(bb * SEQ + (c + (J) - 8) * 64) * NZ + 512 + hd * 64; vb_ = kb_ + 512; pitch_ = NZ; rmax_ = 63; }
#define ATT_LOADK(J, KS, KF) do { ATT_SRC(J) int kr_ = 32 * (KS) + r; kr_ = kr_ > rmax_ ? rmax_ : kr_; (void)vb_; \
    _Pragma("unroll") for (int s = 0; s < 4; ++s) KF[s] = *(const bf16x8*)(kb_ + (size_t)kr_ * pitch_ + 16 * s + 8 * h); } while (0)
#define ATT_LOADV(J, VR) do { ATT_SRC(J) (void)kb_; \
    _Pragma("unroll") for (int it = 0; it < 8; ++it) { int key_ = it * 8 + (lane >> 3); key_ = key_ > rmax_ ? rmax_ : key_; VR[it] = *(const u32x4*)(vb_ + (size_t)key_ * pitch_ + (lane & 7) * 8); } } while (0)
    bf16x8 kA[4], kB[4]; u32x4 vr[8];
    ATT_LOADK(jstart, 0, kA);
    ATT_LOADV(jstart, vr);
#pragma unroll 1
    for (int j = jstart; j < 9; ++j) {
        LDS_FENCE();
#pragma unroll
        for (int it = 0; it < 8; ++it) *(LAS u32x4*)(vs + (it * 8 + (lane >> 3)) * VP + (lane & 7) * 16) = vr[it];
        if (j < 8) ATT_LOADV(j + 1, vr);
        ATT_LOADK(j, 1, kB);
        LDS_FENCE();
        const bool nearb = j >= 4; const int mf = (SAMPLE && j == 8) ? 16 : 64;
        attn_step(kA, qf, O, mrun, lrun, tab, bias_far, nearb, 512 + q - (64 * j + 4 * h), mf, vs, 0, h, q4, p4, blk);
        if (j < 8) ATT_LOADK(j + 1, 0, kA);
        if (!(SAMPLE && j == 8)) attn_step(kB, qf, O, mrun, lrun, tab, bias_far, nearb, 512 + q - (64 * j + 32 + 4 * h), 64, vs, 32, h, q4, p4, blk);
    }
#undef ATT_SRC
#undef ATT_LOADK
#undef ATT_LOADV
    const float lt = lrun + __shfl_xor(lrun, 32); const float inv = 1.0f / lt; float ssq = 0.f;
#pragma unroll
    for (int dt = 0; dt < 2; ++dt) { O[dt] *= inv;
#pragma unroll
        for (int i = 0; i < 16; ++i) ssq += O[dt][i] * O[dt][i]; }
    ssq += __shfl_xor(ssq, 32);
    if (h == 0) xs[hd * 64 + 32 * qhalf + r] = ssq;
    __syncthreads();
    const float* gatt = a->in[13] + l * 512 + hd * 64;
    float tot = 0.f;
#pragma unroll
    for (int w = 0; w < 8; ++w) tot += xs[w * 64 + 32 * qhalf + r];
    const float rr = 1.0f / sqrtf(tot * (1.f / 512.f) + EPS);
    const bool ok = SAMPLE ? (r < 16) : true;
    bf16* orow = ACT + (size_t)(qrow0 + 32 * qhalf + r) * DM + hd * 64;
    if (ok) {
#pragma unroll
        for (int dt = 0; dt < 2; ++dt)
#pragma unroll
            for (int g = 0; g < 4; ++g) { const int e0 = 32 * dt + 8 * g + 4 * h; const f32x4 gv = *(const f32x4*)(gatt + e0);
                u32x2 o; o.x = pk2(O[dt][4 * g] * rr * gv.x, O[dt][4 * g + 1] * rr * gv.y); o.y = pk2(O[dt][4 * g + 2] * rr * gv.z, O[dt][4 * g + 3] * rr * gv.w);
                *(u32x2*)(orow + e0) = o; }
    }
    __syncthreads();
}

constexpr int MPB = 288;
DI void m1_item(bool sample, int bb, int c, LAS unsigned char* lds, int hp = -1  ) {
    const ArgsP a = get_args(); const int tid = get_tid(), lane = tid & 63, wave = tid >> 6, head = wave >> 1, half = wave & 1, r = lane & 31, h = lane >> 5;
    const int i16 = lane & 15, q4 = i16 >> 2, p4 = i16 & 3, blk = (lane >> 4) & 1;
    const bf16* Z = (const bf16*)(a->ws + WS_Z); const float* IG = (const float*)(a->ws + WS_IG); const float* LF = (const float*)(a->ws + WS_LF);
    bf16* SC = (bf16*)(a->ws + WS_SC);
    const int row0 = sample ? MPR + bb * 16 : bb * SEQ + c * 64;
    const int u = sample ? 1024 + bb * 4 + head : (bb * 4 + head) * 128 + c;
    const bool act = (hp < 0) || ((head >> 1) == hp);
    u32x4 st16[16];
#pragma unroll
    for (int it = 0; it < 16; ++it) { const int rr = it * 4 + (lane >> 4), ch = lane & 15; const int srow = row0 + (sample ? (rr < 16 ? rr : 15) : rr);
        st16[it] = *(const u32x4*)(Z + (size_t)srow * NZ + (half == 0 ? 2048 : 2560) + head * 128 + ch * 8); }
    const bool valid = sample ? (lane < 16) : true;
    const int rs = row0 + (sample ? (lane < 16 ? lane : 15) : lane);
    float b = valid ? LF[(size_t)rs * 4 + head] : 0.f; const float ig = valid ? IG[(size_t)rs * 4 + head] : -INFINITY;
#pragma unroll
    for (int o = 1; o < 64; o <<= 1) { const float t = __shfl_up(b, o); if (lane >= o) b += t; }
    const float av = ig - b; const float ac = wave_max(av); const float w = __expf(av - ac); const float bl = __shfl(b, 63);
    if (act && half == 0 && lane == 0) { ((float*)(a->ws + WS_BL))[u] = bl; ((float*)(a->ws + WS_AC))[u] = ac; }
    LAS char* kbase = (LAS char*)(lds + head * 36864); LAS char* vbase = kbase + 18432;
#pragma unroll
    for (int it = 0; it < 16; ++it) { const int rr = it * 4 + (lane >> 4), ch = lane & 15;
        const float wr = __shfl(w, rr); const u32x4 x = st16[it];
        if (half == 0) { u32x4 o;
            o.x = pk2(bflo(x.x) * wr, bfhi(x.x) * wr); o.y = pk2(bflo(x.y) * wr, bfhi(x.y) * wr); o.z = pk2(bflo(x.z) * wr, bfhi(x.z) * wr); o.w = pk2(bflo(x.w) * wr, bfhi(x.w) * wr);
            *(LAS u32x4*)(kbase + rr * MPB + ch * 16) = o; }
        else *(LAS u32x4*)(vbase + rr * MPB + ch * 16) = x;
    }
    __syncthreads();
    if (act) {
#pragma unroll
    for (int dh = 0; dh < 2; ++dh) {
        f32x16 acc[2][2];
#pragma unroll
        for (int di = 0; di < 2; ++di) { acc[di][0] = zero16(); acc[di][1] = zero16(); }
#pragma unroll
        for (int ks = 0; ks < 4; ++ks) {
            bf16x8 af[2], bfr[2];
#pragma unroll
            for (int di = 0; di < 2; ++di) af[di] = vtr2(kbase + (16 * ks + 8 * h + q4) * MPB + 2 * (32 * (2 * dh + di) + 16 * blk) + 8 * p4, 4 * MPB);
#pragma unroll
            for (int ei = 0; ei < 2; ++ei) bfr[ei] = vtr2(vbase + (16 * ks + 8 * h + q4) * MPB + 2 * (32 * (2 * half + ei) + 16 * blk) + 8 * p4, 4 * MPB);
#pragma unroll
            for (int di = 0; di < 2; ++di)
#pragma unroll
                for (int ei = 0; ei < 2; ++ei) acc[di][ei] = MFMA32(af[di], bfr[ei], acc[di][ei]);
        }
#pragma unroll
        for (int di = 0; di < 2; ++di)
#pragma unroll
            for (int ei = 0; ei < 2; ++ei)
#pragma unroll
                for (int g = 0; g < 4; ++g) { const int e = 32 * (2 * half + ei) + r, d0 = 32 * (2 * dh + di) + 8 * g + 4 * h;
                    u32x2 o; o.x = pk2(acc[di][ei][4 * g], acc[di][ei][4 * g + 1]); o.y = pk2(acc[di][ei][4 * g + 2], acc[di][ei][4 * g + 3]);
                    *(u32x2*)(SC + (size_t)u * 16384 + e * 128 + d0) = o; }
    }
    { const int d = half * 64 + lane; float s = 0.f;
#pragma unroll 8
      for (int sidx = 0; sidx < 64; ++sidx) s += bf2f(*(const LAS unsigned short*)(kbase + sidx * MPB + d * 2));
      ((float*)(a->ws + WS_NC))[(size_t)u * 128 + d] = s; }
    }
    __syncthreads();
}

DI void phase_c_pre(int l) {
    const ArgsP a = get_args(); const int tid = get_tid();
    const bf16* Z = (const bf16*)(a->ws + WS_Z);
    for (int it = get_bid() * NTHR + tid; it < 147456; it += get_nb() * NTHR) {
        int row, kv, cc; float* dst;
        if (it < 131072) { const int b = it >> 16, t = (it >> 7) & 511; kv = (it >> 6) & 1; cc = it & 63; row = b * SEQ + (SEQ - 512) + t;
            dst = a->out + (kv ? O_VP : O_KP) + ((size_t)((l * 2 + b) * 8 + (cc >> 3)) * 512 + t) * 64 + (cc & 7) * 8; }
        else { const int i2 = it - 131072; const int rr = i2 >> 7; kv = (i2 >> 6) & 1; cc = i2 & 63; row = MPR + rr; const int sb = rr >> 4, t = rr & 15;
            dst = a->out + (kv ? O_VS : O_KS) + ((size_t)((l * 8 + sb) * 8 + (cc >> 3)) * 16 + t) * 64 + (cc & 7) * 8; }
        const u32x4 x = *(const u32x4*)(Z + (size_t)row * NZ + 512 + kv * 512 + cc * 8);
        f32x4 o0 = {bflo(x.x), bfhi(x.x), bflo(x.y), bfhi(x.y)}, o1 = {bflo(x.z), bfhi(x.z), bflo(x.w), bfhi(x.w)};
        __builtin_nontemporal_store(o0, (f32x4*)dst); __builtin_nontemporal_store(o1, (f32x4*)(dst + 4));
    }
}

DI void phase_m2(int l, LAS unsigned char* lds) {
    const ArgsP a = get_args(); const int tid = get_tid(), lane = tid & 63;
    bf16* SC = (bf16*)(a->ws + WS_SC); const float* BL = (const float*)(a->ws + WS_BL); const float* AC = (const float*)(a->ws + WS_AC);
    float* MPREV = (float*)(a->ws + WS_MPREV); const float* NC = (const float*)(a->ws + WS_NC); float* NPREV = (float*)(a->ws + WS_NPREV);
    LAS float* DEC = (LAS float*)lds; LAS float* SCL = DEC + 128;
    const int NTH = get_nb() * NTHR;
    for (int base = get_bid() * NTHR; base < 8 * 16384; base += NTH) {
        const int bh = base >> 14, el = (base & 16383) + tid; const bool doN = el < 128;
        __syncthreads();
        if (tid < 64) {
            float Fc = 0.f, gc = 0.f;
#pragma unroll
            for (int rd = 0; rd < 2; ++rd) {
                const int c = rd * 64 + lane, u = bh * 128 + c; const float bl = BL[u], ac = AC[u];
                float F = bl;
#pragma unroll
                for (int o = 1; o < 64; o <<= 1) { const float t = __shfl_up(F, o); if (lane >= o) F += t; }
                F += Fc;
                float Fm1 = __shfl_up(F, 1); if (lane == 0) Fm1 = Fc;
                float g = ac - Fm1;
#pragma unroll
                for (int o = 1; o < 64; o <<= 1) { const float t = __shfl_up(g, o); if (lane >= o) g = fmaxf(g, t); }
                g = fmaxf(g, gc);
                float gm1 = __shfl_up(g, 1); if (lane == 0) gm1 = gc;
                const float mprev = Fm1 + gm1, mnew = F + g;
                DEC[c] = expf(bl + mprev - mnew); SCL[c] = expf(bl + ac - mnew);
                if ((base & 16383) == 0) { MPREV[u] = mprev; if (c == 127) a->out[O_MP + l * 8 + bh] = mnew; }
                Fc = __shfl(F, 63); gc = __shfl(g, 63);
            }
        }
        __syncthreads();
        float C = 0.f, n = 0.f;
#pragma unroll 1
        for (int c0 = 0; c0 < 128; c0 += 32) {
            float s[32];
#pragma unroll
            for (int k = 0; k < 32; ++k) s[k] = bf2f(SC[(size_t)(bh * 128 + c0 + k) * 16384 + el]);
            if (doN) {
                float nc[32];
#pragma unroll
                for (int k = 0; k < 32; ++k) nc[k] = NC[(size_t)(bh * 128 + c0 + k) * 128 + el];
#pragma unroll
                for (int k = 0; k < 32; ++k) { NPREV[(size_t)(bh * 128 + c0 + k) * 128 + el] = n; n = DEC[c0 + k] * n + SCL[c0 + k] * nc[k]; }
            }
#pragma unroll
            for (int k = 0; k < 32; ++k) { SC[(size_t)(bh * 128 + c0 + k) * 16384 + el] = (bf16)(pk2(C, 0.f) & 0xffffu); C = DEC[c0 + k] * C + SCL[c0 + k] * s[k]; }
        }
        const int e = el >> 7, d = el & 127;
        a->out[O_CP + (size_t)(l * 8 + bh) * 16384 + d * 128 + e] = C;
        if (doN) a->out[O_NP + (size_t)(l * 8 + bh) * 128 + el] = n;
    }
}

DI void m3_item(int l, bool sample, int bb, int c, LAS unsigned char* lds, int hp = -1) {
    const ArgsP a = get_args(); const int tid = get_tid(), lane = tid & 63, wave = tid >> 6, head = wave >> 1, tt = wave & 1, r = lane & 31, h = lane >> 5;
    const int i16 = lane & 15, q4 = i16 >> 2, p4 = i16 & 3, blk = (lane >> 4) & 1;
    const bf16* Z = (const bf16*)(a->ws + WS_Z); const float* IG = (const float*)(a->ws + WS_IG); const float* LF = (const float*)(a->ws + WS_LF);
    const bf16* SC = (const bf16*)(a->ws + WS_SC); bf16* ACT = (bf16*)(a->ws + WS_ACT);
    const int row0 = sample ? MPR + bb * 16 : bb * SEQ + c * 64;
    const int u = sample ? 1024 + bb * 4 + head : (bb * 4 + head) * 128 + c;
    LAS char* vbase = (LAS char*)(lds + head * 18432);
    LAS float* AS = (LAS float*)(lds + 73728) + head * 64; LAS float* BS = (LAS float*)(lds + 73728 + 1024) + head * 64;
    LAS float* MT = (LAS float*)(lds + 73728 + 2048) + head * 64; LAS float* NP = (LAS float*)(lds + 73728 + 3072) + head * 128;
    const float mprev = ((const float*)(a->ws + WS_MPREV))[u];
    {
        const bool valid = sample ? (lane < 16) : true;
        const int rs = row0 + (sample ? (lane < 16 ? lane : 15) : lane);
        float b = valid ? LF[(size_t)rs * 4 + head] : 0.f; const float ig = valid ? IG[(size_t)rs * 4 + head] : -INFINITY;
#pragma unroll
        for (int o = 1; o < 64; o <<= 1) { const float t = __shfl_up(b, o); if (lane >= o) b += t; }
        const float av = ig - b; float cm = av;
#pragma unroll
        for (int o = 1; o < 64; o <<= 1) { const float t = __shfl_up(cm, o); if (lane >= o) cm = fmaxf(cm, t); }
        const float mt = b + fmaxf(mprev, cm);
        if (tt == 0) { AS[lane] = av; BS[lane] = b; MT[lane] = mt; const float* np = (const float*)(a->ws + WS_NPREV) + (size_t)u * 128; NP[lane] = np[lane]; NP[64 + lane] = np[64 + lane]; }
    }
#pragma unroll
    for (int hb = 0; hb < 2; ++hb) {
        u32x4 vst[4];
#pragma unroll
        for (int it = 0; it < 4; ++it) { const int idx = (4 * hb + it) * 128 + tt * 64 + lane; const int rr = idx >> 4, ch = idx & 15; const int srow = row0 + (sample ? (rr < 16 ? rr : 15) : rr);
            vst[it] = *(const u32x4*)(Z + (size_t)srow * NZ + 2560 + head * 128 + ch * 8); }
#pragma unroll
        for (int it = 0; it < 4; ++it) { const int idx = (4 * hb + it) * 128 + tt * 64 + lane; const int rr = idx >> 4, ch = idx & 15; *(LAS u32x4*)(vbase + rr * MPB + ch * 16) = vst[it]; }
    }
    const int t = 32 * tt + r;
    const int rowt = row0 + (sample ? (t < 16 ? t : 15) : t);
    bf16x8 qf[8];
#pragma unroll
    for (int s = 0; s < 8; ++s) qf[s] = *(const bf16x8*)(Z + (size_t)rowt * NZ + 1536 + head * 128 + 16 * s + 8 * h);
    bf16x8 scf[2][8], kf0[8];
#pragma unroll
    for (int et = 0; et < 2; ++et)
#pragma unroll
        for (int s = 0; s < 8; ++s) scf[et][s] = *(const bf16x8*)(SC + (size_t)u * 16384 + (32 * et + r) * 128 + 16 * s + 8 * h);
    { const int krow = row0 + (sample ? (r < 16 ? r : 15) : r);
#pragma unroll
      for (int s = 0; s < 8; ++s) kf0[s] = *(const bf16x8*)(Z + (size_t)krow * NZ + 2048 + head * 128 + 16 * s + 8 * h); }
    __syncthreads();
    if (!(sample && tt == 1) && ((hp < 0) || ((head >> 1) == hp))) {
        f32x16 acc[4];
#pragma unroll
        for (int et = 0; et < 2; ++et) { acc[et] = zero16();
#pragma unroll
            for (int s = 0; s < 8; ++s) acc[et] = MFMA32(scf[et][s], qf[s], acc[et]); }
#pragma unroll
        for (int et = 2; et < 4; ++et) { acc[et] = zero16();
#pragma unroll
            for (int s = 0; s < 8; ++s) { const bf16x8 af = *(const bf16x8*)(SC + (size_t)u * 16384 + (32 * et + r) * 128 + 16 * s + 8 * h); acc[et] = MFMA32(af, qf[s], acc[et]); } }
        const float bt = BS[t], mtt = MT[t]; const float wint = __expf(bt + mprev - mtt);
#pragma unroll
        for (int et = 0; et < 4; ++et) acc[et] *= wint;
        float qn = 0.f;
#pragma unroll
        for (int s = 0; s < 8; ++s)
#pragma unroll
            for (int jj = 0; jj < 8; ++jj) qn += bf2f((unsigned short)qf[s][jj]) * NP[16 * s + 8 * h + jj];
        qn += __shfl_xor(qn, 32);
        float den = wint * qn, denp = 0.f;
        u32x2 ogv[4][4];
#pragma unroll
        for (int et = 0; et < 4; ++et)
#pragma unroll
            for (int g = 0; g < 4; ++g) ogv[et][g] = *(const u32x2*)(Z + (size_t)rowt * NZ + 3072 + head * 128 + 32 * et + 8 * g + 4 * h);
        for (int st = 0; st <= tt; ++st) {
            f32x16 S = zero16();
            const int kr = 32 * st + r; const int krow = row0 + (sample ? (kr < 16 ? kr : 15) : kr);
            if (st == 0) {
#pragma unroll
                for (int s = 0; s < 8; ++s) S = MFMA32(kf0[s], qf[s], S);
            } else {
#pragma unroll
                for (int s = 0; s < 8; ++s) { const bf16x8 kf = *(const bf16x8*)(Z + (size_t)krow * NZ + 2048 + head * 128 + 16 * s + 8 * h); S = MFMA32(kf, qf[s], S); }
            }
#pragma unroll
            for (int i = 0; i < 16; ++i) { const int sl = 32 * st + (i & 3) + 8 * (i >> 2) + 4 * h; const float wgt = (sl <= t) ? __expf(bt + AS[sl] - mtt) : 0.f; S[i] *= wgt; denp += S[i]; }
            const bf16x8 pf0 = pack8(S, 0), pf1 = pack8(S, 1);
#pragma unroll
            for (int et = 0; et < 4; ++et) {
                const bf16x8 v0 = vtr2(vbase + (32 * st + 4 * h + q4) * MPB + 2 * (32 * et + 16 * blk) + 8 * p4, 8 * MPB);
                const bf16x8 v1 = vtr2(vbase + (32 * st + 16 + 4 * h + q4) * MPB + 2 * (32 * et + 16 * blk) + 8 * p4, 8 * MPB);
                acc[et] = MFMA32(v0, pf0, acc[et]); acc[et] = MFMA32(v1, pf1, acc[et]);
            }
        }
        den += denp + __shfl_xor(denp, 32);
        const float dd = fmaxf(fabsf(den), __expf(-mtt)); const float inv = 1.0f / dd;
        float ssq = 0.f;
#pragma unroll
        for (int et = 0; et < 4; ++et) { acc[et] *= inv;
#pragma unroll
            for (int i = 0; i < 16; ++i) ssq += acc[et][i] * acc[et][i]; }
        ssq += __shfl_xor(ssq, 32);
        const float rr = 1.0f / sqrtf(ssq * (1.f / 128.f) + EPS);
        const bool ok = sample ? (t < 16) : true;
        if (ok) {
            const float* gml = a->in[14] + l * 512 + head * 128;
#pragma unroll
            for (int et = 0; et < 4; ++et)
#pragma unroll
                for (int g = 0; g < 4; ++g) { const int e0 = 32 * et + 8 * g + 4 * h;
                    const u32x2 ob = ogv[et][g]; const f32x4 gm = *(const f32x4*)(gml + e0);
                    const float o0 = bflo(ob.x), o1 = bfhi(ob.x), o2 = bflo(ob.y), o3 = bfhi(ob.y);
                    const float y0 = acc[et][4 * g] * rr * gm.x * __builtin_amdgcn_rcpf(1.f + __expf(-o0)), y1 = acc[et][4 * g + 1] * rr * gm.y * __builtin_amdgcn_rcpf(1.f + __expf(-o1));
                    const float y2 = acc[et][4 * g + 2] * rr * gm.z * __builtin_amdgcn_rcpf(1.f + __expf(-o2)), y3 = acc[et][4 * g + 3] * rr * gm.w * __builtin_amdgcn_rcpf(1.f + __expf(-o3));
                    u32x2 o; o.x = pk2(y0, y1); o.y = pk2(y2, y3);
                    *(u32x2*)(ACT + (size_t)rowt * DM + 512 + head * 128 + e0) = o; }
        }
    }
    __syncthreads();
}
DI void sample_m2(int l, int sb, int hp, LAS unsigned char* lds) {
    const ArgsP a = get_args(); const int tid = get_tid();
    bf16* SC = (bf16*)(a->ws + WS_SC); const float* BL = (const float*)(a->ws + WS_BL); const float* AC = (const float*)(a->ws + WS_AC);
    float* MPREV = (float*)(a->ws + WS_MPREV); const float* NC = (const float*)(a->ws + WS_NC); float* NPREV = (float*)(a->ws + WS_NPREV);
    LAS float* Lc = (LAS float*)lds; LAS float* Ls = Lc + 128 * 129;
    for (int hh = 2 * hp; hh < 2 * hp + 2; ++hh) {
        const int su = sb * 4 + hh, u = 1024 + su;
        const float* c0p = a->in[4] + (size_t)(l * 32 + su) * 16384; bf16* scp = SC + (size_t)u * 16384; float* ocp = a->out + O_CS + (size_t)(l * 32 + su) * 16384;
        const float m0 = a->in[6][l * 32 + su];
        const float bl = BL[u], ac = AC[u]; const float mn = bl + fmaxf(m0, ac); const float dec = expf(bl + m0 - mn), sc = expf(bl + ac - mn);
#pragma unroll 1
        for (int i0 = 0; i0 < 32; i0 += 16) {
            float cv[16]; unsigned short sv[16];
#pragma unroll
            for (int ii = 0; ii < 16; ++ii) { const int idx = tid + (i0 + ii) * NTHR; cv[ii] = c0p[idx]; sv[ii] = scp[idx]; }
#pragma unroll
            for (int ii = 0; ii < 16; ++ii) { const int idx = tid + (i0 + ii) * NTHR; const int r = idx >> 7, q = idx & 127; Lc[r * 129 + q] = cv[ii]; Ls[r * 129 + q] = bf2f(sv[ii]); }
        }
        __syncthreads();
#pragma unroll
        for (int ii = 0; ii < 32; ++ii) { const int idx = tid + ii * NTHR; const int r = idx >> 7, q = idx & 127;
            scp[idx] = (bf16)(pk2(Lc[q * 129 + r], 0.f) & 0xffffu);
            ocp[idx] = dec * Lc[r * 129 + q] + sc * Ls[q * 129 + r]; }
        if (tid < 128) { const float n0 = a->in[5][(size_t)(l * 32 + su) * 128 + tid]; NPREV[(size_t)u * 128 + tid] = n0; a->out[O_NS + (size_t)(l * 32 + su) * 128 + tid] = dec * n0 + sc * NC[(size_t)u * 128 + tid]; }
        if (tid == 0) { MPREV[u] = m0; a->out[O_MS + l * 32 + su] = mn; }
        __syncthreads();
    }
}
#define BLOCK_MEM_SYNC() do { asm volatile("s_waitcnt vmcnt(0)" ::: "memory"); __syncthreads(); __builtin_amdgcn_fence(__ATOMIC_ACQUIRE, "agent"); asm volatile("s_waitcnt vmcnt(0)" ::: "memory"); } while (0)
DI void load_bias(int l, LAS unsigned char* lds) {
    const ArgsP a = get_args(); const int tid = get_tid();
    for (int e = tid; e < 8 * 320; e += NTHR) { const int hd = e / 320, i = e % 320; ((LAS float*)(lds + 73728))[hd * 320 + i] = a->in[12][(size_t)(l * 8 + hd) * 513 + 193 + i] * 1.4426950408889634f; }
    __syncthreads();
}
DI void phase_c(int l, LAS unsigned char* lds) {
    phase_c_pre(l);
    const int bid = get_bid(), nb = get_nb();
    const bool deal = (nb == 256);
    const int v = deal ? ((bid & 7) * 32 + (bid >> 3)) : bid;
    for (int t = v; t < 16; t += nb) {
        m1_item(true, t >> 1, 0, lds, t & 1);
        BLOCK_MEM_SYNC();
        sample_m2(l, t >> 1, t & 1, lds);
        BLOCK_MEM_SYNC();
        m3_item(l, true, t >> 1, 0, lds, t & 1);
    }
    int p_lo, p_hi, p_st, m_lo, m_hi, m_st;
    if (deal) { const int w = v - 16; p_lo = w < 0 ? 520 : (w * 520) / 240; p_hi = w < 0 ? 520 : ((w + 1) * 520) / 240; p_st = 1;
                const int r2 = 3 * w - p_lo; const bool two = (w >= 0) && (p_hi - p_lo == 2); m_lo = two ? (r2 * 256) / 200 : 256; m_hi = two ? ((r2 + 1) * 256) / 200 : 256; m_st = 1; }
    else { p_lo = bid; p_hi = 520; p_st = nb; m_lo = bid; m_hi = 256; m_st = nb; }
    if (p_lo < p_hi) load_bias(l, lds);
    for (int p = p_lo; p < p_hi; p += p_st) {
        if (p >= 512) attn_unit<true>(l, p - 512, 0, 0, lds);
        else attn_unit<false>(l, p >> 8, (p >> 1) & 127, p & 1, lds);
    }
    __syncthreads();
    for (int t = m_lo; t < m_hi; t += m_st) m1_item(false, t >> 7, t & 127, lds);
}
DI void phase_e(int l, LAS unsigned char* lds) {
    for (int it = get_bid(); it < 256; it += get_nb()) m3_item(l, false, it >> 7, it & 127, lds);
}

DI float gelu_tanh(float x) { const float ee = __builtin_amdgcn_exp2f(x * (2.3022082f + 0.10294324f * x * x)); return x - x * __builtin_amdgcn_rcpf(ee + 1.f); }
DI void ld8(const bf16* p, float (&o)[8]) { const u32x4 x = *(const u32x4*)p; o[0] = bflo(x.x); o[1] = bfhi(x.x); o[2] = bflo(x.y); o[3] = bfhi(x.y); o[4] = bflo(x.z); o[5] = bfhi(x.z); o[6] = bflo(x.w); o[7] = bfhi(x.w); }
DI void ldf8(const float* p, float (&o)[8]) { const f32x4 x = *(const f32x4*)p, y = *(const f32x4*)(p + 4); o[0] = x.x; o[1] = x.y; o[2] = x.z; o[3] = x.w; o[4] = y.x; o[5] = y.y; o[6] = y.z; o[7] = y.w; }
DI void phase_fix(int l) {
    const ArgsP a = get_args(); const int gt = get_bid() * NTHR + get_tid(), NTH = get_nb() * NTHR;
    const bf16* UQ = (const bf16*)(a->ws + WS_UQ); bf16* G = (bf16*)(a->ws + WS_G);
    const float* wc = a->in[17] + (size_t)l * 3 * NU; const float* bc = a->in[18] + (size_t)l * NU;
    for (int item = gt; item < (MVALID / 16) * 352; item += NTH) {
        const int k = item / 352, cc = item % 352, j0 = cc * 8; const int m0 = 16 * k;
        const bool smp = m0 >= MPR; const bool bstart = smp ? true : ((m0 & (SEQ - 1)) == 0); const int sb = smp ? (m0 - MPR) >> 4 : 0;
        float w0g[8], w1g[8], w2g[8], bg[8], w0u[8], w1u[8], w2u[8], bu[8];
        ldf8(wc + j0, w0g); ldf8(wc + NU + j0, w1g); ldf8(wc + 2 * NU + j0, w2g); ldf8(bc + j0, bg);
        ldf8(wc + DFF + j0, w0u); ldf8(wc + NU + DFF + j0, w1u); ldf8(wc + 2 * NU + DFF + j0, w2u); ldf8(bc + DFF + j0, bu);
        float p2g[8], p1g[8], p2u[8], p1u[8], c0g[8], c0u[8], c1g[8], c1u[8];
        if (bstart) {
            if (smp) { const float* cb = a->in[7] + (size_t)((l * 8 + sb) * 2) * NU; ldf8(cb + j0, p2g); ldf8(cb + NU + j0, p1g); ldf8(cb + DFF + j0, p2u); ldf8(cb + NU + DFF + j0, p1u); }
            else {
#pragma unroll
                for (int q = 0; q < 8; ++q) { p2g[q] = 0.f; p1g[q] = 0.f; p2u[q] = 0.f; p1u[q] = 0.f; } }
        } else { const bf16* pq = UQ + (size_t)(4 * (k - 1) + 2) * NU; ld8(pq + j0, p2g); ld8(pq + NU + j0, p1g); ld8(pq + DFF + j0, p2u); ld8(pq + NU + DFF + j0, p1u); }
        const bf16* cq = UQ + (size_t)(4 * k) * NU; ld8(cq + j0, c0g); ld8(cq + DFF + j0, c0u); ld8(cq + NU + j0, c1g); ld8(cq + NU + DFF + j0, c1u);
        float o0[8], o1[8];
#pragma unroll
        for (int q = 0; q < 8; ++q) {
            o0[q] = gelu_tanh(bg[q] + p2g[q] * w0g[q] + p1g[q] * w1g[q] + c0g[q] * w2g[q]) * (bu[q] + p2u[q] * w0u[q] + p1u[q] * w1u[q] + c0u[q] * w2u[q]);
            o1[q] = gelu_tanh(bg[q] + p1g[q] * w0g[q] + c0g[q] * w1g[q] + c1g[q] * w2g[q]) * (bu[q] + p1u[q] * w0u[q] + c0u[q] * w1u[q] + c1u[q] * w2u[q]); }
        u32x4 ov; ov.x = pk2(o0[0], o0[1]); ov.y = pk2(o0[2], o0[3]); ov.z = pk2(o0[4], o0[5]); ov.w = pk2(o0[6], o0[7]);
        *(u32x4*)(G + (size_t)m0 * DFF + j0) = ov;
        ov.x = pk2(o1[0], o1[1]); ov.y = pk2(o1[2], o1[3]); ov.z = pk2(o1[4], o1[5]); ov.w = pk2(o1[6], o1[7]);
        *(u32x4*)(G + (size_t)(m0 + 1) * DFF + j0) = ov;
        const bool lastg = smp ? true : ((m0 & (SEQ - 1)) == SEQ - 16);
        if (lastg) {
            float* fo = smp ? a->out + O_FS + (size_t)((l * 8 + sb) * 2) * NU : a->out + O_FP + (size_t)((l * 2 + (m0 >> 13)) * 2) * NU;
            float e0[8], e1[8]; const bf16* lq = UQ + (size_t)(4 * k + 2) * NU;
            ld8(lq + j0, e0); ld8(lq + NU + j0, e1);
            *(f32x4*)(fo + j0) = (f32x4){e0[0], e0[1], e0[2], e0[3]}; *(f32x4*)(fo + j0 + 4) = (f32x4){e0[4], e0[5], e0[6], e0[7]};
            *(f32x4*)(fo + NU + j0) = (f32x4){e1[0], e1[1], e1[2], e1[3]}; *(f32x4*)(fo + NU + j0 + 4) = (f32x4){e1[4], e1[5], e1[6], e1[7]};
            ld8(lq + DFF + j0, e0); ld8(lq + NU + DFF + j0, e1);
            *(f32x4*)(fo + DFF + j0) = (f32x4){e0[0], e0[1], e0[2], e0[3]}; *(f32x4*)(fo + DFF + j0 + 4) = (f32x4){e0[4], e0[5], e0[6], e0[7]};
            *(f32x4*)(fo + NU + DFF + j0) = (f32x4){e1[0], e1[1], e1[2], e1[3]}; *(f32x4*)(fo + NU + DFF + j0 + 4) = (f32x4){e1[4], e1[5], e1[6], e1[7]};
        }
    }
}

#define XB_TMO      128
#define XB_XCNT(j)  (256  + 64 * (j))
#define XB_XSUB(j)  (1280 + 64 * (j))
#define XB_XGEN(j)  (2304 + 64 * (j))
#define XB_TOP      3328
#define XB_TOPGEN   3392
#define XCD_BAR_WORDS 3456
#define XB_SPIN_CAP (1u << 18)
__device__ __forceinline__ unsigned xb_ld(unsigned* p)              { return __hip_atomic_load(p, __ATOMIC_RELAXED, __HIP_MEMORY_SCOPE_AGENT); }
__device__ __forceinline__ unsigned xb_add(unsigned* p, unsigned v) { return __hip_atomic_fetch_add(p, v, __ATOMIC_RELAXED, __HIP_MEMORY_SCOPE_AGENT); }
__device__ __forceinline__ unsigned xb_xcc_id() { return (unsigned)__builtin_amdgcn_s_getreg((3 << 11) | 20) & 0xFu; }
#define XB_SPIN(cond, bar) do { unsigned _sp = 0; while (cond) { __builtin_amdgcn_s_sleep(1); \
    if ((++_sp & 255u) == 0u) { if (xb_ld(&(bar)[XB_TMO])) break; if (_sp > XB_SPIN_CAP) { atomicAdd(&(bar)[XB_TMO], 1u); break; } } } } while (0)

struct XcdBarrier {
    unsigned* bar; unsigned x;
    volatile LAS unsigned* st;
};

__device__ __forceinline__ XcdBarrier xcd_barrier_post(unsigned* bar, volatile LAS unsigned* st) {
    XcdBarrier b; b.bar = bar; b.x = xb_xcc_id(); b.st = st;
    if (threadIdx.x == 0) (void)xb_add(&bar[XB_XCNT(b.x)], 1u);
    return b;
}
__device__ __forceinline__ void xcd_barrier_complete(unsigned* bar, unsigned x, unsigned& nloc, unsigned& nx) {
    const unsigned G = gridDim.x * gridDim.y * gridDim.z;
    unsigned sum, cnt, mine, sp = 0u;
    for (;;) {
        sum = 0u; cnt = 0u; mine = 0u;
#pragma unroll
        for (unsigned j = 0; j < 16; ++j) { const unsigned c = xb_ld(&bar[XB_XCNT(j)]); sum += c; cnt += (c > 0u) ? 1u : 0u; mine = (j == x) ? c : mine; }
        if (sum == G) break;
        __builtin_amdgcn_s_sleep(1);
        if ((++sp & 255u) == 0u) { if (xb_ld(&bar[XB_TMO])) break; if (sp > XB_SPIN_CAP) { atomicAdd(&bar[XB_TMO], 1u); break; } }
    }
    nloc = mine > 0u ? mine : 1u; nx = cnt > 0u ? cnt : 1u;
}

__device__ __forceinline__ void xcd_barrier(const XcdBarrier& b) {
    asm volatile("s_waitcnt vmcnt(0)" ::: "memory");
    __syncthreads();
    if (threadIdx.x == 0) {
        unsigned* bar = b.bar;
        __builtin_amdgcn_s_waitcnt(0);
        unsigned nloc = b.st[0], nx = b.st[1];
        if (nloc == 0u) { xcd_barrier_complete(bar, b.x, nloc, nx); b.st[0] = nloc; b.st[1] = nx; }
        const unsigned old = xb_add(&bar[XB_XSUB(b.x)], 1u);
        const unsigned gen = old / nloc;
        if (old + 1u == (gen + 1u) * nloc) {
            __builtin_amdgcn_fence(__ATOMIC_RELEASE, "agent");
            asm volatile("s_waitcnt vmcnt(0)" ::: "memory");
            const unsigned og = xb_add(&bar[XB_TOP], 1u);
            const unsigned tg = og / nx;
            if (og + 1u == (tg + 1u) * nx) xb_add(&bar[XB_TOPGEN], 1u);
            else XB_SPIN(xb_ld(&bar[XB_TOPGEN]) == tg, bar);
            __builtin_amdgcn_fence(__ATOMIC_ACQUIRE, "agent");
            xb_add(&bar[XB_XGEN(b.x)], 1u);
            asm volatile("s_waitcnt vmcnt(0)" ::: "memory");
        } else {
            XB_SPIN(xb_ld(&bar[XB_XGEN(b.x)]) == gen, bar);
            __builtin_amdgcn_fence(__ATOMIC_ACQUIRE, "agent");
            asm volatile("s_waitcnt vmcnt(0)" ::: "memory");
        }
    }
    __syncthreads();
}


#ifndef PHMASK
#define PHMASK 0xffff
#endif
#ifndef REP_GEMM
#define REP_GEMM 1
#endif
#ifndef REP_C
#define REP_C 1
#endif
#ifndef REP_E
#define REP_E 1
#endif
#ifndef REP_SYNC
#define REP_SYNC 1
#endif
#ifndef REP_CONV
#define REP_CONV 1
#endif
__global__ void __launch_bounds__(NTHR, 2) fwd_mega(Args a_unused) {
    extern __shared__ __attribute__((aligned(16))) unsigned char lds_raw[];
    LAS unsigned char* lds0 = (LAS unsigned char*)lds_raw;
    cg::grid_group grid = cg::this_grid();
    volatile LAS unsigned* st = (volatile LAS unsigned*)(lds0 + 147456);
    if (threadIdx.x < 4) st[threadIdx.x] = 0u;
    __syncthreads();
    unsigned* barw = (unsigned*)(get_args()->ws + WS_BAR);
    if (blockIdx.x == 0) { for (int i = threadIdx.x; i < XCD_BAR_WORDS; i += NTHR) __hip_atomic_store(barw + i, 0u, __ATOMIC_RELAXED, __HIP_MEMORY_SCOPE_AGENT); }
    grid.sync();
    const XcdBarrier bar = xcd_barrier_post(barw, st);
#pragma nounroll
    for (int step = 0; step < 21; ++step) {
        const int l = step / 10, ph = (step == 20) ? 12 : step % 10;
        LAS unsigned char* lds = lds0; asm volatile("" : "+s"(lds));
        if (ph == 1 || ph == 5 || ph == 7 || ph == 9) {
            if (PHMASK & 4) {
            const ArgsP a = get_args(); unsigned char* ws = a->ws;
            const bf16* A; const bf16* Bt; void* O; int M, N, K, mode;
            if (ph == 1)       { A = (const bf16*)(ws + WS_ACT); Bt = (const bf16*)(ws + WS_WIN); O = ws + WS_Z; M = MPAD; N = NZ + 256; K = DM; mode = 1; }
            else if (ph == 5)  { A = (const bf16*)(ws + WS_ACT); Bt = (const bf16*)(ws + WS_WOUT); O = ws + WS_MIX; M = MPR; N = DM; K = DM; mode = 0; }
            else if (ph == 7)  { A = (const bf16*)(ws + WS_ACT); Bt = (const bf16*)(ws + WS_WUP); O = ws + WS_G; M = MPAD; N = NU; K = DM; mode = 3; }
            else               { A = (const bf16*)(ws + WS_G); Bt = (const bf16*)(ws + WS_WDN); O = ws + WS_FFN; M = MPR; N = DM; K = DFF; mode = 0; }
            pg8::EpiGen E{O, N, mode, ws + WS_UQ, a->in[17] + (size_t)l * 3 * NU, a->in[18] + (size_t)l * NU, (float*)(ws + WS_IG), (float*)(ws + WS_LF), a->in[10] + l * 4, a->in[11] + l * 4};
            pg8::Gemm g{A, Bt, M, N, K}; pg8::StaticOrder S; S.init(M, N, get_nb(), get_bid());
            pg8::gemm_phase<pg8::EpiGen, pg8::StaticOrder, true, true>(lds, g, S, E);
            if (ph == 5 || ph == 9) mini_gemm(lds, A + (size_t)MPR * K, Bt, K, (bf16*)O + (size_t)MPR * DM);
            }
        } else if (ph == 0 || ph == 6 || ph == 12) {
            if (ph == 0 && (PHMASK & 1)) { phase_convert(l, lds); __syncthreads(); }
            if (PHMASK & 2) {
            const ArgsP a = get_args();
            const float* ngl = a->in[8] + (size_t)l * 4 * DM;
            bool first; const bf16* addsrc; const float* gadd; const float* gn; int gl;
            if (ph == 0) { first = (l == 0); addsrc = (l == 0) ? nullptr : (const bf16*)(a->ws + WS_FFN); gadd = ngl - DM; gn = ngl; gl = -1; }
            else if (ph == 6) { first = (l == 0); addsrc = (const bf16*)(a->ws + WS_MIX); gadd = ngl + DM; gn = ngl + 2 * DM; gl = -1; }
            else { first = false; addsrc = (const bf16*)(a->ws + WS_FFN); gadd = a->in[8] + (size_t)7 * DM; gn = nullptr; gl = -1; }
            phase_rows(lds, first, addsrc, gadd, gn, gl, ph == 12);
            }
        } else if (ph == 2) { if (PHMASK & 8) phase_c(l, lds); }
        else if (ph == 3) { if (PHMASK & 16) phase_m2(l, lds); }
        else if (ph == 4) { if (PHMASK & 32) phase_e(l, lds); }
        else { if (PHMASK & 512) phase_fix(l); }
        if (step < 20) xcd_barrier(bar);
    }
}

extern "C" void kernel_launch(void* const* d_in, const int* in_sizes, int n_in, void* d_out, int out_size, void* d_ws, size_t ws_size, hipStream_t stream) {
    static int grid = 0;
    if (grid == 0) {
        if (n_in != 20 || (size_t)out_size != O_END || ws_size < WS_END) { fprintf(stderr, "kernel_launch: unexpected shapes: n_in %d out %d ws %zu\n", n_in, out_size, ws_size); grid = -1; return; }
        int dev = 0, cus = 0, per_cu = 0;
        (void)hipGetDevice(&dev);
        (void)hipDeviceGetAttribute(&cus, hipDeviceAttributeMultiprocessorCount, dev);
        (void)hipFuncSetAttribute((const void*)fwd_mega, hipFuncAttributeMaxDynamicSharedMemorySize, LDS_BYTES);
        (void)hipOccupancyMaxActiveBlocksPerMultiprocessor(&per_cu, (const void*)fwd_mega, NTHR, LDS_BYTES);
        if (per_cu < 1) per_cu = 1;
        grid = cus * per_cu;
    }
    if (grid < 0) return;
    Args a{};
    for (int i = 0; i < 20; ++i) a.in[i] = (const float*)d_in[i];
    a.out = (float*)d_out; a.ws = (unsigned char*)d_ws;
    void* args[] = {&a};
    hipError_t e = hipLaunchCooperativeKernel((const void*)fwd_mega, dim3(grid), dim3(NTHR), args, LDS_BYTES, stream);
    if (e != hipSuccess) fprintf(stderr, "cooperative launch failed: %s (grid %d)\n", hipGetErrorString(e), grid);
}
```

```cpp
#include <hip/hip_runtime.h>
#include <hip/hip_cooperative_groups.h>
#include <cstdio>
#include <cstdint>
#include <cmath>
namespace cg = cooperative_groups;

namespace pg8 {
#define PG8_LAS __attribute__((address_space(3)))
typedef unsigned short bf16_t;
typedef short bf16x8 __attribute__((ext_vector_type(8)));
typedef float f32x4 __attribute__((ext_vector_type(4)));
typedef unsigned u32x4 __attribute__((ext_vector_type(4)));
constexpr int BM = 256, BK = 64, HALF = 128, HTB = HALF * BK * 2  , STAGE_BYTES = 8 * HTB, NXCD = 8, WGM = 8;

__host__ __device__ __forceinline__ int lds_byte(int r, int c) { const int st = (r >> 4) * 2 + (c >> 5), rr = r & 15, cc = c & 31, ob = rr * 64 + cc * 2; return st * 1024 + (ob ^ (((ob >> 9) & 1) << 5)); }
__host__ __device__ __forceinline__ void stage_rc(int b, int& R, int& C) { const int st = b / 1024, sb = b % 1024, swz = sb ^ (((sb >> 9) & 1) << 5); R = (st >> 1) * 16 + swz / 64; C = (st & 1) * 32 + (swz % 64) / 2; }
__host__ __device__ __forceinline__ int perm32(int rho) { const int n = rho >> 4, i = rho & 15; return 8 * (i >> 2) + 4 * n + (i & 3); }

struct Unit { int pm, pn; };
struct Gemm { const bf16_t* A; const bf16_t* Bt; int M, N, K; };

struct StaticOrder {
    int nM, nN, nwg, G, c;
    __host__ __device__ void init(int M, int N, int G_, int c_) { nM = M / BM; nN = N / BM; nwg = nM * nN; G = G_; c = c_; }
    __host__ __device__ bool next(int i, Unit& u) const {
        const long L = (long)i * G + c; if (L >= nwg) return false;
        int wgid = (int)L; { const int q = nwg / NXCD, r = nwg % NXCD, xcd = wgid % NXCD, off = wgid / NXCD; wgid = (xcd < r ? xcd * (q + 1) : r * (q + 1) + (xcd - r) * q) + off; }
        const int nig = WGM * nN, gid = wgid / nig, fm = gid * WGM, gsz = (nM - fm) < WGM ? (nM - fm) : WGM;
        u.pm = fm + ((wgid % nig) % gsz); u.pn = (wgid % nig) / gsz; return true;
    }
    __device__ __forceinline__ void a_ready(const Unit&) const {}
    __device__ __forceinline__ void done(const Unit&) const {}
};

typedef float f32x2e __attribute__((ext_vector_type(2)));
typedef __bf16 bf16x2e __attribute__((ext_vector_type(2)));
__device__ __forceinline__ unsigned cvt_pk_bf16(float lo, float hi) { f32x2e v = {lo, hi}; bf16x2e b = __builtin_convertvector(v, bf16x2e); return __builtin_bit_cast(unsigned, b); }
__device__ __forceinline__ float gelu_t(float x) { const float ee = __builtin_amdgcn_exp2f(x * (2.3022082f + 0.10294324f * x * x)); return x - x * __builtin_amdgcn_rcpf(ee + 1.f); }
__device__ __forceinline__ float dpp_shr1(float v) { return __builtin_bit_cast(float, __builtin_amdgcn_update_dpp(0, __builtin_bit_cast(int, v), 0x111, 0xf, 0xf, true)); }
__device__ __forceinline__ float dpp_shr2(float v) { return __builtin_bit_cast(float, __builtin_amdgcn_update_dpp(0, __builtin_bit_cast(int, v), 0x112, 0xf, 0xf, true)); }
struct EpiGen {
    static constexpr bool PERM = true, AFTER_DRAIN = false;
    void* O; int ldc; int mode;
    void* O2; const float* cw; const float* cb;
    float* IGo; float* LFo; const float* bi; const float* bfg;
    __device__ __forceinline__ void operator()(const f32x4 (&acc)[2][2][4][2], const Unit& u, int wr, int wc, int fr, int fq) const {
        const int row0 = u.pm * BM + wr * 64 + fr; const int col0 = u.pn * BM + wc * 32 + 8 * fq;
        if (mode == 3) {
            const int f0 = u.pn * 128 + wc * 32 + 8 * fq;
#pragma unroll
            for (int n = 0; n < 2; ++n) {
                const int fn = f0 + 4 * n;
                const f32x4 w0g = *(const f32x4*)(cw + fn), w1g = *(const f32x4*)(cw + 5632 + fn), w2g = *(const f32x4*)(cw + 2 * 5632 + fn), bg = *(const f32x4*)(cb + fn);
                const f32x4 w0u = *(const f32x4*)(cw + 2816 + fn), w1u = *(const f32x4*)(cw + 5632 + 2816 + fn), w2u = *(const f32x4*)(cw + 2 * 5632 + 2816 + fn), bu = *(const f32x4*)(cb + 2816 + fn);
#pragma unroll
                for (int ai = 0; ai < 2; ++ai)
#pragma unroll
                    for (int m = 0; m < 4; ++m) { const int row = row0 + ai * HALF + m * 16;
                        float og[4];
#pragma unroll
                        for (int i = 0; i < 4; ++i) { const float ug = acc[ai][0][m][n][i], uu = acc[ai][1][m][n][i];
                            const float yg = bg[i] + dpp_shr2(ug) * w0g[i] + dpp_shr1(ug) * w1g[i] + ug * w2g[i];
                            const float yu = bu[i] + dpp_shr2(uu) * w0u[i] + dpp_shr1(uu) * w1u[i] + uu * w2u[i];
                            og[i] = gelu_t(yg) * yu; }
                        if (fr >= 2) { unsigned w0 = cvt_pk_bf16(og[0], og[1]), w1 = cvt_pk_bf16(og[2], og[3]);
                            unsigned* dst = (unsigned*)((bf16_t*)O + (size_t)row * 2816 + fn); dst[0] = w0; dst[1] = w1; } }
            }
            if (fr < 2 || fr >= 14) {
#pragma unroll
                for (int ai = 0; ai < 2; ++ai)
#pragma unroll
                    for (int m = 0; m < 4; ++m) { const int row = row0 + ai * HALF + m * 16;
                        bf16_t* q = (bf16_t*)O2 + (size_t)((row >> 4) * 4 + (fr < 2 ? fr : fr - 12)) * 5632 + f0;
                        u32x4 wg, wu; const f32x4 g0 = acc[ai][0][m][0], g1 = acc[ai][0][m][1], u0 = acc[ai][1][m][0], u1 = acc[ai][1][m][1];
                        wg.x = cvt_pk_bf16(g0[0], g0[1]); wg.y = cvt_pk_bf16(g0[2], g0[3]); wg.z = cvt_pk_bf16(g1[0], g1[1]); wg.w = cvt_pk_bf16(g1[2], g1[3]);
                        wu.x = cvt_pk_bf16(u0[0], u0[1]); wu.y = cvt_pk_bf16(u0[2], u0[3]); wu.z = cvt_pk_bf16(u1[0], u1[1]); wu.w = cvt_pk_bf16(u1[2], u1[3]);
                        *(u32x4*)q = wg; *(u32x4*)(q + 2816) = wu; }
            }
        } else if (mode == 2) {
#pragma unroll
            for (int ai = 0; ai < 2; ++ai)
#pragma unroll
                for (int m = 0; m < 4; ++m) { float* rowp = (float*)O + (size_t)(row0 + ai * HALF + m * 16) * ldc + col0;
#pragma unroll
                    for (int bj = 0; bj < 2; ++bj) { *(f32x4*)(rowp + bj * HALF) = acc[ai][bj][m][0]; *(f32x4*)(rowp + bj * HALF + 4) = acc[ai][bj][m][1]; } }
        } else if (mode == 1 && u.pn == 14) {
            if (wc == 0 && fq == 0) {
                const f32x4 bi4 = *(const f32x4*)bi, bf4 = *(const f32x4*)bfg;
#pragma unroll
                for (int ai = 0; ai < 2; ++ai)
#pragma unroll
                    for (int m = 0; m < 4; ++m) { const int row = row0 + ai * HALF + m * 16;
                        *(f32x4*)(IGo + (size_t)row * 4) = acc[ai][0][m][0] + bi4;
                        f32x4 x = acc[ai][0][m][1] + bf4, o;
#pragma unroll
                        for (int i = 0; i < 4; ++i) o[i] = fminf(x[i], 0.f) - log1pf(expf(-fabsf(x[i])));
                        *(f32x4*)(LFo + (size_t)row * 4) = o; }
            }
        } else {
            const int ldz = (mode == 1) ? 3584 : ldc;
            float sc = 1.f; if (mode == 1) { sc = (u.pn < 2) ? 0.18033688011112042f   : ((u.pn == 8 || u.pn == 9) ? 0.08838834764831845f : 1.f); }
#pragma unroll
            for (int ai = 0; ai < 2; ++ai)
#pragma unroll
                for (int m = 0; m < 4; ++m) { bf16_t* rowp = (bf16_t*)O + (size_t)(row0 + ai * HALF + m * 16) * ldz + col0;
#pragma unroll
                    for (int bj = 0; bj < 2; ++bj) { f32x4 v0 = acc[ai][bj][m][0] * sc, v1 = acc[ai][bj][m][1] * sc;
                        u32x4 w; w.x = cvt_pk_bf16(v0[0], v0[1]); w.y = cvt_pk_bf16(v0[2], v0[3]); w.z = cvt_pk_bf16(v1[0], v1[1]); w.w = cvt_pk_bf16(v1[2], v1[3]);
                        *(u32x4*)(rowp + bj * HALF) = w; } }
        }
    }
    __device__ __forceinline__ void fused(f32x4 (&acc)[2][2][4][2], const Unit& u, int wr, int wc, int fr, int fq, PG8_LAS unsigned char* lds, int wid, int lane) const {}
};
template <class Epi, class Sched, bool ALIGN_EPI = false, bool SP2 = false>
__device__ __forceinline__ void gemm_phase(PG8_LAS unsigned char* lds, const Gemm g, const Sched& S, const Epi& E) {
    int tid_ = threadIdx.x; asm volatile("" : "+v"(tid_)); const int tid = tid_, wid = __builtin_amdgcn_readfirstlane(tid >> 6), lane = tid & 63, wr = wid >> 2, wc = wid & 3, fr = lane & 15, fq = lane >> 4;
    const int K = g.K, nt = K / BK;
    unsigned voffA[2], voffB[2];
#pragma unroll
    for (int i = 0; i < 2; ++i) { int R, C; stage_rc(tid * 16 + i * 8192, R, C); const int Rb = Epi::PERM ? ((R & ~31) + perm32(R & 31)) : R;
        voffA[i] = (unsigned)(R * K + C) * 2u; voffB[i] = (unsigned)(Rb * K + C) * 2u; }
    const size_t kstep = (size_t)(BK * 2);
    const size_t hstep = (size_t)HALF * K * 2;
    const size_t tstep = 2 * hstep;
    const unsigned ldsw = (unsigned)wid * 1024u;
    const int aoff = lds_byte(wr * 64 + fr, fq * 8), boff = lds_byte(wc * 32 + fr, fq * 8);
#define PG8_SA(b, h) (((b) * 2 + (h)) * HTB)
#define PG8_SB(b, h) ((4 + (b) * 2 + (h)) * HTB)
#define PG8_STAGE(bufoff, gbase, voff) do { _Pragma("unroll") for (int _i = 0; _i < 2; ++_i) \
        __builtin_amdgcn_global_load_lds((const unsigned*)((const char*)(gbase) + (voff)[_i]), (PG8_LAS unsigned*)(lds + (bufoff) + ldsw + _i * 8192), 16, 0, 0); } while (0)
#define PG8_LDA(dst, b, h) do { _Pragma("unroll") for (int m = 0; m < 4; ++m) _Pragma("unroll") for (int k = 0; k < 2; ++k) dst[m][k] = *(const PG8_LAS bf16x8*)(lds + PG8_SA(b, h) + aoff + m * 2048 + k * 1024); } while (0)
#define PG8_LDB(dst, b, h) do { _Pragma("unroll") for (int n = 0; n < 2; ++n) _Pragma("unroll") for (int k = 0; k < 2; ++k) dst[n][k] = *(const PG8_LAS bf16x8*)(lds + PG8_SB(b, h) + boff + n * 2048 + k * 1024); } while (0)
#define PG8_MMA(ai, bj, At, Bt) do { __builtin_amdgcn_s_setprio(1); _Pragma("unroll") for (int m = 0; m < 4; ++m) _Pragma("unroll") for (int n = 0; n < 2; ++n) _Pragma("unroll") for (int k = 0; k < 2; ++k) \
        acc[ai][bj][m][n] = __builtin_amdgcn_mfma_f32_16x16x32_bf16(Bt[n][k], At[m][k], acc[ai][bj][m][n], 0, 0, 0); __builtin_amdgcn_s_setprio(0); } while (0)
#define PG8_WAIT_V(n) asm volatile("s_waitcnt vmcnt(" #n ")" ::: "memory")
#define PG8_WAIT_L(n) asm volatile("s_waitcnt lgkmcnt(" #n ")" ::: "memory")
#define PG8_BAR __builtin_amdgcn_s_barrier()
#define PG8_SCHED __builtin_amdgcn_sched_barrier(0)
    Unit cur, nxt; int ui = 0;
    if (!S.next(0, cur)) return;
    f32x4 acc[2][2][4][2];
#pragma unroll
    for (int a = 0; a < 2; ++a)
#pragma unroll
        for (int b = 0; b < 2; ++b)
#pragma unroll
            for (int m = 0; m < 4; ++m)
#pragma unroll
                for (int n = 0; n < 2; ++n) acc[a][b][m][n] = (f32x4){0.f, 0.f, 0.f, 0.f};
    bf16x8 At[4][2], B0[2][2], B1[2][2];
    const char* cA = (const char*)g.A + (size_t)cur.pm * tstep; const char* cB = (const char*)g.Bt + (size_t)cur.pn * tstep;
    S.a_ready(cur);
    if constexpr (SP2) {
        PG8_STAGE(PG8_SB(0, 0), cB, voffB); PG8_STAGE(PG8_SB(0, 1), cB + hstep, voffB); PG8_STAGE(PG8_SA(0, 0), cA, voffA); PG8_STAGE(PG8_SA(0, 1), cA + hstep, voffA);
        if (wr == 1) PG8_BAR;
        PG8_WAIT_V(2); PG8_BAR;
        PG8_STAGE(PG8_SB(1, 0), cB + kstep, voffB); PG8_STAGE(PG8_SA(1, 0), cA + kstep, voffA); PG8_STAGE(PG8_SB(1, 1), cB + hstep + kstep, voffB);
        PG8_WAIT_V(6); PG8_BAR;
    } else {
        PG8_STAGE(PG8_SB(0, 0), cB, voffB); PG8_STAGE(PG8_SA(0, 0), cA, voffA); PG8_STAGE(PG8_SB(0, 1), cB + hstep, voffB); PG8_STAGE(PG8_SA(0, 1), cA + hstep, voffA);
        if (wr == 1) PG8_BAR;
        PG8_WAIT_V(4); PG8_BAR;
        PG8_STAGE(PG8_SB(1, 0), cB + kstep, voffB); PG8_STAGE(PG8_SA(1, 0), cA + kstep, voffA); PG8_STAGE(PG8_SB(1, 1), cB + hstep + kstep, voffB);
        PG8_WAIT_V(6); PG8_BAR;
    }
    for (;;) {
        const bool has_next = S.next(ui + 1, nxt);
        const char* nA = has_next ? (const char*)g.A + (size_t)nxt.pm * tstep : cA; const char* nB = has_next ? (const char*)g.Bt + (size_t)nxt.pn * tstep : cB;
        for (int t = 0; t < nt; t += 2) {
            const bool last = (t == nt - 2);
            const char* a1 = cA + (size_t)(t + 1) * kstep;
            const char* a2 = last ? nA : cA + (size_t)(t + 2) * kstep; const char* b2 = last ? nB : cB + (size_t)(t + 2) * kstep;
            const char* a3 = a2 + kstep; const char* b3 = b2 + kstep;
            if (last && has_next) S.a_ready(nxt);
            if constexpr (SP2) {
            PG8_LDB(B0, 0, 0); PG8_LDB(B1, 0, 1); PG8_SCHED; PG8_LDA(At, 0, 0); PG8_STAGE(PG8_SA(1, 1), a1 + hstep, voffA);
            PG8_WAIT_V(8); PG8_WAIT_L(0); PG8_BAR; PG8_MMA(0, 0, At, B0); PG8_MMA(0, 1, At, B1); PG8_BAR; PG8_SCHED;
            PG8_LDA(At, 0, 1); PG8_STAGE(PG8_SB(0, 0), b2, voffB); PG8_STAGE(PG8_SB(0, 1), b2 + hstep, voffB); PG8_STAGE(PG8_SA(0, 0), a2, voffA);
            PG8_WAIT_V(8); PG8_WAIT_L(0); PG8_BAR; PG8_MMA(1, 0, At, B0); PG8_MMA(1, 1, At, B1); PG8_BAR; PG8_SCHED;
            PG8_LDB(B0, 1, 0); PG8_LDB(B1, 1, 1); PG8_SCHED; PG8_LDA(At, 1, 0); PG8_STAGE(PG8_SA(0, 1), a2 + hstep, voffA);
            PG8_WAIT_V(8); PG8_WAIT_L(0); PG8_BAR; PG8_MMA(0, 0, At, B0); PG8_MMA(0, 1, At, B1); PG8_BAR; PG8_SCHED;
            PG8_LDA(At, 1, 1); PG8_STAGE(PG8_SB(1, 0), b3, voffB); PG8_STAGE(PG8_SB(1, 1), b3 + hstep, voffB); PG8_STAGE(PG8_SA(1, 0), a3, voffA);
            PG8_WAIT_V(8); PG8_WAIT_L(0); PG8_BAR; PG8_MMA(1, 0, At, B0); PG8_MMA(1, 1, At, B1); PG8_BAR; PG8_SCHED;
            } else {
            PG8_LDB(B0, 0, 0); PG8_SCHED; PG8_LDA(At, 0, 0); PG8_STAGE(PG8_SA(1, 1), a1 + hstep, voffA);
            PG8_WAIT_L(8); PG8_BAR; PG8_WAIT_L(0); PG8_MMA(0, 0, At, B0); PG8_BAR; PG8_SCHED;
            PG8_LDB(B1, 0, 1); PG8_STAGE(PG8_SB(0, 0), b2, voffB);
            PG8_BAR; PG8_WAIT_L(0); PG8_MMA(0, 1, At, B1); PG8_BAR;
            PG8_LDA(At, 0, 1); PG8_STAGE(PG8_SA(0, 0), a2, voffA);
            PG8_BAR; PG8_WAIT_L(0); PG8_MMA(1, 0, At, B0); PG8_BAR; PG8_SCHED;
            PG8_STAGE(PG8_SB(0, 1), b2 + hstep, voffB);
            PG8_WAIT_V(6); PG8_BAR; PG8_MMA(1, 1, At, B1); PG8_BAR;
            PG8_LDB(B0, 1, 0); PG8_SCHED; PG8_LDA(At, 1, 0); PG8_STAGE(PG8_SA(0, 1), a2 + hstep, voffA);
            PG8_WAIT_L(8); PG8_BAR; PG8_WAIT_L(0); PG8_MMA(0, 0, At, B0); PG8_BAR; PG8_SCHED;
            PG8_LDB(B1, 1, 1); PG8_STAGE(PG8_SB(1, 0), b3, voffB);
            PG8_BAR; PG8_WAIT_L(0); PG8_MMA(0, 1, At, B1); PG8_BAR;
            PG8_LDA(At, 1, 1); PG8_STAGE(PG8_SA(1, 0), a3, voffA);
            PG8_BAR; PG8_WAIT_L(0); PG8_MMA(1, 0, At, B0); PG8_BAR; PG8_SCHED;
            PG8_STAGE(PG8_SB(1, 1), b3 + hstep, voffB);
            PG8_WAIT_V(6); PG8_BAR; PG8_MMA(1, 1, At, B1); PG8_BAR;
            }
        }
        if constexpr (ALIGN_EPI) { if (wr == 0) PG8_BAR; }
        if constexpr (!Epi::AFTER_DRAIN) { E(acc, cur, wr, wc, fr, fq); S.done(cur); }
        if (!has_next) break;
#pragma unroll
        for (int a = 0; a < 2; ++a)
#pragma unroll
            for (int b = 0; b < 2; ++b)
#pragma unroll
                for (int m = 0; m < 4; ++m)
#pragma unroll
                    for (int n = 0; n < 2; ++n) acc[a][b][m][n] = (f32x4){0.f, 0.f, 0.f, 0.f};
        cur = nxt; cA = nA; cB = nB; ++ui;
        if constexpr (ALIGN_EPI) { if (wr == 1) PG8_BAR; }
    }
    PG8_WAIT_V(0);
    if constexpr (!ALIGN_EPI) { if (wr == 0) PG8_BAR; }
    PG8_BAR;
    if constexpr (Epi::AFTER_DRAIN) { E.fused(acc, cur, wr, wc, fr, fq, lds, wid, lane); S.done(cur); }
#undef PG8_SA
#undef PG8_SB
#undef PG8_STAGE
#undef PG8_LDA
#undef PG8_LDB
#undef PG8_MMA
#undef PG8_WAIT_V
#undef PG8_WAIT_L
#undef PG8_BAR
#undef PG8_SCHED
}
}
#define LAS __attribute__((address_space(3)))
#define DI __device__ __forceinline__
typedef unsigned short bf16;
typedef float f32x4 __attribute__((ext_vector_type(4)));
typedef float f32x16 __attribute__((ext_vector_type(16)));
typedef float f32x2 __attribute__((ext_vector_type(2)));
typedef unsigned u32x4 __attribute__((ext_vector_type(4)));
typedef unsigned u32x2 __attribute__((ext_vector_type(2)));
typedef short bf16x8 __attribute__((ext_vector_type(8)));
typedef short s16x4 __attribute__((ext_vector_type(4)));
typedef __bf16 bf16x2_t __attribute__((ext_vector_type(2)));

constexpr int NTHR = 512;
constexpr int DM = 1024, MPR = 16384, MVALID = 16512, MPAD = 16640, NZ = 3584, DIN = 3592, DFF = 2816, NU = 5632;
constexpr int SEQ = 8192;
constexpr float EPS = 1e-6f;
constexpr int LDS_BYTES = 147456 + 64;
constexpr size_t MiB = 1u << 20;
constexpr size_t WS_IG = 0, WS_LF = 512 * 1024, WS_BL = 1 * MiB, WS_AC = 1 * MiB + 8192, WS_MPREV = 1 * MiB + 16384, WS_NC = 2 * MiB, WS_NPREV = 3 * MiB;
constexpr size_t WS_BAR = 3 * MiB + 768 * 1024;
constexpr size_t WS_WIN = 4 * MiB, WS_WOUT = 11 * MiB + 512 * 1024, WS_WUP = 13 * MiB + 512 * 1024, WS_WDN = 24 * MiB + 512 * 1024;
constexpr size_t WS_ACT = 30 * MiB;
constexpr size_t WS_KC = 244 * MiB, WS_VC = 248 * MiB;
constexpr size_t WS_X16 = 63 * MiB;
constexpr size_t WS_R = 96 * MiB;
constexpr size_t WS_Z = WS_R, WS_SC = 210 * MiB;
constexpr size_t WS_MIX = WS_R;
constexpr size_t WS_UQ = WS_R, WS_G = 141 * MiB;
constexpr size_t WS_FFN = WS_R;
constexpr size_t WS_END = 256 * MiB;
static_assert(WS_Z + (size_t)MPAD * NZ * 2 <= WS_SC && WS_SC + (size_t)1056 * 32768 <= WS_KC && WS_X16 + (size_t)MVALID * DM * 2 <= WS_R, "ws stage 1");
static_assert(WS_UQ + (size_t)(MPAD / 4) * NU * 2 <= WS_G && WS_G + (size_t)MPAD * DFF * 2 <= WS_KC, "ws stage 3");
static_assert(WS_ACT + (size_t)MPAD * DM * 2 <= WS_X16 && WS_WDN + (size_t)DM * DFF * 2 <= WS_ACT, "ws fixed");
constexpr size_t O_X = 0, O_KP = 16908288, O_VP = O_KP + 1048576, O_CP = O_VP + 1048576, O_NP = O_CP + 262144, O_MP = O_NP + 2048, O_FP = O_MP + 16,
                 O_KS = O_FP + 45056, O_VS = O_KS + 131072, O_CS = O_VS + 131072, O_NS = O_CS + 1048576, O_MS = O_NS + 8192, O_FS = O_MS + 64, O_END = O_FS + 180224;

DI unsigned pk2(float lo, float hi) { f32x2 v = {lo, hi}; bf16x2_t b = __builtin_convertvector(v, bf16x2_t); return __builtin_bit_cast(unsigned, b); }
DI float bf2f(unsigned short b) { return __uint_as_float((unsigned)b << 16); }
DI float bflo(unsigned w) { return __uint_as_float(w << 16); }
DI float bfhi(unsigned w) { return __uint_as_float(w & 0xffff0000u); }
DI float wave_sum(float v) {
#pragma unroll
    for (int o = 1; o < 64; o <<= 1) v += __shfl_xor(v, o);
    return v;
}
DI float wave_max(float v) {
#pragma unroll
    for (int o = 1; o < 64; o <<= 1) v = fmaxf(v, __shfl_xor(v, o));
    return v;
}
#define MFMA32(a, b, c) __builtin_amdgcn_mfma_f32_32x32x16_bf16((a), (b), (c), 0, 0, 0)
DI s16x4 vtr(const LAS char* p) { return __builtin_bit_cast(s16x4, __builtin_amdgcn_ds_read_tr16_b64_v4i16((LAS s16x4*)p)); }
DI bf16x8 vtr2(const LAS char* p, int rows4_bytes) { s16x4 lo = vtr(p), hi = vtr(p + rows4_bytes); return __builtin_shufflevector(lo, hi, 0, 1, 2, 3, 4, 5, 6, 7); }
DI int crow(int i, int h) { return (i & 3) + 8 * (i >> 2) + 4 * h; }
DI bf16x8 pack8(const f32x16& x, int s) {
    u32x4 p; p.x = pk2(x[8 * s], x[8 * s + 1]); p.y = pk2(x[8 * s + 2], x[8 * s + 3]); p.z = pk2(x[8 * s + 4], x[8 * s + 5]); p.w = pk2(x[8 * s + 6], x[8 * s + 7]);
    return __builtin_bit_cast(bf16x8, p);
}
DI f32x16 zero16() { f32x16 z;
#pragma unroll
    for (int i = 0; i < 16; ++i) z[i] = 0.f; return z; }
#define LDS_FENCE() asm volatile("s_waitcnt lgkmcnt(0)" ::: "memory")

struct Args { const float* in[20]; float* out; unsigned char* ws; };
typedef const __attribute__((address_space(4))) Args* ArgsP;
DI ArgsP get_args() { ArgsP p = (ArgsP)__builtin_amdgcn_kernarg_segment_ptr(); asm volatile("" : "+s"(p)); return p; }
DI int get_bid() { int b = blockIdx.x; asm volatile("" : "+s"(b)); return b; }
DI int get_nb() { int b = gridDim.x; asm volatile("" : "+s"(b)); return b; }
DI int get_tid() { int t = threadIdx.x; asm volatile("" : "+v"(t)); return t; }

DI void transpose_item(const float* W, int ldw, int K, int nblk, bf16* WT, LAS float* scr, int item, int lane, bool perm_up = false, int cmax = (1 << 30)) {
    const int kb = item / nblk, nb = item % nblk, k0 = 64 * kb, n0 = 32 * nb;
    const int r0 = !perm_up ? n0 : (n0 < DFF ? 256 * (n0 >> 7) + (n0 & 127) : 256 * ((n0 - DFF) >> 7) + 128 + ((n0 - DFF) & 127));
    { int col0 = n0 + (lane & 7) * 4; col0 = col0 + 3 <= cmax ? col0 : cmax - 3;
      f32x4 v[8];
#pragma unroll
      for (int i = 0; i < 8; ++i) v[i] = __builtin_nontemporal_load((const f32x4*)(W + (size_t)(k0 + 8 * i + (lane >> 3)) * ldw + col0));
#pragma unroll
      for (int i = 0; i < 8; ++i) { const int kk = 8 * i + (lane >> 3); LAS float* d = scr + kk * 33 + (lane & 7) * 4; d[0] = v[i].x; d[1] = v[i].y; d[2] = v[i].z; d[3] = v[i].w; } }
    LDS_FENCE();
    const int c = lane & 7;
#pragma unroll
    for (int j = 0; j < 4; ++j) { const int n = (lane >> 3) + 8 * j; const LAS float* s = scr + (8 * c) * 33 + n;
        u32x4 o; o.x = pk2(s[0 * 33], s[1 * 33]); o.y = pk2(s[2 * 33], s[3 * 33]); o.z = pk2(s[4 * 33], s[5 * 33]); o.w = pk2(s[6 * 33], s[7 * 33]);
        *(u32x4*)(WT + (size_t)(r0 + n) * K + k0 + 8 * c) = o; }
    LDS_FENCE();
}
DI void phase_convert(int l, LAS unsigned char* lds) {
    const ArgsP a = get_args(); const int tid = get_tid(), lane = tid & 63, wave = tid >> 6;
    LAS float* scr = (LAS float*)(lds + wave * 8448);
    const int gw = get_bid() * 8 + wave, NGW = get_nb() * 8;
    constexpr int I_IN = 16 * 113, I_OUT = 16 * 32, I_UP = 16 * 176, I_DN = 44 * 32;
    const float* win = a->in[9] + (size_t)l * DM * DIN; const float* wout = a->in[15] + (size_t)l * DM * DM;
    const float* wup = a->in[16] + (size_t)l * DM * NU; const float* wdn = a->in[19] + (size_t)l * DFF * DM;
    for (int it = gw; it < I_IN + I_OUT + I_UP + I_DN; it += NGW) {
        int r = it;
        if (r < I_IN) { transpose_item(win, DIN, DM, 113, (bf16*)(a->ws + WS_WIN), scr, r, lane, false, DIN - 1); continue; } r -= I_IN;
        if (r < I_OUT) { transpose_item(wout, DM, DM, 32, (bf16*)(a->ws + WS_WOUT), scr, r, lane); continue; } r -= I_OUT;
        if (r < I_UP) { transpose_item(wup, NU, DM, 176, (bf16*)(a->ws + WS_WUP), scr, r, lane, true); continue; } r -= I_UP;
        transpose_item(wdn, DM, DFF, 32, (bf16*)(a->ws + WS_WDN), scr, r, lane);
    }
    {   const int gt0 = get_bid() * NTHR + tid, gstep = get_nb() * NTHR;
        for (int it0 = gt0; it0 < 2 * 262144; it0 += 4 * gstep) {
            f32x4 x0[4], x1[4];
#pragma unroll
            for (int k = 0; k < 4; ++k) { const int it = it0 + k * gstep; if (it < 2 * 262144) { const int kv = it >> 18, e = (it & 262143) * 8; const float* src = a->in[2 + kv] + (size_t)l * 2097152 + e; x0[k] = __builtin_nontemporal_load((const f32x4*)src); x1[k] = __builtin_nontemporal_load((const f32x4*)(src + 4)); } }
#pragma unroll
            for (int k = 0; k < 4; ++k) { const int it = it0 + k * gstep; if (it < 2 * 262144) { const int kv = it >> 18, e = (it & 262143) * 8;
                u32x4 w; w.x = pk2(x0[k].x, x0[k].y); w.y = pk2(x0[k].z, x0[k].w); w.z = pk2(x1[k].x, x1[k].y); w.w = pk2(x1[k].z, x1[k].w);
                *(u32x4*)((bf16*)(a->ws + (kv ? WS_VC : WS_KC)) + e) = w; } }
        } }
}

DI void phase_rows(LAS unsigned char* lds, bool first, const bf16* addsrc, const float* gadd, const float* gn, int gate_layer  , bool final) {
    const ArgsP a = get_args(); const int tid = get_tid(), lane = tid & 63, wave = tid >> 6;
    float* Y = a->out; bf16* X16 = (bf16*)(a->ws + WS_X16); bf16* ACT = (bf16*)(a->ws + WS_ACT);
    const int gw = get_bid() * 8 + wave, NGW = get_nb() * 8;
    float ga[16], gb[16];
#pragma unroll
    for (int j = 0; j < 2; ++j)
#pragma unroll
        for (int k = 0; k < 8; ++k) { ga[8 * j + k] = addsrc ? gadd[8 * lane + 512 * j + k] : 0.f; gb[8 * j + k] = gn ? gn[8 * lane + 512 * j + k] : 0.f; }
#define ROWS_LOAD(MM, VV, XX, FF) do { const int mm_ = (MM); \
        if (first) { const float* xr_ = mm_ < MPR ? a->in[0] + (size_t)mm_ * DM : a->in[1] + (size_t)(mm_ - MPR) * DM; \
            _Pragma("unroll") for (int j = 0; j < 2; ++j) { VV[2 * j] = *(const f32x4*)(xr_ + 8 * lane + 512 * j); VV[2 * j + 1] = *(const f32x4*)(xr_ + 8 * lane + 512 * j + 4); } } \
        else { _Pragma("unroll") for (int j = 0; j < 2; ++j) XX[j] = *(const u32x4*)(X16 + (size_t)mm_ * DM + 8 * lane + 512 * j); } \
        if (addsrc) { _Pragma("unroll") for (int j = 0; j < 2; ++j) FF[j] = *(const u32x4*)(addsrc + (size_t)mm_ * DM + 8 * lane + 512 * j); } } while (0)
    f32x4 vn[4], vn2[4]; u32x4 xn[2], fn[2], xn2[2], fn2[2];
#pragma unroll
    for (int j = 0; j < 4; ++j) { vn[j] = (f32x4){0.f, 0.f, 0.f, 0.f}; vn2[j] = vn[j]; }
#pragma unroll
    for (int j = 0; j < 2; ++j) { xn[j] = (u32x4){0u, 0u, 0u, 0u}; fn[j] = xn[j]; xn2[j] = xn[j]; fn2[j] = xn[j]; }
    if (gw < MVALID) ROWS_LOAD(gw, vn, xn, fn);
    if (gw + NGW < MVALID) ROWS_LOAD(gw + NGW, vn2, xn2, fn2);
    for (int m = gw; m < MVALID; m += NGW) {
        float v[16], f[16];
#pragma unroll
        for (int j = 0; j < 2; ++j) {
            if (first) {
#pragma unroll
                for (int k = 0; k < 4; ++k) { v[8 * j + k] = vn[2 * j][k]; v[8 * j + 4 + k] = vn[2 * j + 1][k]; }
            } else { v[8 * j] = bflo(xn[j].x); v[8 * j + 1] = bfhi(xn[j].x); v[8 * j + 2] = bflo(xn[j].y); v[8 * j + 3] = bfhi(xn[j].y); v[8 * j + 4] = bflo(xn[j].z); v[8 * j + 5] = bfhi(xn[j].z); v[8 * j + 6] = bflo(xn[j].w); v[8 * j + 7] = bfhi(xn[j].w); }
            f[8 * j] = bflo(fn[j].x); f[8 * j + 1] = bfhi(fn[j].x); f[8 * j + 2] = bflo(fn[j].y); f[8 * j + 3] = bfhi(fn[j].y); f[8 * j + 4] = bflo(fn[j].z); f[8 * j + 5] = bfhi(fn[j].z); f[8 * j + 6] = bflo(fn[j].w); f[8 * j + 7] = bfhi(fn[j].w);
        }
#pragma unroll
        for (int j = 0; j < 4; ++j) vn[j] = vn2[j];
#pragma unroll
        for (int j = 0; j < 2; ++j) { xn[j] = xn2[j]; fn[j] = fn2[j]; }
        if (m + 2 * NGW < MVALID) ROWS_LOAD(m + 2 * NGW, vn2, xn2, fn2);
        if (addsrc) {
            float s = 0.f;
#pragma unroll
            for (int k = 0; k < 16; ++k) s += f[k] * f[k];
            const float r = 1.0f / sqrtf(wave_sum(s) * (1.f / DM) + EPS);
#pragma unroll
            for (int k = 0; k < 16; ++k) v[k] = v[k] + f[k] * r * ga[k];
#pragma unroll
            for (int j = 0; j < 2; ++j) {
                if (final) { float* yp = Y + (size_t)m * DM + 8 * lane + 512 * j; __builtin_nontemporal_store((f32x4){v[8 * j], v[8 * j + 1], v[8 * j + 2], v[8 * j + 3]}, (f32x4*)yp); __builtin_nontemporal_store((f32x4){v[8 * j + 4], v[8 * j + 5], v[8 * j + 6], v[8 * j + 7]}, (f32x4*)(yp + 4)); }
                else { u32x4 o; o.x = pk2(v[8 * j], v[8 * j + 1]); o.y = pk2(v[8 * j + 2], v[8 * j + 3]); o.z = pk2(v[8 * j + 4], v[8 * j + 5]); o.w = pk2(v[8 * j + 6], v[8 * j + 7]); *(u32x4*)(X16 + (size_t)m * DM + 8 * lane + 512 * j) = o; } }
        }
        if (gn) {
            float s = 0.f;
#pragma unroll
            for (int k = 0; k < 16; ++k) s += v[k] * v[k];
            const float r = 1.0f / sqrtf(wave_sum(s) * (1.f / DM) + EPS);
#pragma unroll
            for (int j = 0; j < 2; ++j) { u32x4 o;
                o.x = pk2(v[8 * j] * r * gb[8 * j], v[8 * j + 1] * r * gb[8 * j + 1]); o.y = pk2(v[8 * j + 2] * r * gb[8 * j + 2], v[8 * j + 3] * r * gb[8 * j + 3]);
                o.z = pk2(v[8 * j + 4] * r * gb[8 * j + 4], v[8 * j + 5] * r * gb[8 * j + 5]); o.w = pk2(v[8 * j + 6] * r * gb[8 * j + 6], v[8 * j + 7] * r * gb[8 * j + 7]);
                *(u32x4*)(ACT + (size_t)m * DM + 8 * lane + 512 * j) = o; }
        }
    }
#undef ROWS_LOAD
}

DI void mini_gemm(LAS unsigned char* lds, const bf16* A, const bf16* Bt, int K, bf16* O) {
    const int tid = get_tid(), lane = tid & 63, wave = tid >> 6, fr = lane & 15, fq = lane >> 4;
    LAS float* red = (LAS float*)lds;
    const int ksl = K >> 3, k0 = wave * ksl, nks = ksl >> 5;
    for (int unit = get_bid(); unit < 256; unit += get_nb()) {
        const int rt = unit >> 5, ct = unit & 31;
        const bf16* ap = A + (size_t)(rt * 16 + fr) * K + k0 + 8 * fq;
        const bf16* bp0 = Bt + (size_t)(ct * 32 + fr) * K + k0 + 8 * fq; const bf16* bp1 = bp0 + (size_t)16 * K;
        f32x4 acc0 = {0.f, 0.f, 0.f, 0.f}, acc1 = {0.f, 0.f, 0.f, 0.f};
#pragma unroll 4
        for (int ks = 0; ks < nks; ++ks) { const bf16x8 av = *(const bf16x8*)(ap + 32 * ks), b0 = *(const bf16x8*)(bp0 + 32 * ks), b1 = *(const bf16x8*)(bp1 + 32 * ks);
            acc0 = __builtin_amdgcn_mfma_f32_16x16x32_bf16(av, b0, acc0, 0, 0, 0); acc1 = __builtin_amdgcn_mfma_f32_16x16x32_bf16(av, b1, acc1, 0, 0, 0); }
#pragma unroll
        for (int j = 0; j < 4; ++j) { red[(wave * 2 + 0) * 256 + j * 64 + lane] = acc0[j]; red[(wave * 2 + 1) * 256 + j * 64 + lane] = acc1[j]; }
        __syncthreads();
        { const int n = tid >> 8, idx = tid & 255, j = idx >> 6, ln = idx & 63; float s = 0.f;
#pragma unroll
          for (int w = 0; w < 8; ++w) s += red[(w * 2 + n) * 256 + idx];
          O[(size_t)(rt * 16 + 4 * (ln >> 4) + j) * DM + ct * 32 + 16 * n + (ln & 15)] = (bf16)(pk2(s, 0.f) & 0xffffu); }
        __syncthreads();
    }
}

constexpr int VP = 144;
DI void attn_step(const bf16x8 (&kf)[4], const bf16x8 (&qf)[4], f32x16 (&O)[2], float& mrun, float& lrun, const LAS float* tab, float bias_far, bool nearb, int dq  , int maskfrom  ,
                  const LAS char* vs, int kb, int h, int q4, int p4, int blk) {
    bf16x8 vf0[2], vf1[2];
#pragma unroll
    for (int dt = 0; dt < 2; ++dt) {
        vf0[dt] = vtr2(vs + (kb + 4 * h + q4) * VP + 2 * (32 * dt + 16 * blk) + 8 * p4, 8 * VP);
        vf1[dt] = vtr2(vs + (kb + 16 + 4 * h + q4) * VP + 2 * (32 * dt + 16 * blk) + 8 * p4, 8 * VP); }
    f32x16 S = zero16();
#pragma unroll
    for (int s = 0; s < 4; ++s) S = MFMA32(kf[s], qf[s], S);
    if (nearb) {
#pragma unroll
        for (int i = 0; i < 16; ++i) { int d = dq - ((i & 3) + 8 * (i >> 2)); d = d > 256 ? 256 : d; S[i] += tab[d + 63]; }
    } else {
#pragma unroll
        for (int i = 0; i < 16; ++i) S[i] += bias_far;
    }
    if (maskfrom < 64) {
#pragma unroll
        for (int i = 0; i < 16; ++i) if ((i & 3) + 8 * (i >> 2) + 4 * h >= maskfrom) S[i] = -1e30f;
    }
    float mx = S[0];
#pragma unroll
    for (int i = 1; i < 16; ++i) mx = fmaxf(mx, S[i]);
    mx = fmaxf(mx, __shfl_xor(mx, 32));
    const float mnew = fmaxf(mrun, mx), alpha = __builtin_amdgcn_exp2f(mrun - mnew);
    float rs = 0.f;
#pragma unroll
    for (int i = 0; i < 16; ++i) { S[i] = __builtin_amdgcn_exp2f(S[i] - mnew); rs += S[i]; }
    lrun = lrun * alpha + rs;
    if (__builtin_amdgcn_ballot_w64(mnew > mrun)) { O[0] *= alpha; O[1] *= alpha; }
    mrun = mnew;
    const bf16x8 pf0 = pack8(S, 0), pf1 = pack8(S, 1);
#pragma unroll
    for (int dt = 0; dt < 2; ++dt) { O[dt] = MFMA32(vf0[dt], pf0, O[dt]); O[dt] = MFMA32(vf1[dt], pf1, O[dt]); }
}
template <bool SAMPLE>
DI void attn_unit(int l, int bb, int c, int qhalf, LAS unsigned char* lds) {
    const ArgsP a = get_args(); const int tid = get_tid(), lane = tid & 63, hd = tid >> 6, r = lane & 31, h = lane >> 5;
    const int i16 = lane & 15, q4 = i16 >> 2, p4 = i16 & 3, blk = (lane >> 4) & 1;
    const bf16* Z = (const bf16*)(a->ws + WS_Z); bf16* ACT = (bf16*)(a->ws + WS_ACT);
    LAS char* vs = (LAS char*)(lds + hd * 9216);
    const LAS float* tab = (const LAS float*)(lds + 73728 + hd * 1280);
    LAS float* xs = (LAS float*)(lds + 73728 + 10240);
    const int qrow0 = SAMPLE ? MPR + bb * 16 : bb * SEQ + c * 64;
    const bf16* kc16 = (const bf16*)(a->ws + WS_KC) + (size_t)(bb * 8 + hd) * 512 * 64;
    const bf16* vc16 = (const bf16*)(a->ws + WS_VC) + (size_t)(bb * 8 + hd) * 512 * 64;
    bf16x8 qf[4];
    { const int qr = SAMPLE ? (r < 16 ? r : 15) : 32 * qhalf + r;
#pragma unroll
      for (int s = 0; s < 4; ++s) qf[s] = *(const bf16x8*)(Z + (size_t)(qrow0 + qr) * NZ + hd * 64 + 16 * s + 8 * h); }
    f32x16 O[2]; O[0] = zero16(); O[1] = zero16(); float mrun = -1e30f, lrun = 0.f;
    const float bias_far = tab[319];
    const int q = 32 * qhalf + r;
    const int jstart = SAMPLE ? 0 : (c >= 8 ? 0 : 8 - c);
#define ATT_SRC(J) const bf16* kb_; const bf16* vb_; int pitch_, rmax_; \
    if (SAMPLE && (J) < 8) { kb_ = kc16 + (size_t)(64 * (J)) * 64; vb_ = vc16 + (size_t)(64 * (J)) * 64; pitch_ = 64; rmax_ = 63; } \
    else if (SAMPLE) { kb_ = Z + (size_t)qrow0 * NZ + 512 + hd * 64; vb_ = kb_ + 512; pitch_ = NZ; rmax_ = 15; } \
    else { kb_ = Z + (size_t)(bb * SEQ + (c + (J) - 8) * 64) * NZ + 512 + hd * 64; vb_ = kb_ + 512; pitch_ = NZ; rmax_ = 63; }
#define ATT_LOADK(J, KS, KF) do { ATT_SRC(J) int kr_ = 32 * (KS) + r; kr_ = kr_ > rmax_ ? rmax_ : kr_; (void)vb_; \
    _Pragma("unroll") for (int s = 0; s < 4; ++s) KF[s] = *(const bf16x8*)(kb_ + (size_t)kr_ * pitch_ + 16 * s + 8 * h); } while (0)
#define ATT_LOADV(J, VR) do { ATT_SRC(J) (void)kb_; \
    _Pragma("unroll") for (int it = 0; it < 8; ++it) { int key_ = it * 8 + (lane >> 3); key_ = key_ > rmax_ ? rmax_ : key_; VR[it] = *(const u32x4*)(vb_ + (size_t)key_ * pitch_ + (lane & 7) * 8); } } while (0)
    bf16x8 kA[4], kB[4]; u32x4 vr[8];
    ATT_LOADK(jstart, 0, kA);
    ATT_LOADV(jstart, vr);
#pragma unroll 1
    for (int j = jstart; j < 9; ++j) {
        LDS_FENCE();
#pragma unroll
        for (int it = 0; it < 8; ++it) *(LAS u32x4*)(vs + (it * 8 + (lane >> 3)) * VP + (lane & 7) * 16) = vr[it];
        if (j < 8) ATT_LOADV(j + 1, vr);
        ATT_LOADK(j, 1, kB);
        LDS_FENCE();
        const bool nearb = j >= 4; const int mf = (SAMPLE && j == 8) ? 16 : 64;
        attn_step(kA, qf, O, mrun, lrun, tab, bias_far, nearb, 512 + q - (64 * j + 4 * h), mf, vs, 0, h, q4, p4, blk);
        if (j < 8) ATT_LOADK(j + 1, 0, kA);
        if (!(SAMPLE && j == 8)) attn_step(kB, qf, O, mrun, lrun, tab, bias_far, nearb, 512 + q - (64 * j + 32 + 4 * h), 64, vs, 32, h, q4, p4, blk);
    }
#undef ATT_SRC
#undef ATT_LOADK
#undef ATT_LOADV
    const float lt = lrun + __shfl_xor(lrun, 32); const float inv = 1.0f / lt; float ssq = 0.f;
#pragma unroll
    for (int dt = 0; dt < 2; ++dt) { O[dt] *= inv;
#pragma unroll
        for (int i = 0; i < 16; ++i) ssq += O[dt][i] * O[dt][i]; }
    ssq += __shfl_xor(ssq, 32);
    if (h == 0) xs[hd * 64 + 32 * qhalf + r] = ssq;
    __syncthreads();
    const float* gatt = a->in[13] + l * 512 + hd * 64;
    float tot = 0.f;
#pragma unroll
    for (int w = 0; w < 8; ++w) tot += xs[w * 64 + 32 * qhalf + r];
    const float rr = 1.0f / sqrtf(tot * (1.f / 512.f) + EPS);
    const bool ok = SAMPLE ? (r < 16) : true;
    bf16* orow = ACT + (size_t)(qrow0 + 32 * qhalf + r) * DM + hd * 64;
    if (ok) {
#pragma unroll
        for (int dt = 0; dt < 2; ++dt)
#pragma unroll
            for (int g = 0; g < 4; ++g) { const int e0 = 32 * dt + 8 * g + 4 * h; const f32x4 gv = *(const f32x4*)(gatt + e0);
                u32x2 o; o.x = pk2(O[dt][4 * g] * rr * gv.x, O[dt][4 * g + 1] * rr * gv.y); o.y = pk2(O[dt][4 * g + 2] * rr * gv.z, O[dt][4 * g + 3] * rr * gv.w);
                *(u32x2*)(orow + e0) = o; }
    }
    __syncthreads();
}

constexpr int MPB = 288;
DI void m1_item(bool sample, int bb, int c, LAS unsigned char* lds, int hp = -1  ) {
    const ArgsP a = get_args(); const int tid = get_tid(), lane = tid & 63, wave = tid >> 6, head = wave >> 1, half = wave & 1, r = lane & 31, h = lane >> 5;
    const int i16 = lane & 15, q4 = i16 >> 2, p4 = i16 & 3, blk = (lane >> 4) & 1;
    const bf16* Z = (const bf16*)(a->ws + WS_Z); const float* IG = (const float*)(a->ws + WS_IG); const float* LF = (const float*)(a->ws + WS_LF);
    bf16* SC = (bf16*)(a->ws + WS_SC);
    const int row0 = sample ? MPR + bb * 16 : bb * SEQ + c * 64;
    const int u = sample ? 1024 + bb * 4 + head : (bb * 4 + head) * 128 + c;
    const bool act = (hp < 0) || ((head >> 1) == hp);
    u32x4 st16[16];
#pragma unroll
    for (int it = 0; it < 16; ++it) { const int rr = it * 4 + (lane >> 4), ch = lane & 15; const int srow = row0 + (sample ? (rr < 16 ? rr : 15) : rr);
        st16[it] = *(const u32x4*)(Z + (size_t)srow * NZ + (half == 0 ? 2048 : 2560) + head * 128 + ch * 8); }
    const bool valid = sample ? (lane < 16) : true;
    const int rs = row0 + (sample ? (lane < 16 ? lane : 15) : lane);
    float b = valid ? LF[(size_t)rs * 4 + head] : 0.f; const float ig = valid ? IG[(size_t)rs * 4 + head] : -INFINITY;
#pragma unroll
    for (int o = 1; o < 64; o <<= 1) { const float t = __shfl_up(b, o); if (lane >= o) b += t; }
    const float av = ig - b; const float ac = wave_max(av); const float w = __expf(av - ac); const float bl = __shfl(b, 63);
    if (act && half == 0 && lane == 0) { ((float*)(a->ws + WS_BL))[u] = bl; ((float*)(a->ws + WS_AC))[u] = ac; }
    LAS char* kbase = (LAS char*)(lds + head * 36864); LAS char* vbase = kbase + 18432;
#pragma unroll
    for (int it = 0; it < 16; ++it) { const int rr = it * 4 + (lane >> 4), ch = lane & 15;
        const float wr = __shfl(w, rr); const u32x4 x = st16[it];
        if (half == 0) { u32x4 o;
            o.x = pk2(bflo(x.x) * wr, bfhi(x.x) * wr); o.y = pk2(bflo(x.y) * wr, bfhi(x.y) * wr); o.z = pk2(bflo(x.z) * wr, bfhi(x.z) * wr); o.w = pk2(bflo(x.w) * wr, bfhi(x.w) * wr);
            *(LAS u32x4*)(kbase + rr * MPB + ch * 16) = o; }
        else *(LAS u32x4*)(vbase + rr * MPB + ch * 16) = x;
    }
    __syncthreads();
    if (act) {
#pragma unroll
    for (int dh = 0; dh < 2; ++dh) {
        f32x16 acc[2][2];
#pragma unroll
        for (int di = 0; di < 2; ++di) { acc[di][0] = zero16(); acc[di][1] = zero16(); }
#pragma unroll
        for (int ks = 0; ks < 4; ++ks) {
            bf16x8 af[2], bfr[2];
#pragma unroll
            for (int di = 0; di < 2; ++di) af[di] = vtr2(kbase + (16 * ks + 8 * h + q4) * MPB + 2 * (32 * (2 * dh + di) + 16 * blk) + 8 * p4, 4 * MPB);
#pragma unroll
            for (int ei = 0; ei < 2; ++ei) bfr[ei] = vtr2(vbase + (16 * ks + 8 * h + q4) * MPB + 2 * (32 * (2 * half + ei) + 16 * blk) + 8 * p4, 4 * MPB);
#pragma unroll
            for (int di = 0; di < 2; ++di)
#pragma unroll
                for (int ei = 0; ei < 2; ++ei) acc[di][ei] = MFMA32(af[di], bfr[ei], acc[di][ei]);
        }
#pragma unroll
        for (int di = 0; di < 2; ++di)
#pragma unroll
            for (int ei = 0; ei < 2; ++ei)
#pragma unroll
                for (int g = 0; g < 4; ++g) { const int e = 32 * (2 * half + ei) + r, d0 = 32 * (2 * dh + di) + 8 * g + 4 * h;
                    u32x2 o; o.x = pk2(acc[di][ei][4 * g], acc[di][ei][4 * g + 1]); o.y = pk2(acc[di][ei][4 * g + 2], acc[di][ei][4 * g + 3]);
                    *(u32x2*)(SC + (size_t)u * 16384 + e * 128 + d0) = o; }
    }
    { const int d = half * 64 + lane; float s = 0.f;
#pragma unroll 8
      for (int sidx = 0; sidx < 64; ++sidx) s += bf2f(*(const LAS unsigned short*)(kbase + sidx * MPB + d * 2));
      ((float*)(a->ws + WS_NC))[(size_t)u * 128 + d] = s; }
    }
    __syncthreads();
}

DI void phase_c_pre(int l) {
    const ArgsP a = get_args(); const int tid = get_tid();
    const bf16* Z = (const bf16*)(a->ws + WS_Z);
    for (int it = get_bid() * NTHR + tid; it < 147456; it += get_nb() * NTHR) {
        int row, kv, cc; float* dst;
        if (it < 131072) { const int b = it >> 16, t = (it >> 7) & 511; kv = (it >> 6) & 1; cc = it & 63; row = b * SEQ + (SEQ - 512) + t;
            dst = a->out + (kv ? O_VP : O_KP) + ((size_t)((l * 2 + b) * 8 + (cc >> 3)) * 512 + t) * 64 + (cc & 7) * 8; }
        else { const int i2 = it - 131072; const int rr = i2 >> 7; kv = (i2 >> 6) & 1; cc = i2 & 63; row = MPR + rr; const int sb = rr >> 4, t = rr & 15;
            dst = a->out + (kv ? O_VS : O_KS) + ((size_t)((l * 8 + sb) * 8 + (cc >> 3)) * 16 + t) * 64 + (cc & 7) * 8; }
        const u32x4 x = *(const u32x4*)(Z + (size_t)row * NZ + 512 + kv * 512 + cc * 8);
        f32x4 o0 = {bflo(x.x), bfhi(x.x), bflo(x.y), bfhi(x.y)}, o1 = {bflo(x.z), bfhi(x.z), bflo(x.w), bfhi(x.w)};
        __builtin_nontemporal_store(o0, (f32x4*)dst); __builtin_nontemporal_store(o1, (f32x4*)(dst + 4));
    }
}

DI void phase_m2(int l, LAS unsigned char* lds) {
    const ArgsP a = get_args(); const int tid = get_tid(), lane = tid & 63;
    bf16* SC = (bf16*)(a->ws + WS_SC); const float* BL = (const float*)(a->ws + WS_BL); const float* AC = (const float*)(a->ws + WS_AC);
    float* MPREV = (float*)(a->ws + WS_MPREV); const float* NC = (const float*)(a->ws + WS_NC); float* NPREV = (float*)(a->ws + WS_NPREV);
    LAS float* DEC = (LAS float*)lds; LAS float* SCL = DEC + 128;
    const int NTH = get_nb() * NTHR;
    for (int base = get_bid() * NTHR; base < 8 * 16384; base += NTH) {
        const int bh = base >> 14, el = (base & 16383) + tid; const bool doN = el < 128;
        __syncthreads();
        if (tid < 64) {
            float Fc = 0.f, gc = 0.f;
#pragma unroll
            for (int rd = 0; rd < 2; ++rd) {
                const int c = rd * 64 + lane, u = bh * 128 + c; const float bl = BL[u], ac = AC[u];
                float F = bl;
#pragma unroll
                for (int o = 1; o < 64; o <<= 1) { const float t = __shfl_up(F, o); if (lane >= o) F += t; }
                F += Fc;
                float Fm1 = __shfl_up(F, 1); if (lane == 0) Fm1 = Fc;
                float g = ac - Fm1;
#pragma unroll
                for (int o = 1; o < 64; o <<= 1) { const float t = __shfl_up(g, o); if (lane >= o) g = fmaxf(g, t); }
                g = fmaxf(g, gc);
                float gm1 = __shfl_up(g, 1); if (lane == 0) gm1 = gc;
                const float mprev = Fm1 + gm1, mnew = F + g;
                DEC[c] = expf(bl + mprev - mnew); SCL[c] = expf(bl + ac - mnew);
                if ((base & 16383) == 0) { MPREV[u] = mprev; if (c == 127) a->out[O_MP + l * 8 + bh] = mnew; }
                Fc = __shfl(F, 63); gc = __shfl(g, 63);
            }
        }
        __syncthreads();
        float C = 0.f, n = 0.f;
#pragma unroll 1
        for (int c0 = 0; c0 < 128; c0 += 32) {
            float s[32];
#pragma unroll
            for (int k = 0; k < 32; ++k) s[k] = bf2f(SC[(size_t)(bh * 128 + c0 + k) * 16384 + el]);
            if (doN) {
                float nc[32];
#pragma unroll
                for (int k = 0; k < 32; ++k) nc[k] = NC[(size_t)(bh * 128 + c0 + k) * 128 + el];
#pragma unroll
                for (int k = 0; k < 32; ++k) { NPREV[(size_t)(bh * 128 + c0 + k) * 128 + el] = n; n = DEC[c0 + k] * n + SCL[c0 + k] * nc[k]; }
            }
#pragma unroll
            for (int k = 0; k < 32; ++k) { SC[(size_t)(bh * 128 + c0 + k) * 16384 + el] = (bf16)(pk2(C, 0.f) & 0xffffu); C = DEC[c0 + k] * C + SCL[c0 + k] * s[k]; }
        }
        const int e = el >> 7, d = el & 127;
        a->out[O_CP + (size_t)(l * 8 + bh) * 16384 + d * 128 + e] = C;
        if (doN) a->out[O_NP + (size_t)(l * 8 + bh) * 128 + el] = n;
    }
}

DI void m3_item(int l, bool sample, int bb, int c, LAS unsigned char* lds, int hp = -1) {
    const ArgsP a = get_args(); const int tid = get_tid(), lane = tid & 63, wave = tid >> 6, head = wave >> 1, tt = wave & 1, r = lane & 31, h = lane >> 5;
    const int i16 = lane & 15, q4 = i16 >> 2, p4 = i16 & 3, blk = (lane >> 4) & 1;
    const bf16* Z = (const bf16*)(a->ws + WS_Z); const float* IG = (const float*)(a->ws + WS_IG); const float* LF = (const float*)(a->ws + WS_LF);
    const bf16* SC = (const bf16*)(a->ws + WS_SC); bf16* ACT = (bf16*)(a->ws + WS_ACT);
    const int row0 = sample ? MPR + bb * 16 : bb * SEQ + c * 64;
    const int u = sample ? 1024 + bb * 4 + head : (bb * 4 + head) * 128 + c;
    LAS char* vbase = (LAS char*)(lds + head * 18432);
    LAS float* AS = (LAS float*)(lds + 73728) + head * 64; LAS float* BS = (LAS float*)(lds + 73728 + 1024) + head * 64;
    LAS float* MT = (LAS float*)(lds + 73728 + 2048) + head * 64; LAS float* NP = (LAS float*)(lds + 73728 + 3072) + head * 128;
    const float mprev = ((const float*)(a->ws + WS_MPREV))[u];
    {
        const bool valid = sample ? (lane < 16) : true;
        const int rs = row0 + (sample ? (lane < 16 ? lane : 15) : lane);
        float b = valid ? LF[(size_t)rs * 4 + head] : 0.f; const float ig = valid ? IG[(size_t)rs * 4 + head] : -INFINITY;
#pragma unroll
        for (int o = 1; o < 64; o <<= 1) { const float t = __shfl_up(b, o); if (lane >= o) b += t; }
        const float av = ig - b; float cm = av;
#pragma unroll
        for (int o = 1; o < 64; o <<= 1) { const float t = __shfl_up(cm, o); if (lane >= o) cm = fmaxf(cm, t); }
        const float mt = b + fmaxf(mprev, cm);
        if (tt == 0) { AS[lane] = av; BS[lane] = b; MT[lane] = mt; const float* np = (const float*)(a->ws + WS_NPREV) + (size_t)u * 128; NP[lane] = np[lane]; NP[64 + lane] = np[64 + lane]; }
    }
#pragma unroll
    for (int hb = 0; hb < 2; ++hb) {
        u32x4 vst[4];
#pragma unroll
        for (int it = 0; it < 4; ++it) { const int idx = (4 * hb + it) * 128 + tt * 64 + lane; const int rr = idx >> 4, ch = idx & 15; const int srow = row0 + (sample ? (rr < 16 ? rr : 15) : rr);
            vst[it] = *(const u32x4*)(Z + (size_t)srow * NZ + 2560 + head * 128 + ch * 8); }
#pragma unroll
        for (int it = 0; it < 4; ++it) { const int idx = (4 * hb + it) * 128 + tt * 64 + lane; const int rr = idx >> 4, ch = idx & 15; *(LAS u32x4*)(vbase + rr * MPB + ch * 16) = vst[it]; }
    }
    const int t = 32 * tt + r;
    const int rowt = row0 + (sample ? (t < 16 ? t : 15) : t);
    bf16x8 qf[8];
#pragma unroll
    for (int s = 0; s < 8; ++s) qf[s] = *(const bf16x8*)(Z + (size_t)rowt * NZ + 1536 + head * 128 + 16 * s + 8 * h);
    bf16x8 scf[2][8], kf0[8];
#pragma unroll
    for (int et = 0; et < 2; ++et)
#pragma unroll
        for (int s = 0; s < 8; ++s) scf[et][s] = *(const bf16x8*)(SC + (size_t)u * 16384 + (32 * et + r) * 128 + 16 * s + 8 * h);
    { const int krow = row0 + (sample ? (r < 16 ? r : 15) : r);
#pragma unroll
      for (int s = 0; s < 8; ++s) kf0[s] = *(const bf16x8*)(Z + (size_t)krow * NZ + 2048 + head * 128 + 16 * s + 8 * h); }
    __syncthreads();
    if (!(sample && tt == 1) && ((hp < 0) || ((head >> 1) == hp))) {
        f32x16 acc[4];
#pragma unroll
        for (int et = 0; et < 2; ++et) { acc[et] = zero16();
#pragma unroll
            for (int s = 0; s < 8; ++s) acc[et] = MFMA32(scf[et][s], qf[s], acc[et]); }
#pragma unroll
        for (int et = 2; et < 4; ++et) { acc[et] = zero16();
#pragma unroll
            for (int s = 0; s < 8; ++s) { const bf16x8 af = *(const bf16x8*)(SC + (size_t)u * 16384 + (32 * et + r) * 128 + 16 * s + 8 * h); acc[et] = MFMA32(af, qf[s], acc[et]); } }
        const float bt = BS[t], mtt = MT[t]; const float wint = __expf(bt + mprev - mtt);
#pragma unroll
        for (int et = 0; et < 4; ++et) acc[et] *= wint;
        float qn = 0.f;
#pragma unroll
        for (int s = 0; s < 8; ++s)
#pragma unroll
            for (int jj = 0; jj < 8; ++jj) qn += bf2f((unsigned short)qf[s][jj]) * NP[16 * s + 8 * h + jj];
        qn += __shfl_xor(qn, 32);
        float den = wint * qn, denp = 0.f;
        u32x2 ogv[4][4];
#pragma unroll
        for (int et = 0; et < 4; ++et)
#pragma unroll
            for (int g = 0; g < 4; ++g) ogv[et][g] = *(const u32x2*)(Z + (size_t)rowt * NZ + 3072 + head * 128 + 32 * et + 8 * g + 4 * h);
        for (int st = 0; st <= tt; ++st) {
            f32x16 S = zero16();
            const int kr = 32 * st + r; const int krow = row0 + (sample ? (kr < 16 ? kr : 15) : kr);
            if (st == 0) {
#pragma unroll
                for (int s = 0; s < 8; ++s) S = MFMA32(kf0[s], qf[s], S);
            } else {
#pragma unroll
                for (int s = 0; s < 8; ++s) { const bf16x8 kf = *(const bf16x8*)(Z + (size_t)krow * NZ + 2048 + head * 128 + 16 * s + 8 * h); S = MFMA32(kf, qf[s], S); }
            }
#pragma unroll
            for (int i = 0; i < 16; ++i) { const int sl = 32 * st + (i & 3) + 8 * (i >> 2) + 4 * h; const float wgt = (sl <= t) ? __expf(bt + AS[sl] - mtt) : 0.f; S[i] *= wgt; denp += S[i]; }
            const bf16x8 pf0 = pack8(S, 0), pf1 = pack8(S, 1);
#pragma unroll
            for (int et = 0; et < 4; ++et) {
                const bf16x8 v0 = vtr2(vbase + (32 * st + 4 * h + q4) * MPB + 2 * (32 * et + 16 * blk) + 8 * p4, 8 * MPB);
                const bf16x8 v1 = vtr2(vbase + (32 * st + 16 + 4 * h + q4) * MPB + 2 * (32 * et + 16 * blk) + 8 * p4, 8 * MPB);
                acc[et] = MFMA32(v0, pf0, acc[et]); acc[et] = MFMA32(v1, pf1, acc[et]);
            }
        }
        den += denp + __shfl_xor(denp, 32);
        const float dd = fmaxf(fabsf(den), __expf(-mtt)); const float inv = 1.0f / dd;
        float ssq = 0.f;
#pragma unroll
        for (int et = 0; et < 4; ++et) { acc[et] *= inv;
#pragma unroll
            for (int i = 0; i < 16; ++i) ssq += acc[et][i] * acc[et][i]; }
        ssq += __shfl_xor(ssq, 32);
        const float rr = 1.0f / sqrtf(ssq * (1.f / 128.f) + EPS);
        const bool ok = sample ? (t < 16) : true;
        if (ok) {
            const float* gml = a->in[14] + l * 512 + head * 128;
#pragma unroll
            for (int et = 0; et < 4; ++et)
#pragma unroll
                for (int g = 0; g < 4; ++g) { const int e0 = 32 * et + 8 * g + 4 * h;
                    const u32x2 ob = ogv[et][g]; const f32x4 gm = *(const f32x4*)(gml + e0);
                    const float o0 = bflo(ob.x), o1 = bfhi(ob.x), o2 = bflo(ob.y), o3 = bfhi(ob.y);
                    const float y0 = acc[et][4 * g] * rr * gm.x * __builtin_amdgcn_rcpf(1.f + __expf(-o0)), y1 = acc[et][4 * g + 1] * rr * gm.y * __builtin_amdgcn_rcpf(1.f + __expf(-o1));
                    const float y2 = acc[et][4 * g + 2] * rr * gm.z * __builtin_amdgcn_rcpf(1.f + __expf(-o2)), y3 = acc[et][4 * g + 3] * rr * gm.w * __builtin_amdgcn_rcpf(1.f + __expf(-o3));
                    u32x2 o; o.x = pk2(y0, y1); o.y = pk2(y2, y3);
                    *(u32x2*)(ACT + (size_t)rowt * DM + 512 + head * 128 + e0) = o; }
        }
    }
    __syncthreads();
}
DI void sample_m2(int l, int sb, int hp, LAS unsigned char* lds) {
    const ArgsP a = get_args(); const int tid = get_tid();
    bf16* SC = (bf16*)(a->ws + WS_SC); const float* BL = (const float*)(a->ws + WS_BL); const float* AC = (const float*)(a->ws + WS_AC);
    float* MPREV = (float*)(a->ws + WS_MPREV); const float* NC = (const float*)(a->ws + WS_NC); float* NPREV = (float*)(a->ws + WS_NPREV);
    LAS float* Lc = (LAS float*)lds; LAS float* Ls = Lc + 128 * 129;
    for (int hh = 2 * hp; hh < 2 * hp + 2; ++hh) {
        const int su = sb * 4 + hh, u = 1024 + su;
        const float* c0p = a->in[4] + (size_t)(l * 32 + su) * 16384; bf16* scp = SC + (size_t)u * 16384; float* ocp = a->out + O_CS + (size_t)(l * 32 + su) * 16384;
        const float m0 = a->in[6][l * 32 + su];
        const float bl = BL[u], ac = AC[u]; const float mn = bl + fmaxf(m0, ac); const float dec = expf(bl + m0 - mn), sc = expf(bl + ac - mn);
#pragma unroll 1
        for (int i0 = 0; i0 < 32; i0 += 16) {
            float cv[16]; unsigned short sv[16];
#pragma unroll
            for (int ii = 0; ii < 16; ++ii) { const int idx = tid + (i0 + ii) * NTHR; cv[ii] = c0p[idx]; sv[ii] = scp[idx]; }
#pragma unroll
            for (int ii = 0; ii < 16; ++ii) { const int idx = tid + (i0 + ii) * NTHR; const int r = idx >> 7, q = idx & 127; Lc[r * 129 + q] = cv[ii]; Ls[r * 129 + q] = bf2f(sv[ii]); }
        }
        __syncthreads();
#pragma unroll
        for (int ii = 0; ii < 32; ++ii) { const int idx = tid + ii * NTHR; const int r = idx >> 7, q = idx & 127;
            scp[idx] = (bf16)(pk2(Lc[q * 129 + r], 0.f) & 0xffffu);
            ocp[idx] = dec * Lc[r * 129 + q] + sc * Ls[q * 129 + r]; }
        if (tid < 128) { const float n0 = a->in[5][(size_t)(l * 32 + su) * 128 + tid]; NPREV[(size_t)u * 128 + tid] = n0; a->out[O_NS + (size_t)(l * 32 + su) * 128 + tid] = dec * n0 + sc * NC[(size_t)u * 128 + tid]; }
        if (tid == 0) { MPREV[u] = m0; a->out[O_MS + l * 32 + su] = mn; }
        __syncthreads();
    }
}
#define BLOCK_MEM_SYNC() do { asm volatile("s_waitcnt vmcnt(0)" ::: "memory"); __syncthreads(); __builtin_amdgcn_fence(__ATOMIC_ACQUIRE, "agent"); asm volatile("s_waitcnt vmcnt(0)" ::: "memory"); } while (0)
DI void load_bias(int l, LAS unsigned char* lds) {
    const ArgsP a = get_args(); const int tid = get_tid();
    for (int e = tid; e < 8 * 320; e += NTHR) { const int hd = e / 320, i = e % 320; ((LAS float*)(lds + 73728))[hd * 320 + i] = a->in[12][(size_t)(l * 8 + hd) * 513 + 193 + i] * 1.4426950408889634f; }
    __syncthreads();
}
DI void phase_c(int l, LAS unsigned char* lds) {
    phase_c_pre(l);
    const int bid = get_bid(), nb = get_nb();
    const bool deal = (nb == 256);
    const int v = deal ? ((bid & 7) * 32 + (bid >> 3)) : bid;
    for (int t = v; t < 16; t += nb) {
        m1_item(true, t >> 1, 0, lds, t & 1);
        BLOCK_MEM_SYNC();
        sample_m2(l, t >> 1, t & 1, lds);
        BLOCK_MEM_SYNC();
        m3_item(l, true, t >> 1, 0, lds, t & 1);
    }
    int p_lo, p_hi, p_st, m_lo, m_hi, m_st;
    if (deal) { const int w = v - 16; p_lo = w < 0 ? 520 : (w * 520) / 240; p_hi = w < 0 ? 520 : ((w + 1) * 520) / 240; p_st = 1;
                const int r2 = 3 * w - p_lo; const bool two = (w >= 0) && (p_hi - p_lo == 2); m_lo = two ? (r2 * 256) / 200 : 256; m_hi = two ? ((r2 + 1) * 256) / 200 : 256; m_st = 1; }
    else { p_lo = bid; p_hi = 520; p_st = nb; m_lo = bid; m_hi = 256; m_st = nb; }
    if (p_lo < p_hi) load_bias(l, lds);
    for (int p = p_lo; p < p_hi; p += p_st) {
        if (p >= 512) attn_unit<true>(l, p - 512, 0, 0, lds);
        else attn_unit<false>(l, p >> 8, (p >> 1) & 127, p & 1, lds);
    }
    __syncthreads();
    for (int t = m_lo; t < m_hi; t += m_st) m1_item(false, t >> 7, t & 127, lds);
}
DI void phase_e(int l, LAS unsigned char* lds) {
    const int bid = get_bid(), nb = get_nb(); const int v0 = (nb == 256) ? ((bid & 7) * 32 + (bid >> 3)) : bid;
    for (int it = v0; it < 256; it += nb) m3_item(l, false, it >> 7, it & 127, lds);
}

DI float gelu_tanh(float x) { const float ee = __builtin_amdgcn_exp2f(x * (2.3022082f + 0.10294324f * x * x)); return x - x * __builtin_amdgcn_rcpf(ee + 1.f); }
DI void ld8(const bf16* p, float (&o)[8]) { const u32x4 x = *(const u32x4*)p; o[0] = bflo(x.x); o[1] = bfhi(x.x); o[2] = bflo(x.y); o[3] = bfhi(x.y); o[4] = bflo(x.z); o[5] = bfhi(x.z); o[6] = bflo(x.w); o[7] = bfhi(x.w); }
DI void ldf8(const float* p, float (&o)[8]) { const f32x4 x = *(const f32x4*)p, y = *(const f32x4*)(p + 4); o[0] = x.x; o[1] = x.y; o[2] = x.z; o[3] = x.w; o[4] = y.x; o[5] = y.y; o[6] = y.z; o[7] = y.w; }
DI void phase_fix(int l) {
    const ArgsP a = get_args(); const int gt = get_bid() * NTHR + get_tid(), NTH = get_nb() * NTHR;
    const bf16* UQ = (const bf16*)(a->ws + WS_UQ); bf16* G = (bf16*)(a->ws + WS_G);
    const float* wc = a->in[17] + (size_t)l * 3 * NU; const float* bc = a->in[18] + (size_t)l * NU;
    for (int item = gt; item < (MVALID / 16) * 352; item += NTH) {
        const int k = item / 352, cc = item % 352, j0 = cc * 8; const int m0 = 16 * k;
        const bool smp = m0 >= MPR; const bool bstart = smp ? true : ((m0 & (SEQ - 1)) == 0); const int sb = smp ? (m0 - MPR) >> 4 : 0;
        float w0g[8], w1g[8], w2g[8], bg[8], w0u[8], w1u[8], w2u[8], bu[8];
        ldf8(wc + j0, w0g); ldf8(wc + NU + j0, w1g); ldf8(wc + 2 * NU + j0, w2g); ldf8(bc + j0, bg);
        ldf8(wc + DFF + j0, w0u); ldf8(wc + NU + DFF + j0, w1u); ldf8(wc + 2 * NU + DFF + j0, w2u); ldf8(bc + DFF + j0, bu);
        float p2g[8], p1g[8], p2u[8], p1u[8], c0g[8], c0u[8], c1g[8], c1u[8];
        if (bstart) {
            if (smp) { const float* cb = a->in[7] + (size_t)((l * 8 + sb) * 2) * NU; ldf8(cb + j0, p2g); ldf8(cb + NU + j0, p1g); ldf8(cb + DFF + j0, p2u); ldf8(cb + NU + DFF + j0, p1u); }
            else {
#pragma unroll
                for (int q = 0; q < 8; ++q) { p2g[q] = 0.f; p1g[q] = 0.f; p2u[q] = 0.f; p1u[q] = 0.f; } }
        } else { const bf16* pq = UQ + (size_t)(4 * (k - 1) + 2) * NU; ld8(pq + j0, p2g); ld8(pq + NU + j0, p1g); ld8(pq + DFF + j0, p2u); ld8(pq + NU + DFF + j0, p1u); }
        const bf16* cq = UQ + (size_t)(4 * k) * NU; ld8(cq + j0, c0g); ld8(cq + DFF + j0, c0u); ld8(cq + NU + j0, c1g); ld8(cq + NU + DFF + j0, c1u);
        float o0[8], o1[8];
#pragma unroll
        for (int q = 0; q < 8; ++q) {
            o0[q] = gelu_tanh(bg[q] + p2g[q] * w0g[q] + p1g[q] * w1g[q] + c0g[q] * w2g[q]) * (bu[q] + p2u[q] * w0u[q] + p1u[q] * w1u[q] + c0u[q] * w2u[q]);
            o1[q] = gelu_tanh(bg[q] + p1g[q] * w0g[q] + c0g[q] * w1g[q] + c1g[q] * w2g[q]) * (bu[q] + p1u[q] * w0u[q] + c0u[q] * w1u[q] + c1u[q] * w2u[q]); }
        u32x4 ov; ov.x = pk2(o0[0], o0[1]); ov.y = pk2(o0[2], o0[3]); ov.z = pk2(o0[4], o0[5]); ov.w = pk2(o0[6], o0[7]);
        *(u32x4*)(G + (size_t)m0 * DFF + j0) = ov;
        ov.x = pk2(o1[0], o1[1]); ov.y = pk2(o1[2], o1[3]); ov.z = pk2(o1[4], o1[5]); ov.w = pk2(o1[6], o1[7]);
        *(u32x4*)(G + (size_t)(m0 + 1) * DFF + j0) = ov;
        const bool lastg = smp ? true : ((m0 & (SEQ - 1)) == SEQ - 16);
        if (lastg) {
            float* fo = smp ? a->out + O_FS + (size_t)((l * 8 + sb) * 2) * NU : a->out + O_FP + (size_t)((l * 2 + (m0 >> 13)) * 2) * NU;
            float e0[8], e1[8]; const bf16* lq = UQ + (size_t)(4 * k + 2) * NU;
            ld8(lq + j0, e0); ld8(lq + NU + j0, e1);
            *(f32x4*)(fo + j0) = (f32x4){e0[0], e0[1], e0[2], e0[3]}; *(f32x4*)(fo + j0 + 4) = (f32x4){e0[4], e0[5], e0[6], e0[7]};
            *(f32x4*)(fo + NU + j0) = (f32x4){e1[0], e1[1], e1[2], e1[3]}; *(f32x4*)(fo + NU + j0 + 4) = (f32x4){e1[4], e1[5], e1[6], e1[7]};
            ld8(lq + DFF + j0, e0); ld8(lq + NU + DFF + j0, e1);
            *(f32x4*)(fo + DFF + j0) = (f32x4){e0[0], e0[1], e0[2], e0[3]}; *(f32x4*)(fo + DFF + j0 + 4) = (f32x4){e0[4], e0[5], e0[6], e0[7]};
            *(f32x4*)(fo + NU + DFF + j0) = (f32x4){e1[0], e1[1], e1[2], e1[3]}; *(f32x4*)(fo + NU + DFF + j0 + 4) = (f32x4){e1[4], e1[5], e1[6], e1[7]};
        }
    }
}

#define XB_TMO      128
#define XB_XCNT(j)  (256  + 64 * (j))
#define XB_XSUB(j)  (1280 + 64 * (j))
#define XB_XGEN(j)  (2304 + 64 * (j))
#define XB_TOP      3328
#define XB_TOPGEN   3392
#define XCD_BAR_WORDS 3456
#define XB_SPIN_CAP (1u << 18)
__device__ __forceinline__ unsigned xb_ld(unsigned* p)              { return __hip_atomic_load(p, __ATOMIC_RELAXED, __HIP_MEMORY_SCOPE_AGENT); }
__device__ __forceinline__ unsigned xb_add(unsigned* p, unsigned v) { return __hip_atomic_fetch_add(p, v, __ATOMIC_RELAXED, __HIP_MEMORY_SCOPE_AGENT); }
__device__ __forceinline__ unsigned xb_xcc_id() { return (unsigned)__builtin_amdgcn_s_getreg((3 << 11) | 20) & 0xFu; }
#define XB_SPIN(cond, bar) do { unsigned _sp = 0; while (cond) { __builtin_amdgcn_s_sleep(1); \
    if ((++_sp & 255u) == 0u) { if (xb_ld(&(bar)[XB_TMO])) break; if (_sp > XB_SPIN_CAP) { atomicAdd(&(bar)[XB_TMO], 1u); break; } } } } while (0)

struct XcdBarrier {
    unsigned* bar; unsigned x;
    volatile LAS unsigned* st;
};

__device__ __forceinline__ XcdBarrier xcd_barrier_post(unsigned* bar, volatile LAS unsigned* st) {
    XcdBarrier b; b.bar = bar; b.x = xb_xcc_id(); b.st = st;
    if (threadIdx.x == 0) (void)xb_add(&bar[XB_XCNT(b.x)], 1u);
    return b;
}
__device__ __forceinline__ void xcd_barrier_complete(unsigned* bar, unsigned x, unsigned& nloc, unsigned& nx) {
    const unsigned G = gridDim.x * gridDim.y * gridDim.z;
    unsigned sum, cnt, mine, sp = 0u;
    for (;;) {
        sum = 0u; cnt = 0u; mine = 0u;
#pragma unroll
        for (unsigned j = 0; j < 16; ++j) { const unsigned c = xb_ld(&bar[XB_XCNT(j)]); sum += c; cnt += (c > 0u) ? 1u : 0u; mine = (j == x) ? c : mine; }
        if (sum == G) break;
        __builtin_amdgcn_s_sleep(1);
        if ((++sp & 255u) == 0u) { if (xb_ld(&bar[XB_TMO])) break; if (sp > XB_SPIN_CAP) { atomicAdd(&bar[XB_TMO], 1u); break; } }
    }
    nloc = mine > 0u ? mine : 1u; nx = cnt > 0u ? cnt : 1u;
}

__device__ __forceinline__ void xcd_barrier(const XcdBarrier& b) {
    asm volatile("s_waitcnt vmcnt(0)" ::: "memory");
    __syncthreads();
    if (threadIdx.x == 0) {
        unsigned* bar = b.bar;
        __builtin_amdgcn_s_waitcnt(0);
        unsigned nloc = b.st[0], nx = b.st[1];
        if (nloc == 0u) { xcd_barrier_complete(bar, b.x, nloc, nx); b.st[0] = nloc; b.st[1] = nx; }
        const unsigned old = xb_add(&bar[XB_XSUB(b.x)], 1u);
        const unsigned gen = old / nloc;
        if (old + 1u == (gen + 1u) * nloc) {
            __builtin_amdgcn_fence(__ATOMIC_RELEASE, "agent");
            asm volatile("s_waitcnt vmcnt(0)" ::: "memory");
            const unsigned og = xb_add(&bar[XB_TOP], 1u);
            const unsigned tg = og / nx;
            if (og + 1u == (tg + 1u) * nx) xb_add(&bar[XB_TOPGEN], 1u);
            else XB_SPIN(xb_ld(&bar[XB_TOPGEN]) == tg, bar);
            __builtin_amdgcn_fence(__ATOMIC_ACQUIRE, "agent");
            xb_add(&bar[XB_XGEN(b.x)], 1u);
            asm volatile("s_waitcnt vmcnt(0)" ::: "memory");
        } else {
            XB_SPIN(xb_ld(&bar[XB_XGEN(b.x)]) == gen, bar);
            __builtin_amdgcn_fence(__ATOMIC_ACQUIRE, "agent");
            asm volatile("s_waitcnt vmcnt(0)" ::: "memory");
        }
    }
    __syncthreads();
}


#ifndef PHMASK
#define PHMASK 0xffff
#endif
#ifndef REP_GEMM
#define REP_GEMM 1
#endif
#ifndef REP_C
#define REP_C 1
#endif
#ifndef REP_E
#define REP_E 1
#endif
#ifndef REP_SYNC
#define REP_SYNC 1
#endif
#ifndef REP_CONV
#define REP_CONV 1
#endif
__global__ void __launch_bounds__(NTHR, 2) fwd_mega(Args a_unused) {
    extern __shared__ __attribute__((aligned(16))) unsigned char lds_raw[];
    LAS unsigned char* lds0 = (LAS unsigned char*)lds_raw;
    cg::grid_group grid = cg::this_grid();
    volatile LAS unsigned* st = (volatile LAS unsigned*)(lds0 + 147456);
    if (threadIdx.x < 4) st[threadIdx.x] = 0u;
    __syncthreads();
    unsigned* barw = (unsigned*)(get_args()->ws + WS_BAR);
    if (blockIdx.x == 0) { for (int i = threadIdx.x; i < XCD_BAR_WORDS; i += NTHR) __hip_atomic_store(barw + i, 0u, __ATOMIC_RELAXED, __HIP_MEMORY_SCOPE_AGENT); }
    grid.sync();
    const XcdBarrier bar = xcd_barrier_post(barw, st);
#pragma nounroll
    for (int step = 0; step < 21; ++step) {
        const int l = step / 10, ph = (step == 20) ? 12 : step % 10;
        LAS unsigned char* lds = lds0; asm volatile("" : "+s"(lds));
        if (ph == 1 || ph == 5 || ph == 7 || ph == 9) {
            if (PHMASK & 4) {
            const ArgsP a = get_args(); unsigned char* ws = a->ws;
            const bf16* A; const bf16* Bt; void* O; int M, N, K, mode;
            if (ph == 1)       { A = (const bf16*)(ws + WS_ACT); Bt = (const bf16*)(ws + WS_WIN); O = ws + WS_Z; M = MPAD; N = NZ + 256; K = DM; mode = 1; }
            else if (ph == 5)  { A = (const bf16*)(ws + WS_ACT); Bt = (const bf16*)(ws + WS_WOUT); O = ws + WS_MIX; M = MPR; N = DM; K = DM; mode = 0; }
            else if (ph == 7)  { A = (const bf16*)(ws + WS_ACT); Bt = (const bf16*)(ws + WS_WUP); O = ws + WS_G; M = MPAD; N = NU; K = DM; mode = 3; }
            else               { A = (const bf16*)(ws + WS_G); Bt = (const bf16*)(ws + WS_WDN); O = ws + WS_FFN; M = MPR; N = DM; K = DFF; mode = 0; }
            pg8::EpiGen E{O, N, mode, ws + WS_UQ, a->in[17] + (size_t)l * 3 * NU, a->in[18] + (size_t)l * NU, (float*)(ws + WS_IG), (float*)(ws + WS_LF), a->in[10] + l * 4, a->in[11] + l * 4};
            pg8::Gemm g{A, Bt, M, N, K}; pg8::StaticOrder S; S.init(M, N, get_nb(), get_bid());
            pg8::gemm_phase<pg8::EpiGen, pg8::StaticOrder, true, true>(lds, g, S, E);
            if (ph == 5 || ph == 9) mini_gemm(lds, A + (size_t)MPR * K, Bt, K, (bf16*)O + (size_t)MPR * DM);
            }
        } else if (ph == 0 || ph == 6 || ph == 12) {
            if (ph == 0 && (PHMASK & 1)) { phase_convert(l, lds); __syncthreads(); }
            if (PHMASK & 2) {
            const ArgsP a = get_args();
            const float* ngl = a->in[8] + (size_t)l * 4 * DM;
            bool first; const bf16* addsrc; const float* gadd; const float* gn; int gl;
            if (ph == 0) { first = (l == 0); addsrc = (l == 0) ? nullptr : (const bf16*)(a->ws + WS_FFN); gadd = ngl - DM; gn = ngl; gl = -1; }
            else if (ph == 6) { first = (l == 0); addsrc = (const bf16*)(a->ws + WS_MIX); gadd = ngl + DM; gn = ngl + 2 * DM; gl = -1; }
            else { first = false; addsrc = (const bf16*)(a->ws + WS_FFN); gadd = a->in[8] + (size_t)7 * DM; gn = nullptr; gl = -1; }
            phase_rows(lds, first, addsrc, gadd, gn, gl, ph == 12);
            }
        } else if (ph == 2) { if (PHMASK & 8) phase_c(l, lds); }
        else if (ph == 3) { if (PHMASK & 16) phase_m2(l, lds); }
        else if (ph == 4) { if (PHMASK & 32) phase_e(l, lds); }
        else { if (PHMASK & 512) phase_fix(l); }
        if (step < 20) xcd_barrier(bar);
    }
}

extern "C" void kernel_launch(void* const* d_in, const int* in_sizes, int n_in, void* d_out, int out_size, void* d_ws, size_t ws_size, hipStream_t stream) {
    static int grid = 0;
    if (grid == 0) {
        if (n_in != 20 || (size_t)out_size != O_END || ws_size < WS_END) { fprintf(stderr, "kernel_launch: unexpected shapes: n_in %d out %d ws %zu\n", n_in, out_size, ws_size); grid = -1; return; }
        int dev = 0, cus = 0, per_cu = 0;
        (void)hipGetDevice(&dev);
        (void)hipDeviceGetAttribute(&cus, hipDeviceAttributeMultiprocessorCount, dev);
        (void)hipFuncSetAttribute((const void*)fwd_mega, hipFuncAttributeMaxDynamicSharedMemorySize, LDS_BYTES);
        (void)hipOccupancyMaxActiveBlocksPerMultiprocessor(&per_cu, (const void*)fwd_mega, NTHR, LDS_BYTES);
        if (per_cu < 1) per_cu = 1;
        grid = cus * per_cu;
    }
    if (grid < 0) return;
    Args a{};
    for (int i = 0; i < 20; ++i) a.in[i] = (const float*)d_in[i];
    a.out = (float*)d_out; a.ws = (unsigned char*)d_ws;
    void* args[] = {&a};
    hipError_t e = hipLaunchCooperativeKernel((const void*)fwd_mega, dim3(grid), dim3(NTHR), args, LDS_BYTES, stream);
    if (e != hipSuccess) fprintf(stderr, "cooperative launch failed: %s (grid %d)\n", hipGetErrorString(e), grid);
}
```

```cpp
#include <hip/hip_runtime.h>
#include <hip/hip_cooperative_groups.h>
#include <cstdio>
#include <cstdint>
#include <cmath>
namespace cg = cooperative_groups;

namespace pg8 {
#define PG8_LAS __attribute__((address_space(3)))
typedef unsigned short bf16_t;
typedef short bf16x8 __attribute__((ext_vector_type(8)));
typedef float f32x4 __attribute__((ext_vector_type(4)));
typedef unsigned u32x4 __attribute__((ext_vector_type(4)));
constexpr int BM = 256, BK = 64, HALF = 128, HTB = HALF * BK * 2  , STAGE_BYTES = 8 * HTB, NXCD = 8, WGM = 8;

__host__ __device__ __forceinline__ int lds_byte(int r, int c) { const int st = (r >> 4) * 2 + (c >> 5), rr = r & 15, cc = c & 31, ob = rr * 64 + cc * 2; return st * 1024 + (ob ^ (((ob >> 9) & 1) << 5)); }
__host__ __device__ __forceinline__ void stage_rc(int b, int& R, int& C) { const int st = b / 1024, sb = b % 1024, swz = sb ^ (((sb >> 9) & 1) << 5); R = (st >> 1) * 16 + swz / 64; C = (st & 1) * 32 + (swz % 64) / 2; }
__host__ __device__ __forceinline__ int perm32(int rho) { const int n = rho >> 4, i = rho & 15; return 8 * (i >> 2) + 4 * n + (i & 3); }

struct Unit { int pm, pn; };
struct Gemm { const bf16_t* A; const bf16_t* Bt; int M, N, K; };

struct StaticOrder {
    int nM, nN, nwg, G, c;
    __host__ __device__ void init(int M, int N, int G_, int c_) { nM = M / BM; nN = N / BM; nwg = nM * nN; G = G_; c = c_; }
    __host__ __device__ bool next(int i, Unit& u) const {
        const long L = (long)i * G + c; if (L >= nwg) return false;
        int wgid = (int)L; { const int q = nwg / NXCD, r = nwg % NXCD, xcd = wgid % NXCD, off = wgid / NXCD; wgid = (xcd < r ? xcd * (q + 1) : r * (q + 1) + (xcd - r) * q) + off; }
        const int nig = WGM * nN, gid = wgid / nig, fm = gid * WGM, gsz = (nM - fm) < WGM ? (nM - fm) : WGM;
        u.pm = fm + ((wgid % nig) % gsz); u.pn = (wgid % nig) / gsz; return true;
    }
    __device__ __forceinline__ void a_ready(const Unit&) const {}
    __device__ __forceinline__ void done(const Unit&) const {}
};

typedef float f32x2e __attribute__((ext_vector_type(2)));
typedef __bf16 bf16x2e __attribute__((ext_vector_type(2)));
__device__ __forceinline__ unsigned cvt_pk_bf16(float lo, float hi) { f32x2e v = {lo, hi}; bf16x2e b = __builtin_convertvector(v, bf16x2e); return __builtin_bit_cast(unsigned, b); }
__device__ __forceinline__ float gelu_t(float x) { const float ee = __builtin_amdgcn_exp2f(x * (2.3022082f + 0.10294324f * x * x)); return x - x * __builtin_amdgcn_rcpf(ee + 1.f); }
__device__ __forceinline__ float dpp_shr1(float v) { return __builtin_bit_cast(float, __builtin_amdgcn_update_dpp(0, __builtin_bit_cast(int, v), 0x111, 0xf, 0xf, true)); }
__device__ __forceinline__ float dpp_shr2(float v) { return __builtin_bit_cast(float, __builtin_amdgcn_update_dpp(0, __builtin_bit_cast(int, v), 0x112, 0xf, 0xf, true)); }
struct EpiGen {
    static constexpr bool PERM = true, AFTER_DRAIN = false;
    void* O; int ldc; int mode;
    void* O2; const float* cw; const float* cb;
    float* IGo; float* LFo; const float* bi; const float* bfg;
    __device__ __forceinline__ void operator()(const f32x4 (&acc)[2][2][4][2], const Unit& u, int wr, int wc, int fr, int fq) const {
        const int row0 = u.pm * BM + wr * 64 + fr; const int col0 = u.pn * BM + wc * 32 + 8 * fq;
        if (mode == 3) {
            const int f0 = u.pn * 128 + wc * 32 + 8 * fq;
#pragma unroll
            for (int n = 0; n < 2; ++n) {
                const int fn = f0 + 4 * n;
                const f32x4 w0g = *(const f32x4*)(cw + fn), w1g = *(const f32x4*)(cw + 5632 + fn), w2g = *(const f32x4*)(cw + 2 * 5632 + fn), bg = *(const f32x4*)(cb + fn);
                const f32x4 w0u = *(const f32x4*)(cw + 2816 + fn), w1u = *(const f32x4*)(cw + 5632 + 2816 + fn), w2u = *(const f32x4*)(cw + 2 * 5632 + 2816 + fn), bu = *(const f32x4*)(cb + 2816 + fn);
#pragma unroll
                for (int ai = 0; ai < 2; ++ai)
#pragma unroll
                    for (int m = 0; m < 4; ++m) { const int row = row0 + ai * HALF + m * 16;
                        float og[4];
#pragma unroll
                        for (int i = 0; i < 4; ++i) { const float ug = acc[ai][0][m][n][i], uu = acc[ai][1][m][n][i];
                            const float yg = bg[i] + dpp_shr2(ug) * w0g[i] + dpp_shr1(ug) * w1g[i] + ug * w2g[i];
                            const float yu = bu[i] + dpp_shr2(uu) * w0u[i] + dpp_shr1(uu) * w1u[i] + uu * w2u[i];
                            og[i] = gelu_t(yg) * yu; }
                        if (fr >= 2) { unsigned w0 = cvt_pk_bf16(og[0], og[1]), w1 = cvt_pk_bf16(og[2], og[3]);
                            unsigned* dst = (unsigned*)((bf16_t*)O + (size_t)row * 2816 + fn); dst[0] = w0; dst[1] = w1; } }
            }
            if (fr < 2 || fr >= 14) {
#pragma unroll
                for (int ai = 0; ai < 2; ++ai)
#pragma unroll
                    for (int m = 0; m < 4; ++m) { const int row = row0 + ai * HALF + m * 16;
                        bf16_t* q = (bf16_t*)O2 + (size_t)((row >> 4) * 4 + (fr < 2 ? fr : fr - 12)) * 5632 + f0;
                        u32x4 wg, wu; const f32x4 g0 = acc[ai][0][m][0], g1 = acc[ai][0][m][1], u0 = acc[ai][1][m][0], u1 = acc[ai][1][m][1];
                        wg.x = cvt_pk_bf16(g0[0], g0[1]); wg.y = cvt_pk_bf16(g0[2], g0[3]); wg.z = cvt_pk_bf16(g1[0], g1[1]); wg.w = cvt_pk_bf16(g1[2], g1[3]);
                        wu.x = cvt_pk_bf16(u0[0], u0[1]); wu.y = cvt_pk_bf16(u0[2], u0[3]); wu.z = cvt_pk_bf16(u1[0], u1[1]); wu.w = cvt_pk_bf16(u1[2], u1[3]);
                        *(u32x4*)q = wg; *(u32x4*)(q + 2816) = wu; }
            }
        } else if (mode == 2) {
#pragma unroll
            for (int ai = 0; ai < 2; ++ai)
#pragma unroll
                for (int m = 0; m < 4; ++m) { float* rowp = (float*)O + (size_t)(row0 + ai * HALF + m * 16) * ldc + col0;
#pragma unroll
                    for (int bj = 0; bj < 2; ++bj) { *(f32x4*)(rowp + bj * HALF) = acc[ai][bj][m][0]; *(f32x4*)(rowp + bj * HALF + 4) = acc[ai][bj][m][1]; } }
        } else if (mode == 1 && u.pn == 14) {
            if (wc == 0 && fq == 0) {
                const f32x4 bi4 = *(const f32x4*)bi, bf4 = *(const f32x4*)bfg;
#pragma unroll
                for (int ai = 0; ai < 2; ++ai)
#pragma unroll
                    for (int m = 0; m < 4; ++m) { const int row = row0 + ai * HALF + m * 16;
                        *(f32x4*)(IGo + (size_t)row * 4) = acc[ai][0][m][0] + bi4;
                        f32x4 x = acc[ai][0][m][1] + bf4, o;
#pragma unroll
                        for (int i = 0; i < 4; ++i) o[i] = fminf(x[i], 0.f) - log1pf(expf(-fabsf(x[i])));
                        *(f32x4*)(LFo + (size_t)row * 4) = o; }
            }
        } else {
            const int ldz = (mode == 1) ? 3584 : ldc;
            float sc = 1.f; if (mode == 1) { sc = (u.pn < 2) ? 0.18033688011112042f   : ((u.pn == 8 || u.pn == 9) ? 0.08838834764831845f : 1.f); }
#pragma unroll
            for (int ai = 0; ai < 2; ++ai)
#pragma unroll
                for (int m = 0; m < 4; ++m) { bf16_t* rowp = (bf16_t*)O + (size_t)(row0 + ai * HALF + m * 16) * ldz + col0;
#pragma unroll
                    for (int bj = 0; bj < 2; ++bj) { f32x4 v0 = acc[ai][bj][m][0] * sc, v1 = acc[ai][bj][m][1] * sc;
                        u32x4 w; w.x = cvt_pk_bf16(v0[0], v0[1]); w.y = cvt_pk_bf16(v0[2], v0[3]); w.z = cvt_pk_bf16(v1[0], v1[1]); w.w = cvt_pk_bf16(v1[2], v1[3]);
                        *(u32x4*)(rowp + bj * HALF) = w; } }
        }
    }
    __device__ __forceinline__ void fused(f32x4 (&acc)[2][2][4][2], const Unit& u, int wr, int wc, int fr, int fq, PG8_LAS unsigned char* lds, int wid, int lane) const {}
};
template <class Epi, class Sched, bool ALIGN_EPI = false, bool SP2 = false>
__device__ __forceinline__ void gemm_phase(PG8_LAS unsigned char* lds, const Gemm g, const Sched& S, const Epi& E) {
    int tid_ = threadIdx.x; asm volatile("" : "+v"(tid_)); const int tid = tid_, wid = __builtin_amdgcn_readfirstlane(tid >> 6), lane = tid & 63, wr = wid >> 2, wc = wid & 3, fr = lane & 15, fq = lane >> 4;
    const int K = g.K, nt = K / BK;
    unsigned voffA[2], voffB[2];
#pragma unroll
    for (int i = 0; i < 2; ++i) { int R, C; stage_rc(tid * 16 + i * 8192, R, C); const int Rb = Epi::PERM ? ((R & ~31) + perm32(R & 31)) : R;
        voffA[i] = (unsigned)(R * K + C) * 2u; voffB[i] = (unsigned)(Rb * K + C) * 2u; }
    const size_t kstep = (size_t)(BK * 2);
    const size_t hstep = (size_t)HALF * K * 2;
    const size_t tstep = 2 * hstep;
    const unsigned ldsw = (unsigned)wid * 1024u;
    const int aoff = lds_byte(wr * 64 + fr, fq * 8), boff = lds_byte(wc * 32 + fr, fq * 8);
#define PG8_SA(b, h) (((b) * 2 + (h)) * HTB)
#define PG8_SB(b, h) ((4 + (b) * 2 + (h)) * HTB)
#define PG8_STAGE(bufoff, gbase, voff) do { _Pragma("unroll") for (int _i = 0; _i < 2; ++_i) \
        __builtin_amdgcn_global_load_lds((const unsigned*)((const char*)(gbase) + (voff)[_i]), (PG8_LAS unsigned*)(lds + (bufoff) + ldsw + _i * 8192), 16, 0, 0); } while (0)
#define PG8_LDA(dst, b, h) do { _Pragma("unroll") for (int m = 0; m < 4; ++m) _Pragma("unroll") for (int k = 0; k < 2; ++k) dst[m][k] = *(const PG8_LAS bf16x8*)(lds + PG8_SA(b, h) + aoff + m * 2048 + k * 1024); } while (0)
#define PG8_LDB(dst, b, h) do { _Pragma("unroll") for (int n = 0; n < 2; ++n) _Pragma("unroll") for (int k = 0; k < 2; ++k) dst[n][k] = *(const PG8_LAS bf16x8*)(lds + PG8_SB(b, h) + boff + n * 2048 + k * 1024); } while (0)
#define PG8_MMA(ai, bj, At, Bt) do { __builtin_amdgcn_s_setprio(1); _Pragma("unroll") for (int m = 0; m < 4; ++m) _Pragma("unroll") for (int n = 0; n < 2; ++n) _Pragma("unroll") for (int k = 0; k < 2; ++k) \
        acc[ai][bj][m][n] = __builtin_amdgcn_mfma_f32_16x16x32_bf16(Bt[n][k], At[m][k], acc[ai][bj][m][n], 0, 0, 0); __builtin_amdgcn_s_setprio(0); } while (0)
#define PG8_WAIT_V(n) asm volatile("s_waitcnt vmcnt(" #n ")" ::: "memory")
#define PG8_WAIT_L(n) asm volatile("s_waitcnt lgkmcnt(" #n ")" ::: "memory")
#define PG8_BAR __builtin_amdgcn_s_barrier()
#define PG8_SCHED __builtin_amdgcn_sched_barrier(0)
    Unit cur, nxt; int ui = 0;
    if (!S.next(0, cur)) return;
    f32x4 acc[2][2][4][2];
#pragma unroll
    for (int a = 0; a < 2; ++a)
#pragma unroll
        for (int b = 0; b < 2; ++b)
#pragma unroll
            for (int m = 0; m < 4; ++m)
#pragma unroll
                for (int n = 0; n < 2; ++n) acc[a][b][m][n] = (f32x4){0.f, 0.f, 0.f, 0.f};
    bf16x8 At[4][2], B0[2][2], B1[2][2];
    const char* cA = (const char*)g.A + (size_t)cur.pm * tstep; const char* cB = (const char*)g.Bt + (size_t)cur.pn * tstep;
    S.a_ready(cur);
    if constexpr (SP2) {
        PG8_STAGE(PG8_SB(0, 0), cB, voffB); PG8_STAGE(PG8_SB(0, 1), cB + hstep, voffB); PG8_STAGE(PG8_SA(0, 0), cA, voffA); PG8_STAGE(PG8_SA(0, 1), cA + hstep, voffA);
        if (wr == 1) PG8_BAR;
        PG8_WAIT_V(2); PG8_BAR;
        PG8_STAGE(PG8_SB(1, 0), cB + kstep, voffB); PG8_STAGE(PG8_SA(1, 0), cA + kstep, voffA); PG8_STAGE(PG8_SB(1, 1), cB + hstep + kstep, voffB);
        PG8_WAIT_V(6); PG8_BAR;
    } else {
        PG8_STAGE(PG8_SB(0, 0), cB, voffB); PG8_STAGE(PG8_SA(0, 0), cA, voffA); PG8_STAGE(PG8_SB(0, 1), cB + hstep, voffB); PG8_STAGE(PG8_SA(0, 1), cA + hstep, voffA);
        if (wr == 1) PG8_BAR;
        PG8_WAIT_V(4); PG8_BAR;
        PG8_STAGE(PG8_SB(1, 0), cB + kstep, voffB); PG8_STAGE(PG8_SA(1, 0), cA + kstep, voffA); PG8_STAGE(PG8_SB(1, 1), cB + hstep + kstep, voffB);
        PG8_WAIT_V(6); PG8_BAR;
    }
    for (;;) {
        const bool has_next = S.next(ui + 1, nxt);
        const char* nA = has_next ? (const char*)g.A + (size_t)nxt.pm * tstep : cA; const char* nB = has_next ? (const char*)g.Bt + (size_t)nxt.pn * tstep : cB;
        for (int t = 0; t < nt; t += 2) {
            const bool last = (t == nt - 2);
            const char* a1 = cA + (size_t)(t + 1) * kstep;
            const char* a2 = last ? nA : cA + (size_t)(t + 2) * kstep; const char* b2 = last ? nB : cB + (size_t)(t + 2) * kstep;
            const char* a3 = a2 + kstep; const char* b3 = b2 + kstep;
            if (last && has_next) S.a_ready(nxt);
            if constexpr (SP2) {
            PG8_LDB(B0, 0, 0); PG8_LDB(B1, 0, 1); PG8_SCHED; PG8_LDA(At, 0, 0); PG8_STAGE(PG8_SA(1, 1), a1 + hstep, voffA);
            PG8_WAIT_V(8); PG8_WAIT_L(0); PG8_BAR; PG8_MMA(0, 0, At, B0); PG8_MMA(0, 1, At, B1); PG8_BAR; PG8_SCHED;
            PG8_LDA(At, 0, 1); PG8_STAGE(PG8_SB(0, 0), b2, voffB); PG8_STAGE(PG8_SB(0, 1), b2 + hstep, voffB); PG8_STAGE(PG8_SA(0, 0), a2, voffA);
            PG8_WAIT_V(8); PG8_WAIT_L(0); PG8_BAR; PG8_MMA(1, 0, At, B0); PG8_MMA(1, 1, At, B1); PG8_BAR; PG8_SCHED;
            PG8_LDB(B0, 1, 0); PG8_LDB(B1, 1, 1); PG8_SCHED; PG8_LDA(At, 1, 0); PG8_STAGE(PG8_SA(0, 1), a2 + hstep, voffA);
            PG8_WAIT_V(8); PG8_WAIT_L(0); PG8_BAR; PG8_MMA(0, 0, At, B0); PG8_MMA(0, 1, At, B1); PG8_BAR; PG8_SCHED;
            PG8_LDA(At, 1, 1); PG8_STAGE(PG8_SB(1, 0), b3, voffB); PG8_STAGE(PG8_SB(1, 1), b3 + hstep, voffB); PG8_STAGE(PG8_SA(1, 0), a3, voffA);
            PG8_WAIT_V(8); PG8_WAIT_L(0); PG8_BAR; PG8_MMA(1, 0, At, B0); PG8_MMA(1, 1, At, B1); PG8_BAR; PG8_SCHED;
            } else {
            PG8_LDB(B0, 0, 0); PG8_SCHED; PG8_LDA(At, 0, 0); PG8_STAGE(PG8_SA(1, 1), a1 + hstep, voffA);
            PG8_WAIT_L(8); PG8_BAR; PG8_WAIT_L(0); PG8_MMA(0, 0, At, B0); PG8_BAR; PG8_SCHED;
            PG8_LDB(B1, 0, 1); PG8_STAGE(PG8_SB(0, 0), b2, voffB);
            PG8_BAR; PG8_WAIT_L(0); PG8_MMA(0, 1, At, B1); PG8_BAR;
            PG8_LDA(At, 0, 1); PG8_STAGE(PG8_SA(0, 0), a2, voffA);
            PG8_BAR; PG8_WAIT_L(0); PG8_MMA(1, 0, At, B0); PG8_BAR; PG8_SCHED;
            PG8_STAGE(PG8_SB(0, 1), b2 + hstep, voffB);
            PG8_WAIT_V(6); PG8_BAR; PG8_MMA(1, 1, At, B1); PG8_BAR;
            PG8_LDB(B0, 1, 0); PG8_SCHED; PG8_LDA(At, 1, 0); PG8_STAGE(PG8_SA(0, 1), a2 + hstep, voffA);
            PG8_WAIT_L(8); PG8_BAR; PG8_WAIT_L(0); PG8_MMA(0, 0, At, B0); PG8_BAR; PG8_SCHED;
            PG8_LDB(B1, 1, 1); PG8_STAGE(PG8_SB(1, 0), b3, voffB);
            PG8_BAR; PG8_WAIT_L(0); PG8_MMA(0, 1, At, B1); PG8_BAR;
            PG8_LDA(At, 1, 1); PG8_STAGE(PG8_SA(1, 0), a3, voffA);
            PG8_BAR; PG8_WAIT_L(0); PG8_MMA(1, 0, At, B0); PG8_BAR; PG8_SCHED;
            PG8_STAGE(PG8_SB(1, 1), b3 + hstep, voffB);
            PG8_WAIT_V(6); PG8_BAR; PG8_MMA(1, 1, At, B1); PG8_BAR;
            }
        }
        if constexpr (ALIGN_EPI) { if (wr == 0) PG8_BAR; }
        if constexpr (!Epi::AFTER_DRAIN) { E(acc, cur, wr, wc, fr, fq); S.done(cur); }
        if (!has_next) break;
#pragma unroll
        for (int a = 0; a < 2; ++a)
#pragma unroll
            for (int b = 0; b < 2; ++b)
#pragma unroll
                for (int m = 0; m < 4; ++m)
#pragma unroll
                    for (int n = 0; n < 2; ++n) acc[a][b][m][n] = (f32x4){0.f, 0.f, 0.f, 0.f};
        cur = nxt; cA = nA; cB = nB; ++ui;
        if constexpr (ALIGN_EPI) { if (wr == 1) PG8_BAR; }
    }
    PG8_WAIT_V(0);
    if constexpr (!ALIGN_EPI) { if (wr == 0) PG8_BAR; }
    PG8_BAR;
    if constexpr (Epi::AFTER_DRAIN) { E.fused(acc, cur, wr, wc, fr, fq, lds, wid, lane); S.done(cur); }
#undef PG8_SA
#undef PG8_SB
#undef PG8_STAGE
#undef PG8_LDA
#undef PG8_LDB
#undef PG8_MMA
#undef PG8_WAIT_V
#undef PG8_WAIT_L
#undef PG8_BAR
#undef PG8_SCHED
}
}
#define LAS __attribute__((address_space(3)))
#define DI __device__ __forceinline__
typedef unsigned short bf16;
typedef float f32x4 __attribute__((ext_vector_type(4)));
typedef float f32x16 __attribute__((ext_vector_type(16)));
typedef float f32x2 __attribute__((ext_vector_type(2)));
typedef unsigned u32x4 __attribute__((ext_vector_type(4)));
typedef unsigned u32x2 __attribute__((ext_vector_type(2)));
typedef short bf16x8 __attribute__((ext_vector_type(8)));
typedef short s16x4 __attribute__((ext_vector_type(4)));
typedef __bf16 bf16x2_t __attribute__((ext_vector_type(2)));

constexpr int NTHR = 512;
constexpr int DM = 1024, MPR = 16384, MVALID = 16512, MPAD = 16640, NZ = 3584, DIN = 3592, DFF = 2816, NU = 5632;
constexpr int SEQ = 8192;
constexpr float EPS = 1e-6f;
constexpr int LDS_BYTES = 147456 + 64;
constexpr size_t MiB = 1u << 20;
constexpr size_t WS_IG = 0, WS_LF = 512 * 1024, WS_BL = 1 * MiB, WS_AC = 1 * MiB + 8192, WS_MPREV = 1 * MiB + 16384, WS_NC = 2 * MiB, WS_NPREV = 3 * MiB;
constexpr size_t WS_BAR = 3 * MiB + 768 * 1024;
constexpr size_t WS_WIN = 4 * MiB, WS_WOUT = 11 * MiB + 512 * 1024, WS_WUP = 13 * MiB + 512 * 1024, WS_WDN = 24 * MiB + 512 * 1024;
constexpr size_t WS_ACT = 30 * MiB;
constexpr size_t WS_KC = 244 * MiB, WS_VC = 248 * MiB;
constexpr size_t WS_X16 = 63 * MiB;
constexpr size_t WS_R = 96 * MiB;
constexpr size_t WS_Z = WS_R, WS_SC = 210 * MiB;
constexpr size_t WS_MIX = WS_R;
constexpr size_t WS_UQ = WS_R, WS_G = 141 * MiB;
constexpr size_t WS_FFN = WS_R;
constexpr size_t WS_END = 256 * MiB;
static_assert(WS_Z + (size_t)MPAD * NZ * 2 <= WS_SC && WS_SC + (size_t)1056 * 32768 <= WS_KC && WS_X16 + (size_t)MVALID * DM * 2 <= WS_R, "ws stage 1");
static_assert(WS_UQ + (size_t)(MPAD / 4) * NU * 2 <= WS_G && WS_G + (size_t)MPAD * DFF * 2 <= WS_KC, "ws stage 3");
static_assert(WS_ACT + (size_t)MPAD * DM * 2 <= WS_X16 && WS_WDN + (size_t)DM * DFF * 2 <= WS_ACT, "ws fixed");
constexpr size_t O_X = 0, O_KP = 16908288, O_VP = O_KP + 1048576, O_CP = O_VP + 1048576, O_NP = O_CP + 262144, O_MP = O_NP + 2048, O_FP = O_MP + 16,
                 O_KS = O_FP + 45056, O_VS = O_KS + 131072, O_CS = O_VS + 131072, O_NS = O_CS + 1048576, O_MS = O_NS + 8192, O_FS = O_MS + 64, O_END = O_FS + 180224;

DI unsigned pk2(float lo, float hi) { f32x2 v = {lo, hi}; bf16x2_t b = __builtin_convertvector(v, bf16x2_t); return __builtin_bit_cast(unsigned, b); }
DI float bf2f(unsigned short b) { return __uint_as_float((unsigned)b << 16); }
DI float bflo(unsigned w) { return __uint_as_float(w << 16); }
DI float bfhi(unsigned w) { return __uint_as_float(w & 0xffff0000u); }
DI float wave_sum(float v) {
#pragma unroll
    for (int o = 1; o < 64; o <<= 1) v += __shfl_xor(v, o);
    return v;
}
DI float wave_max(float v) {
#pragma unroll
    for (int o = 1; o < 64; o <<= 1) v = fmaxf(v, __shfl_xor(v, o));
    return v;
}
#define MFMA32(a, b, c) __builtin_amdgcn_mfma_f32_32x32x16_bf16((a), (b), (c), 0, 0, 0)
DI s16x4 vtr(const LAS char* p) { return __builtin_bit_cast(s16x4, __builtin_amdgcn_ds_read_tr16_b64_v4i16((LAS s16x4*)p)); }
DI bf16x8 vtr2(const LAS char* p, int rows4_bytes) { s16x4 lo = vtr(p), hi = vtr(p + rows4_bytes); return __builtin_shufflevector(lo, hi, 0, 1, 2, 3, 4, 5, 6, 7); }
DI int crow(int i, int h) { return (i & 3) + 8 * (i >> 2) + 4 * h; }
DI bf16x8 pack8(const f32x16& x, int s) {
    u32x4 p; p.x = pk2(x[8 * s], x[8 * s + 1]); p.y = pk2(x[8 * s + 2], x[8 * s + 3]); p.z = pk2(x[8 * s + 4], x[8 * s + 5]); p.w = pk2(x[8 * s + 6], x[8 * s + 7]);
    return __builtin_bit_cast(bf16x8, p);
}
DI f32x16 zero16() { f32x16 z;
#pragma unroll
    for (int i = 0; i < 16; ++i) z[i] = 0.f; return z; }
#define LDS_FENCE() asm volatile("s_waitcnt lgkmcnt(0)" ::: "memory")

struct Args { const float* in[20]; float* out; unsigned char* ws; };
typedef const __attribute__((address_space(4))) Args* ArgsP;
DI ArgsP get_args() { ArgsP p = (ArgsP)__builtin_amdgcn_kernarg_segment_ptr(); asm volatile("" : "+s"(p)); return p; }
DI int get_bid() { int b = blockIdx.x; asm volatile("" : "+s"(b)); return b; }
DI int get_nb() { int b = gridDim.x; asm volatile("" : "+s"(b)); return b; }
DI int get_tid() { int t = threadIdx.x; asm volatile("" : "+v"(t)); return t; }

DI void transpose_item(const float* W, int ldw, int K, int nblk, bf16* WT, LAS float* scr, int item, int lane, bool perm_up = false, int cmax = (1 << 30)) {
    const int kb = item / nblk, nb = item % nblk, k0 = 64 * kb, n0 = 32 * nb;
    const int r0 = !perm_up ? n0 : (n0 < DFF ? 256 * (n0 >> 7) + (n0 & 127) : 256 * ((n0 - DFF) >> 7) + 128 + ((n0 - DFF) & 127));
    { int col0 = n0 + (lane & 7) * 4; col0 = col0 + 3 <= cmax ? col0 : cmax - 3;
      f32x4 v[8];
#pragma unroll
      for (int i = 0; i < 8; ++i) v[i] = __builtin_nontemporal_load((const f32x4*)(W + (size_t)(k0 + 8 * i + (lane >> 3)) * ldw + col0));
#pragma unroll
      for (int i = 0; i < 8; ++i) { const int kk = 8 * i + (lane >> 3); LAS float* d = scr + kk * 33 + (lane & 7) * 4; d[0] = v[i].x; d[1] = v[i].y; d[2] = v[i].z; d[3] = v[i].w; } }
    LDS_FENCE();
    const int c = lane & 7;
#pragma unroll
    for (int j = 0; j < 4; ++j) { const int n = (lane >> 3) + 8 * j; const LAS float* s = scr + (8 * c) * 33 + n;
        u32x4 o; o.x = pk2(s[0 * 33], s[1 * 33]); o.y = pk2(s[2 * 33], s[3 * 33]); o.z = pk2(s[4 * 33], s[5 * 33]); o.w = pk2(s[6 * 33], s[7 * 33]);
        *(u32x4*)(WT + (size_t)(r0 + n) * K + k0 + 8 * c) = o; }
    LDS_FENCE();
}
DI void phase_convert(int l, LAS unsigned char* lds) {
    const ArgsP a = get_args(); const int tid = get_tid(), lane = tid & 63, wave = tid >> 6;
    LAS float* scr = (LAS float*)(lds + wave * 8448);
    const int gw = get_bid() * 8 + wave, NGW = get_nb() * 8;
    constexpr int I_IN = 16 * 113, I_OUT = 16 * 32, I_UP = 16 * 176, I_DN = 44 * 32;
    const float* win = a->in[9] + (size_t)l * DM * DIN; const float* wout = a->in[15] + (size_t)l * DM * DM;
    const float* wup = a->in[16] + (size_t)l * DM * NU; const float* wdn = a->in[19] + (size_t)l * DFF * DM;
    for (int it = gw; it < I_IN + I_OUT + I_UP + I_DN; it += NGW) {
        int r = it;
        if (r < I_IN) { transpose_item(win, DIN, DM, 113, (bf16*)(a->ws + WS_WIN), scr, r, lane, false, DIN - 1); continue; } r -= I_IN;
        if (r < I_OUT) { transpose_item(wout, DM, DM, 32, (bf16*)(a->ws + WS_WOUT), scr, r, lane); continue; } r -= I_OUT;
        if (r < I_UP) { transpose_item(wup, NU, DM, 176, (bf16*)(a->ws + WS_WUP), scr, r, lane, true); continue; } r -= I_UP;
        transpose_item(wdn, DM, DFF, 32, (bf16*)(a->ws + WS_WDN), scr, r, lane);
    }
    {   const int gt0 = get_bid() * NTHR + tid, gstep = get_nb() * NTHR;
        for (int it0 = gt0; it0 < 2 * 262144; it0 += 4 * gstep) {
            f32x4 x0[4], x1[4];
#pragma unroll
            for (int k = 0; k < 4; ++k) { const int it = it0 + k * gstep; if (it < 2 * 262144) { const int kv = it >> 18, e = (it & 262143) * 8; const float* src = a->in[2 + kv] + (size_t)l * 2097152 + e; x0[k] = __builtin_nontemporal_load((const f32x4*)src); x1[k] = __builtin_nontemporal_load((const f32x4*)(src + 4)); } }
#pragma unroll
            for (int k = 0; k < 4; ++k) { const int it = it0 + k * gstep; if (it < 2 * 262144) { const int kv = it >> 18, e = (it & 262143) * 8;
                u32x4 w; w.x = pk2(x0[k].x, x0[k].y); w.y = pk2(x0[k].z, x0[k].w); w.z = pk2(x1[k].x, x1[k].y); w.w = pk2(x1[k].z, x1[k].w);
                *(u32x4*)((bf16*)(a->ws + (kv ? WS_VC : WS_KC)) + e) = w; } }
        } }
}

DI void phase_rows(LAS unsigned char* lds, bool first, const bf16* addsrc, const float* gadd, const float* gn, int gate_layer  , bool final) {
    const ArgsP a = get_args(); const int tid = get_tid(), lane = tid & 63, wave = tid >> 6;
    float* Y = a->out; bf16* X16 = (bf16*)(a->ws + WS_X16); bf16* ACT = (bf16*)(a->ws + WS_ACT);
    const int gw = get_bid() * 8 + wave, NGW = get_nb() * 8;
    float ga[16], gb[16];
#pragma unroll
    for (int j = 0; j < 2; ++j)
#pragma unroll
        for (int k = 0; k < 8; ++k) { ga[8 * j + k] = addsrc ? gadd[8 * lane + 512 * j + k] : 0.f; gb[8 * j + k] = gn ? gn[8 * lane + 512 * j + k] : 0.f; }
#define ROWS_LOAD(MM, VV, XX, FF) do { const int mm_ = (MM); \
        if (first) { const float* xr_ = mm_ < MPR ? a->in[0] + (size_t)mm_ * DM : a->in[1] + (size_t)(mm_ - MPR) * DM; \
            _Pragma("unroll") for (int j = 0; j < 2; ++j) { VV[2 * j] = __builtin_nontemporal_load((const f32x4*)(xr_ + 8 * lane + 512 * j)); VV[2 * j + 1] = __builtin_nontemporal_load((const f32x4*)(xr_ + 8 * lane + 512 * j + 4)); } } \
        else { _Pragma("unroll") for (int j = 0; j < 2; ++j) XX[j] = *(const u32x4*)(X16 + (size_t)mm_ * DM + 8 * lane + 512 * j); } \
        if (addsrc) { _Pragma("unroll") for (int j = 0; j < 2; ++j) FF[j] = *(const u32x4*)(addsrc + (size_t)mm_ * DM + 8 * lane + 512 * j); } } while (0)
    f32x4 vn[4], vn2[4]; u32x4 xn[2], fn[2], xn2[2], fn2[2];
#pragma unroll
    for (int j = 0; j < 4; ++j) { vn[j] = (f32x4){0.f, 0.f, 0.f, 0.f}; vn2[j] = vn[j]; }
#pragma unroll
    for (int j = 0; j < 2; ++j) { xn[j] = (u32x4){0u, 0u, 0u, 0u}; fn[j] = xn[j]; xn2[j] = xn[j]; fn2[j] = xn[j]; }
    if (gw < MVALID) ROWS_LOAD(gw, vn, xn, fn);
    if (gw + NGW < MVALID) ROWS_LOAD(gw + NGW, vn2, xn2, fn2);
    for (int m = gw; m < MVALID; m += NGW) {
        float v[16], f[16];
#pragma unroll
        for (int j = 0; j < 2; ++j) {
            if (first) {
#pragma unroll
                for (int k = 0; k < 4; ++k) { v[8 * j + k] = vn[2 * j][k]; v[8 * j + 4 + k] = vn[2 * j + 1][k]; }
            } else { v[8 * j] = bflo(xn[j].x); v[8 * j + 1] = bfhi(xn[j].x); v[8 * j + 2] = bflo(xn[j].y); v[8 * j + 3] = bfhi(xn[j].y); v[8 * j + 4] = bflo(xn[j].z); v[8 * j + 5] = bfhi(xn[j].z); v[8 * j + 6] = bflo(xn[j].w); v[8 * j + 7] = bfhi(xn[j].w); }
            f[8 * j] = bflo(fn[j].x); f[8 * j + 1] = bfhi(fn[j].x); f[8 * j + 2] = bflo(fn[j].y); f[8 * j + 3] = bfhi(fn[j].y); f[8 * j + 4] = bflo(fn[j].z); f[8 * j + 5] = bfhi(fn[j].z); f[8 * j + 6] = bflo(fn[j].w); f[8 * j + 7] = bfhi(fn[j].w);
        }
#pragma unroll
        for (int j = 0; j < 4; ++j) vn[j] = vn2[j];
#pragma unroll
        for (int j = 0; j < 2; ++j) { xn[j] = xn2[j]; fn[j] = fn2[j]; }
        if (m + 2 * NGW < MVALID) ROWS_LOAD(m + 2 * NGW, vn2, xn2, fn2);
        if (addsrc) {
            float s = 0.f;
#pragma unroll
            for (int k = 0; k < 16; ++k) s += f[k] * f[k];
            const float r = 1.0f / sqrtf(wave_sum(s) * (1.f / DM) + EPS);
#pragma unroll
            for (int k = 0; k < 16; ++k) v[k] = v[k] + f[k] * r * ga[k];
#pragma unroll
            for (int j = 0; j < 2; ++j) {
                if (final) { float* yp = Y + (size_t)m * DM + 8 * lane + 512 * j; __builtin_nontemporal_store((f32x4){v[8 * j], v[8 * j + 1], v[8 * j + 2], v[8 * j + 3]}, (f32x4*)yp); __builtin_nontemporal_store((f32x4){v[8 * j + 4], v[8 * j + 5], v[8 * j + 6], v[8 * j + 7]}, (f32x4*)(yp + 4)); }
                else { u32x4 o; o.x = pk2(v[8 * j], v[8 * j + 1]); o.y = pk2(v[8 * j + 2], v[8 * j + 3]); o.z = pk2(v[8 * j + 4], v[8 * j + 5]); o.w = pk2(v[8 * j + 6], v[8 * j + 7]); *(u32x4*)(X16 + (size_t)m * DM + 8 * lane + 512 * j) = o; } }
        }
        if (first && !addsrc) {
#pragma unroll
            for (int j = 0; j < 2; ++j) { u32x4 o; o.x = pk2(v[8 * j], v[8 * j + 1]); o.y = pk2(v[8 * j + 2], v[8 * j + 3]); o.z = pk2(v[8 * j + 4], v[8 * j + 5]); o.w = pk2(v[8 * j + 6], v[8 * j + 7]); *(u32x4*)(X16 + (size_t)m * DM + 8 * lane + 512 * j) = o; }
        }
        if (gn) {
            float s = 0.f;
#pragma unroll
            for (int k = 0; k < 16; ++k) s += v[k] * v[k];
            const float r = 1.0f / sqrtf(wave_sum(s) * (1.f / DM) + EPS);
#pragma unroll
            for (int j = 0; j < 2; ++j) { u32x4 o;
                o.x = pk2(v[8 * j] * r * gb[8 * j], v[8 * j + 1] * r * gb[8 * j + 1]); o.y = pk2(v[8 * j + 2] * r * gb[8 * j + 2], v[8 * j + 3] * r * gb[8 * j + 3]);
                o.z = pk2(v[8 * j + 4] * r * gb[8 * j + 4], v[8 * j + 5] * r * gb[8 * j + 5]); o.w = pk2(v[8 * j + 6] * r * gb[8 * j + 6], v[8 * j + 7] * r * gb[8 * j + 7]);
                *(u32x4*)(ACT + (size_t)m * DM + 8 * lane + 512 * j) = o; }
        }
    }
#undef ROWS_LOAD
}

DI void mini_gemm(LAS unsigned char* lds, const bf16* A, const bf16* Bt, int K, bf16* O) {
    const int tid = get_tid(), lane = tid & 63, wave = tid >> 6, fr = lane & 15, fq = lane >> 4;
    LAS float* red = (LAS float*)lds;
    const int ksl = K >> 3, k0 = wave * ksl, nks = ksl >> 5;
    for (int unit = get_bid(); unit < 256; unit += get_nb()) {
        const int rt = unit >> 5, ct = unit & 31;
        const bf16* ap = A + (size_t)(rt * 16 + fr) * K + k0 + 8 * fq;
        const bf16* bp0 = Bt + (size_t)(ct * 32 + fr) * K + k0 + 8 * fq; const bf16* bp1 = bp0 + (size_t)16 * K;
        f32x4 acc0 = {0.f, 0.f, 0.f, 0.f}, acc1 = {0.f, 0.f, 0.f, 0.f};
#pragma unroll 4
        for (int ks = 0; ks < nks; ++ks) { const bf16x8 av = *(const bf16x8*)(ap + 32 * ks), b0 = *(const bf16x8*)(bp0 + 32 * ks), b1 = *(const bf16x8*)(bp1 + 32 * ks);
            acc0 = __builtin_amdgcn_mfma_f32_16x16x32_bf16(av, b0, acc0, 0, 0, 0); acc1 = __builtin_amdgcn_mfma_f32_16x16x32_bf16(av, b1, acc1, 0, 0, 0); }
#pragma unroll
        for (int j = 0; j < 4; ++j) { red[(wave * 2 + 0) * 256 + j * 64 + lane] = acc0[j]; red[(wave * 2 + 1) * 256 + j * 64 + lane] = acc1[j]; }
        __syncthreads();
        { const int n = tid >> 8, idx = tid & 255, j = idx >> 6, ln = idx & 63; float s = 0.f;
#pragma unroll
          for (int w = 0; w < 8; ++w) s += red[(w * 2 + n) * 256 + idx];
          O[(size_t)(rt * 16 + 4 * (ln >> 4) + j) * DM + ct * 32 + 16 * n + (ln & 15)] = (bf16)(pk2(s, 0.f) & 0xffffu); }
        __syncthreads();
    }
}

constexpr int VP = 144;
DI void attn_step(const bf16x8 (&kf)[4], const bf16x8 (&qf)[4], f32x16 (&O)[2], float& mrun, float& lrun, const LAS float* tab, float bias_far, bool nearb, int dq  , int maskfrom  ,
                  const LAS char* vs, int kb, int h, int q4, int p4, int blk) {
    bf16x8 vf0[2], vf1[2];
#pragma unroll
    for (int dt = 0; dt < 2; ++dt) {
        vf0[dt] = vtr2(vs + (kb + 4 * h + q4) * VP + 2 * (32 * dt + 16 * blk) + 8 * p4, 8 * VP);
        vf1[dt] = vtr2(vs + (kb + 16 + 4 * h + q4) * VP + 2 * (32 * dt + 16 * blk) + 8 * p4, 8 * VP); }
    f32x16 S = zero16();
#pragma unroll
    for (int s = 0; s < 4; ++s) S = MFMA32(kf[s], qf[s], S);
    if (nearb) {
#pragma unroll
        for (int i = 0; i < 16; ++i) { int d = dq - ((i & 3) + 8 * (i >> 2)); d = d > 256 ? 256 : d; S[i] += tab[d + 63]; }
    } else {
#pragma unroll
        for (int i = 0; i < 16; ++i) S[i] += bias_far;
    }
    if (maskfrom < 64) {
#pragma unroll
        for (int i = 0; i < 16; ++i) if ((i & 3) + 8 * (i >> 2) + 4 * h >= maskfrom) S[i] = -1e30f;
    }
    float mx = S[0];
#pragma unroll
    for (int i = 1; i < 16; ++i) mx = fmaxf(mx, S[i]);
    mx = fmaxf(mx, __shfl_xor(mx, 32));
    const float mnew = fmaxf(mrun, mx), alpha = __builtin_amdgcn_exp2f(mrun - mnew);
    float rs = 0.f;
#pragma unroll
    for (int i = 0; i < 16; ++i) { S[i] = __builtin_amdgcn_exp2f(S[i] - mnew); rs += S[i]; }
    lrun = lrun * alpha + rs;
    if (__builtin_amdgcn_ballot_w64(mnew > mrun)) { O[0] *= alpha; O[1] *= alpha; }
    mrun = mnew;
    const bf16x8 pf0 = pack8(S, 0), pf1 = pack8(S, 1);
#pragma unroll
    for (int dt = 0; dt < 2; ++dt) { O[dt] = MFMA32(vf0[dt], pf0, O[dt]); O[dt] = MFMA32(vf1[dt], pf1, O[dt]); }
}
template <bool SAMPLE>
DI void attn_unit(int l, int bb, int c, int qhalf, LAS unsigned char* lds) {
    const ArgsP a = get_args(); const int tid = get_tid(), lane = tid & 63, hd = tid >> 6, r = lane & 31, h = lane >> 5;
    const int i16 = lane & 15, q4 = i16 >> 2, p4 = i16 & 3, blk = (lane >> 4) & 1;
    const bf16* Z = (const bf16*)(a->ws + WS_Z); bf16* ACT = (bf16*)(a->ws + WS_ACT);
    LAS char* vs = (LAS char*)(lds + hd * 9216);
    const LAS float* tab = (const LAS float*)(lds + 73728 + hd * 1280);
    LAS float* xs = (LAS float*)(lds + 73728 + 10240);
    const int qrow0 = SAMPLE ? MPR + bb * 16 : bb * SEQ + c * 64;
    const bf16* kc16 = (const bf16*)(a->ws + WS_KC) + (size_t)(bb * 8 + hd) * 512 * 64;
    const bf16* vc16 = (const bf16*)(a->ws + WS_VC) + (size_t)(bb * 8 + hd) * 512 * 64;
    bf16x8 qf[4];
    { const int qr = SAMPLE ? (r < 16 ? r : 15) : 32 * qhalf + r;
#pragma unroll
      for (int s = 0; s < 4; ++s) qf[s] = *(const bf16x8*)(Z + (size_t)(qrow0 + qr) * NZ + hd * 64 + 16 * s + 8 * h); }
    f32x16 O[2]; O[0] = zero16(); O[1] = zero16(); float mrun = -1e30f, lrun = 0.f;
    const float bias_far = tab[319];
    const int q = 32 * qhalf + r;
    const int jstart = SAMPLE ? 0 : (c >= 8 ? 0 : 8 - c);
#define ATT_SRC(J) const bf16* kb_; const bf16* vb_; int pitch_, rmax_; \
    if (SAMPLE && (J) < 8) { kb_ = kc16 + (size_t)(64 * (J)) * 64; vb_ = vc16 + (size_t)(64 * (J)) * 64; pitch_ = 64; rmax_ = 63; } \
    else if (SAMPLE) { kb_ = Z + (size_t)qrow0 * NZ + 512 + hd * 64; vb_ = kb_ + 512; pitch_ = NZ; rmax_ = 15; } \
    else { kb_ = Z + (size_t)(bb * SEQ + (c + (J) - 8) * 64) * NZ + 512 + hd * 64; vb_ = kb_ + 512; pitch_ = NZ; rmax_ = 63; }
#define ATT_LOADK(J, KS, KF) do { ATT_SRC(J) int kr_ = 32 * (KS) + r; kr_ = kr_ > rmax_ ? rmax_ : kr_; (void)vb_; \
    _Pragma("unroll") for (int s = 0; s < 4; ++s) KF[s] = *(const bf16x8*)(kb_ + (size_t)kr_ * pitch_ + 16 * s + 8 * h); } while (0)
#define ATT_LOADV(J, VR) do { ATT_SRC(J) (void)kb_; \
    _Pragma("unroll") for (int it = 0; it < 8; ++it) { int key_ = it * 8 + (lane >> 3); key_ = key_ > rmax_ ? rmax_ : key_; VR[it] = *(const u32x4*)(vb_ + (size_t)key_ * pitch_ + (lane & 7) * 8); } } while (0)
    bf16x8 kA[4], kB[4]; u32x4 vr[8];
    ATT_LOADK(jstart, 0, kA);
    ATT_LOADV(jstart, vr);
#pragma unroll 1
    for (int j = jstart; j < 9; ++j) {
        LDS_FENCE();
#pragma unroll
        for (int it = 0; it < 8; ++it) *(LAS u32x4*)(vs + (it * 8 + (lane >> 3)) * VP + (lane & 7) * 16) = vr[it];
        if (j < 8) ATT_LOADV(j + 1, vr);
        ATT_LOADK(j, 1, kB);
        LDS_FENCE();
        const bool nearb = j >= 4; const int mf = (SAMPLE && j == 8) ? 16 : 64;
        attn_step(kA, qf, O, mrun, lrun, tab, bias_far, nearb, 512 + q - (64 * j + 4 * h), mf, vs, 0, h, q4, p4, blk);
        if (j < 8) ATT_LOADK(j + 1, 0, kA);
        if (!(SAMPLE && j == 8)) attn_step(kB, qf, O, mrun, lrun, tab, bias_far, nearb, 512 + q - (64 * j + 32 + 4 * h), 64, vs, 32, h, q4, p4, blk);
    }
#undef ATT_SRC
#undef ATT_LOADK
#undef ATT_LOADV
    const float lt = lrun + __shfl_xor(lrun, 32); const float inv = 1.0f / lt; float ssq = 0.f;
#pragma unroll
    for (int dt = 0; dt < 2; ++dt) { O[dt] *= inv;
#pragma unroll
        for (int i = 0; i < 16; ++i) ssq += O[dt][i] * O[dt][i]; }
    ssq += __shfl_xor(ssq, 32);
    if (h == 0) xs[hd * 64 + 32 * qhalf + r] = ssq;
    __syncthreads();
    const float* gatt = a->in[13] + l * 512 + hd * 64;
    float tot = 0.f;
#pragma unroll
    for (int w = 0; w < 8; ++w) tot += xs[w * 64 + 32 * qhalf + r];
    const float rr = 1.0f / sqrtf(tot * (1.f / 512.f) + EPS);
    const bool ok = SAMPLE ? (r < 16) : true;
    bf16* orow = ACT + (size_t)(qrow0 + 32 * qhalf + r) * DM + hd * 64;
    if (ok) {
#pragma unroll
        for (int dt = 0; dt < 2; ++dt)
#pragma unroll
            for (int g = 0; g < 4; ++g) { const int e0 = 32 * dt + 8 * g + 4 * h; const f32x4 gv = *(const f32x4*)(gatt + e0);
                u32x2 o; o.x = pk2(O[dt][4 * g] * rr * gv.x, O[dt][4 * g + 1] * rr * gv.y); o.y = pk2(O[dt][4 * g + 2] * rr * gv.z, O[dt][4 * g + 3] * rr * gv.w);
                *(u32x2*)(orow + e0) = o; }
    }
    __syncthreads();
}

constexpr int MPB = 288;
DI void m1_item(bool sample, int bb, int c, LAS unsigned char* lds, int hp = -1  ) {
    const ArgsP a = get_args(); const int tid = get_tid(), lane = tid & 63, wave = tid >> 6, head = wave >> 1, half = wave & 1, r = lane & 31, h = lane >> 5;
    const int i16 = lane & 15, q4 = i16 >> 2, p4 = i16 & 3, blk = (lane >> 4) & 1;
    const bf16* Z = (const bf16*)(a->ws + WS_Z); const float* IG = (const float*)(a->ws + WS_IG); const float* LF = (const float*)(a->ws + WS_LF);
    bf16* SC = (bf16*)(a->ws + WS_SC);
    const int row0 = sample ? MPR + bb * 16 : bb * SEQ + c * 64;
    const int u = sample ? 1024 + bb * 4 + head : (bb * 4 + head) * 128 + c;
    const bool act = (hp < 0) || ((head >> 1) == hp);
    u32x4 st16[16];
#pragma unroll
    for (int it = 0; it < 16; ++it) { const int rr = it * 4 + (lane >> 4), ch = lane & 15; const int srow = row0 + (sample ? (rr < 16 ? rr : 15) : rr);
        st16[it] = *(const u32x4*)(Z + (size_t)srow * NZ + (half == 0 ? 2048 : 2560) + head * 128 + ch * 8); }
    const bool valid = sample ? (lane < 16) : true;
    const int rs = row0 + (sample ? (lane < 16 ? lane : 15) : lane);
    float b = valid ? LF[(size_t)rs * 4 + head] : 0.f; const float ig = valid ? IG[(size_t)rs * 4 + head] : -INFINITY;
#pragma unroll
    for (int o = 1; o < 64; o <<= 1) { const float t = __shfl_up(b, o); if (lane >= o) b += t; }
    const float av = ig - b; const float ac = wave_max(av); const float w = __expf(av - ac); const float bl = __shfl(b, 63);
    if (act && half == 0 && lane == 0) { ((float*)(a->ws + WS_BL))[u] = bl; ((float*)(a->ws + WS_AC))[u] = ac; }
    LAS char* kbase = (LAS char*)(lds + head * 36864); LAS char* vbase = kbase + 18432;
#pragma unroll
    for (int it = 0; it < 16; ++it) { const int rr = it * 4 + (lane >> 4), ch = lane & 15;
        const float wr = __shfl(w, rr); const u32x4 x = st16[it];
        if (half == 0) { u32x4 o;
            o.x = pk2(bflo(x.x) * wr, bfhi(x.x) * wr); o.y = pk2(bflo(x.y) * wr, bfhi(x.y) * wr); o.z = pk2(bflo(x.z) * wr, bfhi(x.z) * wr); o.w = pk2(bflo(x.w) * wr, bfhi(x.w) * wr);
            *(LAS u32x4*)(kbase + rr * MPB + ch * 16) = o; }
        else *(LAS u32x4*)(vbase + rr * MPB + ch * 16) = x;
    }
    __syncthreads();
    if (act) {
#pragma unroll
    for (int dh = 0; dh < 2; ++dh) {
        f32x16 acc[2][2];
#pragma unroll
        for (int di = 0; di < 2; ++di) { acc[di][0] = zero16(); acc[di][1] = zero16(); }
#pragma unroll
        for (int ks = 0; ks < 4; ++ks) {
            bf16x8 af[2], bfr[2];
#pragma unroll
            for (int di = 0; di < 2; ++di) af[di] = vtr2(kbase + (16 * ks + 8 * h + q4) * MPB + 2 * (32 * (2 * dh + di) + 16 * blk) + 8 * p4, 4 * MPB);
#pragma unroll
            for (int ei = 0; ei < 2; ++ei) bfr[ei] = vtr2(vbase + (16 * ks + 8 * h + q4) * MPB + 2 * (32 * (2 * half + ei) + 16 * blk) + 8 * p4, 4 * MPB);
#pragma unroll
            for (int di = 0; di < 2; ++di)
#pragma unroll
                for (int ei = 0; ei < 2; ++ei) acc[di][ei] = MFMA32(af[di], bfr[ei], acc[di][ei]);
        }
#pragma unroll
        for (int di = 0; di < 2; ++di)
#pragma unroll
            for (int ei = 0; ei < 2; ++ei)
#pragma unroll
                for (int g = 0; g < 4; ++g) { const int e = 32 * (2 * half + ei) + r, d0 = 32 * (2 * dh + di) + 8 * g + 4 * h;
                    u32x2 o; o.x = pk2(acc[di][ei][4 * g], acc[di][ei][4 * g + 1]); o.y = pk2(acc[di][ei][4 * g + 2], acc[di][ei][4 * g + 3]);
                    *(u32x2*)(SC + (size_t)u * 16384 + e * 128 + d0) = o; }
    }
    { const int d = half * 64 + lane; float s = 0.f;
#pragma unroll 8
      for (int sidx = 0; sidx < 64; ++sidx) s += bf2f(*(const LAS unsigned short*)(kbase + sidx * MPB + d * 2));
      ((float*)(a->ws + WS_NC))[(size_t)u * 128 + d] = s; }
    }
    __syncthreads();
}

DI void phase_c_pre(int l) {
    const ArgsP a = get_args(); const int tid = get_tid();
    const bf16* Z = (const bf16*)(a->ws + WS_Z);
    for (int it = get_bid() * NTHR + tid; it < 147456; it += get_nb() * NTHR) {
        int row, kv, cc; float* dst;
        if (it < 131072) { const int b = it >> 16, t = (it >> 7) & 511; kv = (it >> 6) & 1; cc = it & 63; row = b * SEQ + (SEQ - 512) + t;
            dst = a->out + (kv ? O_VP : O_KP) + ((size_t)((l * 2 + b) * 8 + (cc >> 3)) * 512 + t) * 64 + (cc & 7) * 8; }
        else { const int i2 = it - 131072; const int rr = i2 >> 7; kv = (i2 >> 6) & 1; cc = i2 & 63; row = MPR + rr; const int sb = rr >> 4, t = rr & 15;
            dst = a->out + (kv ? O_VS : O_KS) + ((size_t)((l * 8 + sb) * 8 + (cc >> 3)) * 16 + t) * 64 + (cc & 7) * 8; }
        const u32x4 x = *(const u32x4*)(Z + (size_t)row * NZ + 512 + kv * 512 + cc * 8);
        f32x4 o0 = {bflo(x.x), bfhi(x.x), bflo(x.y), bfhi(x.y)}, o1 = {bflo(x.z), bfhi(x.z), bflo(x.w), bfhi(x.w)};
        __builtin_nontemporal_store(o0, (f32x4*)dst); __builtin_nontemporal_store(o1, (f32x4*)(dst + 4));
    }
}

DI void phase_m2(int l, LAS unsigned char* lds) {
    const ArgsP a = get_args(); const int tid = get_tid(), lane = tid & 63;
    bf16* SC = (bf16*)(a->ws + WS_SC); const float* BL = (const float*)(a->ws + WS_BL); const float* AC = (const float*)(a->ws + WS_AC);
    float* MPREV = (float*)(a->ws + WS_MPREV); const float* NC = (const float*)(a->ws + WS_NC); float* NPREV = (float*)(a->ws + WS_NPREV);
    LAS float* DEC = (LAS float*)lds; LAS float* SCL = DEC + 128;
    const int NTH = get_nb() * NTHR;
    for (int base = get_bid() * NTHR; base < 8 * 16384; base += NTH) {
        const int bh = base >> 14, el = (base & 16383) + tid; const bool doN = el < 128;
        __syncthreads();
        if (tid < 64) {
            float Fc = 0.f, gc = 0.f;
#pragma unroll
            for (int rd = 0; rd < 2; ++rd) {
                const int c = rd * 64 + lane, u = bh * 128 + c; const float bl = BL[u], ac = AC[u];
                float F = bl;
#pragma unroll
                for (int o = 1; o < 64; o <<= 1) { const float t = __shfl_up(F, o); if (lane >= o) F += t; }
                F += Fc;
                float Fm1 = __shfl_up(F, 1); if (lane == 0) Fm1 = Fc;
                float g = ac - Fm1;
#pragma unroll
                for (int o = 1; o < 64; o <<= 1) { const float t = __shfl_up(g, o); if (lane >= o) g = fmaxf(g, t); }
                g = fmaxf(g, gc);
                float gm1 = __shfl_up(g, 1); if (lane == 0) gm1 = gc;
                const float mprev = Fm1 + gm1, mnew = F + g;
                DEC[c] = expf(bl + mprev - mnew); SCL[c] = expf(bl + ac - mnew);
                if ((base & 16383) == 0) { MPREV[u] = mprev; if (c == 127) a->out[O_MP + l * 8 + bh] = mnew; }
                Fc = __shfl(F, 63); gc = __shfl(g, 63);
            }
        }
        __syncthreads();
        float C = 0.f, n = 0.f;
#pragma unroll 1
        for (int c0 = 0; c0 < 128; c0 += 32) {
            float s[32];
#pragma unroll
            for (int k = 0; k < 32; ++k) s[k] = bf2f(SC[(size_t)(bh * 128 + c0 + k) * 16384 + el]);
            if (doN) {
                float nc[32];
#pragma unroll
                for (int k = 0; k < 32; ++k) nc[k] = NC[(size_t)(bh * 128 + c0 + k) * 128 + el];
#pragma unroll
                for (int k = 0; k < 32; ++k) { NPREV[(size_t)(bh * 128 + c0 + k) * 128 + el] = n; n = DEC[c0 + k] * n + SCL[c0 + k] * nc[k]; }
            }
#pragma unroll
            for (int k = 0; k < 32; ++k) { SC[(size_t)(bh * 128 + c0 + k) * 16384 + el] = (bf16)(pk2(C, 0.f) & 0xffffu); C = DEC[c0 + k] * C + SCL[c0 + k] * s[k]; }
        }
        const int e = el >> 7, d = el & 127;
        a->out[O_CP + (size_t)(l * 8 + bh) * 16384 + d * 128 + e] = C;
        if (doN) a->out[O_NP + (size_t)(l * 8 + bh) * 128 + el] = n;
    }
}

DI void m3_item(int l, bool sample, int bb, int c, LAS unsigned char* lds, int hp = -1) {
    const ArgsP a = get_args(); const int tid = get_tid(), lane = tid & 63, wave = tid >> 6, head = wave >> 1, tt = wave & 1, r = lane & 31, h = lane >> 5;
    const int i16 = lane & 15, q4 = i16 >> 2, p4 = i16 & 3, blk = (lane >> 4) & 1;
    const bf16* Z = (const bf16*)(a->ws + WS_Z); const float* IG = (const float*)(a->ws + WS_IG); const float* LF = (const float*)(a->ws + WS_LF);
    const bf16* SC = (const bf16*)(a->ws + WS_SC); bf16* ACT = (bf16*)(a->ws + WS_ACT);
    const int row0 = sample ? MPR + bb * 16 : bb * SEQ + c * 64;
    const int u = sample ? 1024 + bb * 4 + head : (bb * 4 + head) * 128 + c;
    LAS char* vbase = (LAS char*)(lds + head * 18432);
    LAS float* AS = (LAS float*)(lds + 73728) + head * 64; LAS float* BS = (LAS float*)(lds + 73728 + 1024) + head * 64;
    LAS float* MT = (LAS float*)(lds + 73728 + 2048) + head * 64; LAS float* NP = (LAS float*)(lds + 73728 + 3072) + head * 128;
    const float mprev = ((const float*)(a->ws + WS_MPREV))[u];
    {
        const bool valid = sample ? (lane < 16) : true;
        const int rs = row0 + (sample ? (lane < 16 ? lane : 15) : lane);
        float b = valid ? LF[(size_t)rs * 4 + head] : 0.f; const float ig = valid ? IG[(size_t)rs * 4 + head] : -INFINITY;
#pragma unroll
        for (int o = 1; o < 64; o <<= 1) { const float t = __shfl_up(b, o); if (lane >= o) b += t; }
        const float av = ig - b; float cm = av;
#pragma unroll
        for (int o = 1; o < 64; o <<= 1) { const float t = __shfl_up(cm, o); if (lane >= o) cm = fmaxf(cm, t); }
        const float mt = b + fmaxf(mprev, cm);
        if (tt == 0) { AS[lane] = av; BS[lane] = b; MT[lane] = mt; const float* np = (const float*)(a->ws + WS_NPREV) + (size_t)u * 128; NP[lane] = np[lane]; NP[64 + lane] = np[64 + lane]; }
    }
#pragma unroll
    for (int hb = 0; hb < 2; ++hb) {
        u32x4 vst[4];
#pragma unroll
        for (int it = 0; it < 4; ++it) { const int idx = (4 * hb + it) * 128 + tt * 64 + lane; const int rr = idx >> 4, ch = idx & 15; const int srow = row0 + (sample ? (rr < 16 ? rr : 15) : rr);
            vst[it] = *(const u32x4*)(Z + (size_t)srow * NZ + 2560 + head * 128 + ch * 8); }
#pragma unroll
        for (int it = 0; it < 4; ++it) { const int idx = (4 * hb + it) * 128 + tt * 64 + lane; const int rr = idx >> 4, ch = idx & 15; *(LAS u32x4*)(vbase + rr * MPB + ch * 16) = vst[it]; }
    }
    const int t = 32 * tt + r;
    const int rowt = row0 + (sample ? (t < 16 ? t : 15) : t);
    bf16x8 qf[8];
#pragma unroll
    for (int s = 0; s < 8; ++s) qf[s] = *(const bf16x8*)(Z + (size_t)rowt * NZ + 1536 + head * 128 + 16 * s + 8 * h);
    bf16x8 scf[2][8], kf0[8];
#pragma unroll
    for (int et = 0; et < 2; ++et)
#pragma unroll
        for (int s = 0; s < 8; ++s) scf[et][s] = *(const bf16x8*)(SC + (size_t)u * 16384 + (32 * et + r) * 128 + 16 * s + 8 * h);
    { const int krow = row0 + (sample ? (r < 16 ? r : 15) : r);
#pragma unroll
      for (int s = 0; s < 8; ++s) kf0[s] = *(const bf16x8*)(Z + (size_t)krow * NZ + 2048 + head * 128 + 16 * s + 8 * h); }
    __syncthreads();
    if (!(sample && tt == 1) && ((hp < 0) || ((head >> 1) == hp))) {
        f32x16 acc[4];
#pragma unroll
        for (int et = 0; et < 2; ++et) { acc[et] = zero16();
#pragma unroll
            for (int s = 0; s < 8; ++s) acc[et] = MFMA32(scf[et][s], qf[s], acc[et]); }
#pragma unroll
        for (int et = 2; et < 4; ++et) { acc[et] = zero16();
#pragma unroll
            for (int s = 0; s < 8; ++s) { const bf16x8 af = *(const bf16x8*)(SC + (size_t)u * 16384 + (32 * et + r) * 128 + 16 * s + 8 * h); acc[et] = MFMA32(af, qf[s], acc[et]); } }
        const float bt = BS[t], mtt = MT[t]; const float wint = __expf(bt + mprev - mtt);
#pragma unroll
        for (int et = 0; et < 4; ++et) acc[et] *= wint;
        float qn = 0.f;
#pragma unroll
        for (int s = 0; s < 8; ++s)
#pragma unroll
            for (int jj = 0; jj < 8; ++jj) qn += bf2f((unsigned short)qf[s][jj]) * NP[16 * s + 8 * h + jj];
        qn += __shfl_xor(qn, 32);
        float den = wint * qn, denp = 0.f;
        u32x2 ogv[4][4];
#pragma unroll
        for (int et = 0; et < 4; ++et)
#pragma unroll
            for (int g = 0; g < 4; ++g) ogv[et][g] = *(const u32x2*)(Z + (size_t)rowt * NZ + 3072 + head * 128 + 32 * et + 8 * g + 4 * h);
        for (int st = 0; st <= tt; ++st) {
            f32x16 S = zero16();
            const int kr = 32 * st + r; const int krow = row0 + (sample ? (kr < 16 ? kr : 15) : kr);
            if (st == 0) {
#pragma unroll
                for (int s = 0; s < 8; ++s) S = MFMA32(kf0[s], qf[s], S);
            } else {
#pragma unroll
                for (int s = 0; s < 8; ++s) { const bf16x8 kf = *(const bf16x8*)(Z + (size_t)krow * NZ + 2048 + head * 128 + 16 * s + 8 * h); S = MFMA32(kf, qf[s], S); }
            }
#pragma unroll
            for (int i = 0; i < 16; ++i) { const int sl = 32 * st + (i & 3) + 8 * (i >> 2) + 4 * h; const float wgt = (sl <= t) ? __expf(bt + AS[sl] - mtt) : 0.f; S[i] *= wgt; denp += S[i]; }
            const bf16x8 pf0 = pack8(S, 0), pf1 = pack8(S, 1);
#pragma unroll
            for (int et = 0; et < 4; ++et) {
                const bf16x8 v0 = vtr2(vbase + (32 * st + 4 * h + q4) * MPB + 2 * (32 * et + 16 * blk) + 8 * p4, 8 * MPB);
                const bf16x8 v1 = vtr2(vbase + (32 * st + 16 + 4 * h + q4) * MPB + 2 * (32 * et + 16 * blk) + 8 * p4, 8 * MPB);
                acc[et] = MFMA32(v0, pf0, acc[et]); acc[et] = MFMA32(v1, pf1, acc[et]);
            }
        }
        den += denp + __shfl_xor(denp, 32);
        const float dd = fmaxf(fabsf(den), __expf(-mtt)); const float inv = 1.0f / dd;
        float ssq = 0.f;
#pragma unroll
        for (int et = 0; et < 4; ++et) { acc[et] *= inv;
#pragma unroll
            for (int i = 0; i < 16; ++i) ssq += acc[et][i] * acc[et][i]; }
        ssq += __shfl_xor(ssq, 32);
        const float rr = 1.0f / sqrtf(ssq * (1.f / 128.f) + EPS);
        const bool ok = sample ? (t < 16) : true;
        if (ok) {
            const float* gml = a->in[14] + l * 512 + head * 128;
#pragma unroll
            for (int et = 0; et < 4; ++et)
#pragma unroll
                for (int g = 0; g < 4; ++g) { const int e0 = 32 * et + 8 * g + 4 * h;
                    const u32x2 ob = ogv[et][g]; const f32x4 gm = *(const f32x4*)(gml + e0);
                    const float o0 = bflo(ob.x), o1 = bfhi(ob.x), o2 = bflo(ob.y), o3 = bfhi(ob.y);
                    const float y0 = acc[et][4 * g] * rr * gm.x * __builtin_amdgcn_rcpf(1.f + __expf(-o0)), y1 = acc[et][4 * g + 1] * rr * gm.y * __builtin_amdgcn_rcpf(1.f + __expf(-o1));
                    const float y2 = acc[et][4 * g + 2] * rr * gm.z * __builtin_amdgcn_rcpf(1.f + __expf(-o2)), y3 = acc[et][4 * g + 3] * rr * gm.w * __builtin_amdgcn_rcpf(1.f + __expf(-o3));
                    u32x2 o; o.x = pk2(y0, y1); o.y = pk2(y2, y3);
                    *(u32x2*)(ACT + (size_t)rowt * DM + 512 + head * 128 + e0) = o; }
        }
    }
    __syncthreads();
}
DI void sample_m2(int l, int sb, int hp, LAS unsigned char* lds) {
    const ArgsP a = get_args(); const int tid = get_tid();
    bf16* SC = (bf16*)(a->ws + WS_SC); const float* BL = (const float*)(a->ws + WS_BL); const float* AC = (const float*)(a->ws + WS_AC);
    float* MPREV = (float*)(a->ws + WS_MPREV); const float* NC = (const float*)(a->ws + WS_NC); float* NPREV = (float*)(a->ws + WS_NPREV);
    LAS float* Lc = (LAS float*)lds; LAS float* Ls = Lc + 128 * 129;
    for (int hh = 2 * hp; hh < 2 * hp + 2; ++hh) {
        const int su = sb * 4 + hh, u = 1024 + su;
        const float* c0p = a->in[4] + (size_t)(l * 32 + su) * 16384; bf16* scp = SC + (size_t)u * 16384; float* ocp = a->out + O_CS + (size_t)(l * 32 + su) * 16384;
        const float m0 = a->in[6][l * 32 + su];
        const float bl = BL[u], ac = AC[u]; const float mn = bl + fmaxf(m0, ac); const float dec = expf(bl + m0 - mn), sc = expf(bl + ac - mn);
#pragma unroll 1
        for (int i0 = 0; i0 < 32; i0 += 16) {
            float cv[16]; unsigned short sv[16];
#pragma unroll
            for (int ii = 0; ii < 16; ++ii) { const int idx = tid + (i0 + ii) * NTHR; cv[ii] = c0p[idx]; sv[ii] = scp[idx]; }
#pragma unroll
            for (int ii = 0; ii < 16; ++ii) { const int idx = tid + (i0 + ii) * NTHR; const int r = idx >> 7, q = idx & 127; Lc[r * 129 + q] = cv[ii]; Ls[r * 129 + q] = bf2f(sv[ii]); }
        }
        __syncthreads();
#pragma unroll
        for (int ii = 0; ii < 32; ++ii) { const int idx = tid + ii * NTHR; const int r = idx >> 7, q = idx & 127;
            scp[idx] = (bf16)(pk2(Lc[q * 129 + r], 0.f) & 0xffffu);
            ocp[idx] = dec * Lc[r * 129 + q] + sc * Ls[q * 129 + r]; }
        if (tid < 128) { const float n0 = a->in[5][(size_t)(l * 32 + su) * 128 + tid]; NPREV[(size_t)u * 128 + tid] = n0; a->out[O_NS + (size_t)(l * 32 + su) * 128 + tid] = dec * n0 + sc * NC[(size_t)u * 128 + tid]; }
        if (tid == 0) { MPREV[u] = m0; a->out[O_MS + l * 32 + su] = mn; }
        __syncthreads();
    }
}
#define BLOCK_MEM_SYNC() do { asm volatile("s_waitcnt vmcnt(0)" ::: "memory"); __syncthreads(); __builtin_amdgcn_fence(__ATOMIC_ACQUIRE, "agent"); asm volatile("s_waitcnt vmcnt(0)" ::: "memory"); } while (0)
DI void load_bias(int l, LAS unsigned char* lds) {
    const ArgsP a = get_args(); const int tid = get_tid();
    for (int e = tid; e < 8 * 320; e += NTHR) { const int hd = e / 320, i = e % 320; ((LAS float*)(lds + 73728))[hd * 320 + i] = a->in[12][(size_t)(l * 8 + hd) * 513 + 193 + i] * 1.4426950408889634f; }
    __syncthreads();
}
DI void phase_c(int l, LAS unsigned char* lds) {
    phase_c_pre(l);
    const int bid = get_bid(), nb = get_nb();
    const bool deal = (nb == 256);
    const int v = deal ? ((bid & 7) * 32 + (bid >> 3)) : bid;
    for (int t = v; t < 16; t += nb) {
        m1_item(true, t >> 1, 0, lds, t & 1);
        BLOCK_MEM_SYNC();
        sample_m2(l, t >> 1, t & 1, lds);
        BLOCK_MEM_SYNC();
        m3_item(l, true, t >> 1, 0, lds, t & 1);
    }
    int p_lo, p_hi, p_st, m_lo, m_hi, m_st;
    if (deal) { const int w = v - 16; p_lo = w < 0 ? 520 : (w * 520) / 240; p_hi = w < 0 ? 520 : ((w + 1) * 520) / 240; p_st = 1;
                const int r2 = 3 * w - p_lo; const bool two = (w >= 0) && (p_hi - p_lo == 2); m_lo = two ? (r2 * 256) / 200 : 256; m_hi = two ? ((r2 + 1) * 256) / 200 : 256; m_st = 1; }
    else { p_lo = bid; p_hi = 520; p_st = nb; m_lo = bid; m_hi = 256; m_st = nb; }
    if (p_lo < p_hi) load_bias(l, lds);
    for (int p = p_lo; p < p_hi; p += p_st) {
        if (p >= 512) attn_unit<true>(l, p - 512, 0, 0, lds);
        else attn_unit<false>(l, p >> 8, (p >> 1) & 127, p & 1, lds);
    }
    __syncthreads();
    for (int t = m_lo; t < m_hi; t += m_st) m1_item(false, t >> 7, t & 127, lds);
}
DI void phase_e(int l, LAS unsigned char* lds) {
    const int bid = get_bid(), nb = get_nb(); const int v0 = (nb == 256) ? ((bid & 7) * 32 + (bid >> 3)) : bid;
    for (int it = v0; it < 256; it += nb) m3_item(l, false, it >> 7, it & 127, lds);
}

DI float gelu_tanh(float x) { const float ee = __builtin_amdgcn_exp2f(x * (2.3022082f + 0.10294324f * x * x)); return x - x * __builtin_amdgcn_rcpf(ee + 1.f); }
DI void ld8(const bf16* p, float (&o)[8]) { const u32x4 x = *(const u32x4*)p; o[0] = bflo(x.x); o[1] = bfhi(x.x); o[2] = bflo(x.y); o[3] = bfhi(x.y); o[4] = bflo(x.z); o[5] = bfhi(x.z); o[6] = bflo(x.w); o[7] = bfhi(x.w); }
DI void ldf8(const float* p, float (&o)[8]) { const f32x4 x = *(const f32x4*)p, y = *(const f32x4*)(p + 4); o[0] = x.x; o[1] = x.y; o[2] = x.z; o[3] = x.w; o[4] = y.x; o[5] = y.y; o[6] = y.z; o[7] = y.w; }
DI void phase_fix(int l) {
    const ArgsP a = get_args(); const int gt = get_bid() * NTHR + get_tid(), NTH = get_nb() * NTHR;
    const bf16* UQ = (const bf16*)(a->ws + WS_UQ); bf16* G = (bf16*)(a->ws + WS_G);
    const float* wc = a->in[17] + (size_t)l * 3 * NU; const float* bc = a->in[18] + (size_t)l * NU;
    for (int item = gt; item < (MVALID / 16) * 352; item += NTH) {
        const int k = item / 352, cc = item % 352, j0 = cc * 8; const int m0 = 16 * k;
        const bool smp = m0 >= MPR; const bool bstart = smp ? true : ((m0 & (SEQ - 1)) == 0); const int sb = smp ? (m0 - MPR) >> 4 : 0;
        float w0g[8], w1g[8], w2g[8], bg[8], w0u[8], w1u[8], w2u[8], bu[8];
        ldf8(wc + j0, w0g); ldf8(wc + NU + j0, w1g); ldf8(wc + 2 * NU + j0, w2g); ldf8(bc + j0, bg);
        ldf8(wc + DFF + j0, w0u); ldf8(wc + NU + DFF + j0, w1u); ldf8(wc + 2 * NU + DFF + j0, w2u); ldf8(bc + DFF + j0, bu);
        float p2g[8], p1g[8], p2u[8], p1u[8], c0g[8], c0u[8], c1g[8], c1u[8];
        if (bstart) {
            if (smp) { const float* cb = a->in[7] + (size_t)((l * 8 + sb) * 2) * NU; ldf8(cb + j0, p2g); ldf8(cb + NU + j0, p1g); ldf8(cb + DFF + j0, p2u); ldf8(cb + NU + DFF + j0, p1u); }
            else {
#pragma unroll
                for (int q = 0; q < 8; ++q) { p2g[q] = 0.f; p1g[q] = 0.f; p2u[q] = 0.f; p1u[q] = 0.f; } }
        } else { const bf16* pq = UQ + (size_t)(4 * (k - 1) + 2) * NU; ld8(pq + j0, p2g); ld8(pq + NU + j0, p1g); ld8(pq + DFF + j0, p2u); ld8(pq + NU + DFF + j0, p1u); }
        const bf16* cq = UQ + (size_t)(4 * k) * NU; ld8(cq + j0, c0g); ld8(cq + DFF + j0, c0u); ld8(cq + NU + j0, c1g); ld8(cq + NU + DFF + j0, c1u);
        float o0[8], o1[8];
#pragma unroll
        for (int q = 0; q < 8; ++q) {
            o0[q] = gelu_tanh(bg[q] + p2g[q] * w0g[q] + p1g[q] * w1g[q] + c0g[q] * w2g[q]) * (bu[q] + p2u[q] * w0u[q] + p1u[q] * w1u[q] + c0u[q] * w2u[q]);
            o1[q] = gelu_tanh(bg[q] + p1g[q] * w0g[q] + c0g[q] * w1g[q] + c1g[q] * w2g[q]) * (bu[q] + p1u[q] * w0u[q] + c0u[q] * w1u[q] + c1u[q] * w2u[q]); }
        u32x4 ov; ov.x = pk2(o0[0], o0[1]); ov.y = pk2(o0[2], o0[3]); ov.z = pk2(o0[4], o0[5]); ov.w = pk2(o0[6], o0[7]);
        *(u32x4*)(G + (size_t)m0 * DFF + j0) = ov;
        ov.x = pk2(o1[0], o1[1]); ov.y = pk2(o1[2], o1[3]); ov.z = pk2(o1[4], o1[5]); ov.w = pk2(o1[6], o1[7]);
        *(u32x4*)(G + (size_t)(m0 + 1) * DFF + j0) = ov;
        const bool lastg = smp ? true : ((m0 & (SEQ - 1)) == SEQ - 16);
        if (lastg) {
            float* fo = smp ? a->out + O_FS + (size_t)((l * 8 + sb) * 2) * NU : a->out + O_FP + (size_t)((l * 2 + (m0 >> 13)) * 2) * NU;
            float e0[8], e1[8]; const bf16* lq = UQ + (size_t)(4 * k + 2) * NU;
            ld8(lq + j0, e0); ld8(lq + NU + j0, e1);
            *(f32x4*)(fo + j0) = (f32x4){e0[0], e0[1], e0[2], e0[3]}; *(f32x4*)(fo + j0 + 4) = (f32x4){e0[4], e0[5], e0[6], e0[7]};
            *(f32x4*)(fo + NU + j0) = (f32x4){e1[0], e1[1], e1[2], e1[3]}; *(f32x4*)(fo + NU + j0 + 4) = (f32x4){e1[4], e1[5], e1[6], e1[7]};
            ld8(lq + DFF + j0, e0); ld8(lq + NU + DFF + j0, e1);
            *(f32x4*)(fo + DFF + j0) = (f32x4){e0[0], e0[1], e0[2], e0[3]}; *(f32x4*)(fo + DFF + j0 + 4) = (f32x4){e0[4], e0[5], e0[6], e0[7]};
            *(f32x4*)(fo + NU + DFF + j0) = (f32x4){e1[0], e1[1], e1[2], e1[3]}; *(f32x4*)(fo + NU + DFF + j0 + 4) = (f32x4){e1[4], e1[5], e1[6], e1[7]};
        }
    }
}

#define XB_TMO      128
#define XB_XCNT(j)  (256  + 64 * (j))
#define XB_XSUB(j)  (1280 + 64 * (j))
#define XB_XGEN(j)  (2304 + 64 * (j))
#define XB_TOP      3328
#define XB_TOPGEN   3392
#define XCD_BAR_WORDS 3456
#define XB_SPIN_CAP (1u << 18)
__device__ __forceinline__ unsigned xb_ld(unsigned* p)              { return __hip_atomic_load(p, __ATOMIC_RELAXED, __HIP_MEMORY_SCOPE_AGENT); }
__device__ __forceinline__ unsigned xb_add(unsigned* p, unsigned v) { return __hip_atomic_fetch_add(p, v, __ATOMIC_RELAXED, __HIP_MEMORY_SCOPE_AGENT); }
__device__ __forceinline__ unsigned xb_xcc_id() { return (unsigned)__builtin_amdgcn_s_getreg((3 << 11) | 20) & 0xFu; }
#define XB_SPIN(cond, bar) do { unsigned _sp = 0; while (cond) { __builtin_amdgcn_s_sleep(1); \
    if ((++_sp & 255u) == 0u) { if (xb_ld(&(bar)[XB_TMO])) break; if (_sp > XB_SPIN_CAP) { atomicAdd(&(bar)[XB_TMO], 1u); break; } } } } while (0)

struct XcdBarrier {
    unsigned* bar; unsigned x;
    volatile LAS unsigned* st;
};

__device__ __forceinline__ XcdBarrier xcd_barrier_post(unsigned* bar, volatile LAS unsigned* st) {
    XcdBarrier b; b.bar = bar; b.x = xb_xcc_id(); b.st = st;
    if (threadIdx.x == 0) (void)xb_add(&bar[XB_XCNT(b.x)], 1u);
    return b;
}
__device__ __forceinline__ void xcd_barrier_complete(unsigned* bar, unsigned x, unsigned& nloc, unsigned& nx) {
    const unsigned G = gridDim.x * gridDim.y * gridDim.z;
    unsigned sum, cnt, mine, sp = 0u;
    for (;;) {
        sum = 0u; cnt = 0u; mine = 0u;
#pragma unroll
        for (unsigned j = 0; j < 16; ++j) { const unsigned c = xb_ld(&bar[XB_XCNT(j)]); sum += c; cnt += (c > 0u) ? 1u : 0u; mine = (j == x) ? c : mine; }
        if (sum == G) break;
        __builtin_amdgcn_s_sleep(1);
        if ((++sp & 255u) == 0u) { if (xb_ld(&bar[XB_TMO])) break; if (sp > XB_SPIN_CAP) { atomicAdd(&bar[XB_TMO], 1u); break; } }
    }
    nloc = mine > 0u ? mine : 1u; nx = cnt > 0u ? cnt : 1u;
}

__device__ __forceinline__ void xcd_barrier(const XcdBarrier& b) {
    asm volatile("s_waitcnt vmcnt(0)" ::: "memory");
    __syncthreads();
    if (threadIdx.x == 0) {
        unsigned* bar = b.bar;
        __builtin_amdgcn_s_waitcnt(0);
        unsigned nloc = b.st[0], nx = b.st[1];
        if (nloc == 0u) { xcd_barrier_complete(bar, b.x, nloc, nx); b.st[0] = nloc; b.st[1] = nx; }
        const unsigned old = xb_add(&bar[XB_XSUB(b.x)], 1u);
        const unsigned gen = old / nloc;
        if (old + 1u == (gen + 1u) * nloc) {
            __builtin_amdgcn_fence(__ATOMIC_RELEASE, "agent");
            asm volatile("s_waitcnt vmcnt(0)" ::: "memory");
            const unsigned og = xb_add(&bar[XB_TOP], 1u);
            const unsigned tg = og / nx;
            if (og + 1u == (tg + 1u) * nx) xb_add(&bar[XB_TOPGEN], 1u);
            else XB_SPIN(xb_ld(&bar[XB_TOPGEN]) == tg, bar);
            __builtin_amdgcn_fence(__ATOMIC_ACQUIRE, "agent");
            xb_add(&bar[XB_XGEN(b.x)], 1u);
            asm volatile("s_waitcnt vmcnt(0)" ::: "memory");
        } else {
            XB_SPIN(xb_ld(&bar[XB_XGEN(b.x)]) == gen, bar);
            __builtin_amdgcn_fence(__ATOMIC_ACQUIRE, "agent");
            asm volatile("s_waitcnt vmcnt(0)" ::: "memory");
        }
    }
    __syncthreads();
}


#ifndef PHMASK
#define PHMASK 0xffff
#endif
#ifndef REP_GEMM
#define REP_GEMM 1
#endif
#ifndef REP_C
#define REP_C 1
#endif
#ifndef REP_E
#define REP_E 1
#endif
#ifndef REP_SYNC
#define REP_SYNC 1
#endif
#ifndef REP_CONV
#define REP_CONV 1
#endif
__global__ void __launch_bounds__(NTHR, 2) fwd_mega(Args a_unused) {
    extern __shared__ __attribute__((aligned(16))) unsigned char lds_raw[];
    LAS unsigned char* lds0 = (LAS unsigned char*)lds_raw;
    cg::grid_group grid = cg::this_grid();
    volatile LAS unsigned* st = (volatile LAS unsigned*)(lds0 + 147456);
    if (threadIdx.x < 4) st[threadIdx.x] = 0u;
    __syncthreads();
    unsigned* barw = (unsigned*)(get_args()->ws + WS_BAR);
    if (blockIdx.x == 0) { for (int i = threadIdx.x; i < XCD_BAR_WORDS; i += NTHR) __hip_atomic_store(barw + i, 0u, __ATOMIC_RELAXED, __HIP_MEMORY_SCOPE_AGENT); }
    grid.sync();
    const XcdBarrier bar = xcd_barrier_post(barw, st);
#pragma nounroll
    for (int step = 0; step < 21; ++step) {
        const int l = step / 10, ph = (step == 20) ? 12 : step % 10;
        LAS unsigned char* lds = lds0; asm volatile("" : "+s"(lds));
        if (ph == 1 || ph == 5 || ph == 7 || ph == 9) {
            if (PHMASK & 4) {
            const ArgsP a = get_args(); unsigned char* ws = a->ws;
            const bf16* A; const bf16* Bt; void* O; int M, N, K, mode;
            if (ph == 1)       { A = (const bf16*)(ws + WS_ACT); Bt = (const bf16*)(ws + WS_WIN); O = ws + WS_Z; M = MPAD; N = NZ + 256; K = DM; mode = 1; }
            else if (ph == 5)  { A = (const bf16*)(ws + WS_ACT); Bt = (const bf16*)(ws + WS_WOUT); O = ws + WS_MIX; M = MPR; N = DM; K = DM; mode = 0; }
            else if (ph == 7)  { A = (const bf16*)(ws + WS_ACT); Bt = (const bf16*)(ws + WS_WUP); O = ws + WS_G; M = MPAD; N = NU; K = DM; mode = 3; }
            else               { A = (const bf16*)(ws + WS_G); Bt = (const bf16*)(ws + WS_WDN); O = ws + WS_FFN; M = MPR; N = DM; K = DFF; mode = 0; }
            pg8::EpiGen E{O, N, mode, ws + WS_UQ, a->in[17] + (size_t)l * 3 * NU, a->in[18] + (size_t)l * NU, (float*)(ws + WS_IG), (float*)(ws + WS_LF), a->in[10] + l * 4, a->in[11] + l * 4};
            pg8::Gemm g{A, Bt, M, N, K}; pg8::StaticOrder S; S.init(M, N, get_nb(), get_bid());
            pg8::gemm_phase<pg8::EpiGen, pg8::StaticOrder, true, true>(lds, g, S, E);
            if (ph == 5 || ph == 9) mini_gemm(lds, A + (size_t)MPR * K, Bt, K, (bf16*)O + (size_t)MPR * DM);
            }
        } else if (ph == 0 || ph == 6 || ph == 12) {
            if (ph == 0 && (PHMASK & 1)) { phase_convert(l, lds); __syncthreads(); }
            if (PHMASK & 2) {
            const ArgsP a = get_args();
            const float* ngl = a->in[8] + (size_t)l * 4 * DM;
            bool first; const bf16* addsrc; const float* gadd; const float* gn; int gl;
            if (ph == 0) { first = (l == 0); addsrc = (l == 0) ? nullptr : (const bf16*)(a->ws + WS_FFN); gadd = ngl - DM; gn = ngl; gl = -1; }
            else if (ph == 6) { first = false; addsrc = (const bf16*)(a->ws + WS_MIX); gadd = ngl + DM; gn = ngl + 2 * DM; gl = -1; }
            else { first = false; addsrc = (const bf16*)(a->ws + WS_FFN); gadd = a->in[8] + (size_t)7 * DM; gn = nullptr; gl = -1; }
            phase_rows(lds, first, addsrc, gadd, gn, gl, ph == 12);
            }
        } else if (ph == 2) { if (PHMASK & 8) phase_c(l, lds); }
        else if (ph == 3) { if (PHMASK & 16) phase_m2(l, lds); }
        else if (ph == 4) { if (PHMASK & 32) phase_e(l, lds); }
        else { if (PHMASK & 512) phase_fix(l); }
        if (step < 20) xcd_barrier(bar);
    }
}

extern "C" void kernel_launch(void* const* d_in, const int* in_sizes, int n_in, void* d_out, int out_size, void* d_ws, size_t ws_size, hipStream_t stream) {
    static int grid = 0;
    if (grid == 0) {
        if (n_in != 20 || (size_t)out_size != O_END || ws_size < WS_END) { fprintf(stderr, "kernel_launch: unexpected shapes: n_in %d out %d ws %zu\n", n_in, out_size, ws_size); grid = -1; return; }
        int dev = 0, cus = 0, per_cu = 0;
        (void)hipGetDevice(&dev);
        (void)hipDeviceGetAttribute(&cus, hipDeviceAttributeMultiprocessorCount, dev);
        (void)hipFuncSetAttribute((const void*)fwd_mega, hipFuncAttributeMaxDynamicSharedMemorySize, LDS_BYTES);
        (void)hipOccupancyMaxActiveBlocksPerMultiprocessor(&per_cu, (const void*)fwd_mega, NTHR, LDS_BYTES);
        if (per_cu < 1) per_cu = 1;
        grid = cus * per_cu;
    }
    if (grid < 0) return;
    Args a{};
    for (int i = 0; i < 20; ++i) a.in[i] = (const float*)d_in[i];
    a.out = (float*)d_out; a.ws = (unsigned char*)d_ws;
    void* args[] = {&a};
    hipError_t e = hipLaunchCooperativeKernel((const void*)fwd_mega, dim3(grid), dim3(NTHR), args, LDS_BYTES, stream);
    if (e != hipSuccess) fprintf(stderr, "cooperative launch failed: %s (grid %d)\n", hipGetErrorString(e), grid);
}
```

```cpp
#include <hip/hip_runtime.h>
#include <hip/hip_cooperative_groups.h>
#include <cstdio>
#include <cstdint>
#include <cmath>
namespace cg = cooperative_groups;

namespace pg8 {
#define PG8_LAS __attribute__((address_space(3)))
typedef unsigned short bf16_t;
typedef short bf16x8 __attribute__((ext_vector_type(8)));
typedef float f32x4 __attribute__((ext_vector_type(4)));
typedef unsigned u32x4 __attribute__((ext_vector_type(4)));
constexpr int BM = 256, BK = 64, HALF = 128, HTB = HALF * BK * 2  , STAGE_BYTES = 8 * HTB, NXCD = 8, WGM = 8;

__host__ __device__ __forceinline__ int lds_byte(int r, int c) { const int st = (r >> 4) * 2 + (c >> 5), rr = r & 15, cc = c & 31, ob = rr * 64 + cc * 2; return st * 1024 + (ob ^ (((ob >> 9) & 1) << 5)); }
__host__ __device__ __forceinline__ void stage_rc(int b, int& R, int& C) { const int st = b / 1024, sb = b % 1024, swz = sb ^ (((sb >> 9) & 1) << 5); R = (st >> 1) * 16 + swz / 64; C = (st & 1) * 32 + (swz % 64) / 2; }
__host__ __device__ __forceinline__ int perm32(int rho) { const int n = rho >> 4, i = rho & 15; return 8 * (i >> 2) + 4 * n + (i & 3); }

struct Unit { int pm, pn; };
struct Gemm { const bf16_t* A; const bf16_t* Bt; int M, N, K; };

struct StaticOrder {
    int nM, nN, nwg, G, c;
    __host__ __device__ void init(int M, int N, int G_, int c_) { nM = M / BM; nN = N / BM; nwg = nM * nN; G = G_; c = c_; }
    __host__ __device__ bool next(int i, Unit& u) const {
        const long L = (long)i * G + c; if (L >= nwg) return false;
        int wgid = (int)L; { const int q = nwg / NXCD, r = nwg % NXCD, xcd = wgid % NXCD, off = wgid / NXCD; wgid = (xcd < r ? xcd * (q + 1) : r * (q + 1) + (xcd - r) * q) + off; }
        const int nig = WGM * nN, gid = wgid / nig, fm = gid * WGM, gsz = (nM - fm) < WGM ? (nM - fm) : WGM;
        u.pm = fm + ((wgid % nig) % gsz); u.pn = (wgid % nig) / gsz; return true;
    }
    __device__ __forceinline__ void a_ready(const Unit&) const {}
    __device__ __forceinline__ void done(const Unit&) const {}
};

typedef float f32x2e __attribute__((ext_vector_type(2)));
typedef __bf16 bf16x2e __attribute__((ext_vector_type(2)));
__device__ __forceinline__ unsigned cvt_pk_bf16(float lo, float hi) { f32x2e v = {lo, hi}; bf16x2e b = __builtin_convertvector(v, bf16x2e); return __builtin_bit_cast(unsigned, b); }
__device__ __forceinline__ float gelu_t(float x) { const float ee = __builtin_amdgcn_exp2f(x * (2.3022082f + 0.10294324f * x * x)); return x - x * __builtin_amdgcn_rcpf(ee + 1.f); }
__device__ __forceinline__ float dpp_shr1(float v) { return __builtin_bit_cast(float, __builtin_amdgcn_update_dpp(0, __builtin_bit_cast(int, v), 0x111, 0xf, 0xf, true)); }
__device__ __forceinline__ float dpp_shr2(float v) { return __builtin_bit_cast(float, __builtin_amdgcn_update_dpp(0, __builtin_bit_cast(int, v), 0x112, 0xf, 0xf, true)); }
struct EpiGen {
    static constexpr bool PERM = true, AFTER_DRAIN = false;
    void* O; int ldc; int mode;
    void* O2; const float* cw; const float* cb;
    float* IGo; float* LFo; const float* bi; const float* bfg;
    __device__ __forceinline__ void operator()(const f32x4 (&acc)[2][2][4][2], const Unit& u, int wr, int wc, int fr, int fq) const {
        const int row0 = u.pm * BM + wr * 64 + fr; const int col0 = u.pn * BM + wc * 32 + 8 * fq;
        if (mode == 3) {
            const int f0 = u.pn * 128 + wc * 32 + 8 * fq;
#pragma unroll
            for (int n = 0; n < 2; ++n) {
                const int fn = f0 + 4 * n;
                const f32x4 w0g = *(const f32x4*)(cw + fn), w1g = *(const f32x4*)(cw + 5632 + fn), w2g = *(const f32x4*)(cw + 2 * 5632 + fn), bg = *(const f32x4*)(cb + fn);
                const f32x4 w0u = *(const f32x4*)(cw + 2816 + fn), w1u = *(const f32x4*)(cw + 5632 + 2816 + fn), w2u = *(const f32x4*)(cw + 2 * 5632 + 2816 + fn), bu = *(const f32x4*)(cb + 2816 + fn);
#pragma unroll
                for (int ai = 0; ai < 2; ++ai)
#pragma unroll
                    for (int m = 0; m < 4; ++m) { const int row = row0 + ai * HALF + m * 16;
                        float og[4];
#pragma unroll
                        for (int i = 0; i < 4; ++i) { const float ug = acc[ai][0][m][n][i], uu = acc[ai][1][m][n][i];
                            const float yg = bg[i] + dpp_shr2(ug) * w0g[i] + dpp_shr1(ug) * w1g[i] + ug * w2g[i];
                            const float yu = bu[i] + dpp_shr2(uu) * w0u[i] + dpp_shr1(uu) * w1u[i] + uu * w2u[i];
                            og[i] = gelu_t(yg) * yu; }
                        if (fr >= 2) { unsigned w0 = cvt_pk_bf16(og[0], og[1]), w1 = cvt_pk_bf16(og[2], og[3]);
                            unsigned* dst = (unsigned*)((bf16_t*)O + (size_t)row * 2816 + fn); dst[0] = w0; dst[1] = w1; } }
            }
            if (fr < 2 || fr >= 14) {
#pragma unroll
                for (int ai = 0; ai < 2; ++ai)
#pragma unroll
                    for (int m = 0; m < 4; ++m) { const int row = row0 + ai * HALF + m * 16;
                        bf16_t* q = (bf16_t*)O2 + (size_t)((row >> 4) * 4 + (fr < 2 ? fr : fr - 12)) * 5632 + f0;
                        u32x4 wg, wu; const f32x4 g0 = acc[ai][0][m][0], g1 = acc[ai][0][m][1], u0 = acc[ai][1][m][0], u1 = acc[ai][1][m][1];
                        wg.x = cvt_pk_bf16(g0[0], g0[1]); wg.y = cvt_pk_bf16(g0[2], g0[3]); wg.z = cvt_pk_bf16(g1[0], g1[1]); wg.w = cvt_pk_bf16(g1[2], g1[3]);
                        wu.x = cvt_pk_bf16(u0[0], u0[1]); wu.y = cvt_pk_bf16(u0[2], u0[3]); wu.z = cvt_pk_bf16(u1[0], u1[1]); wu.w = cvt_pk_bf16(u1[2], u1[3]);
                        *(u32x4*)q = wg; *(u32x4*)(q + 2816) = wu; }
            }
        } else if (mode == 2) {
#pragma unroll
            for (int ai = 0; ai < 2; ++ai)
#pragma unroll
                for (int m = 0; m < 4; ++m) { float* rowp = (float*)O + (size_t)(row0 + ai * HALF + m * 16) * ldc + col0;
#pragma unroll
                    for (int bj = 0; bj < 2; ++bj) { *(f32x4*)(rowp + bj * HALF) = acc[ai][bj][m][0]; *(f32x4*)(rowp + bj * HALF + 4) = acc[ai][bj][m][1]; } }
        } else if (mode == 1 && u.pn == 14) {
            if (wc == 0 && fq == 0) {
                const f32x4 bi4 = *(const f32x4*)bi, bf4 = *(const f32x4*)bfg;
#pragma unroll
                for (int ai = 0; ai < 2; ++ai)
#pragma unroll
                    for (int m = 0; m < 4; ++m) { const int row = row0 + ai * HALF + m * 16;
                        *(f32x4*)(IGo + (size_t)row * 4) = acc[ai][0][m][0] + bi4;
                        f32x4 x = acc[ai][0][m][1] + bf4, o;
#pragma unroll
                        for (int i = 0; i < 4; ++i) o[i] = fminf(x[i], 0.f) - log1pf(expf(-fabsf(x[i])));
                        *(f32x4*)(LFo + (size_t)row * 4) = o; }
            }
        } else {
            const int ldz = (mode == 1) ? 3584 : ldc;
            float sc = 1.f; if (mode == 1) { sc = (u.pn < 2) ? 0.18033688011112042f   : ((u.pn == 8 || u.pn == 9) ? 0.08838834764831845f : 1.f); }
#pragma unroll
            for (int ai = 0; ai < 2; ++ai)
#pragma unroll
                for (int m = 0; m < 4; ++m) { bf16_t* rowp = (bf16_t*)O + (size_t)(row0 + ai * HALF + m * 16) * ldz + col0;
#pragma unroll
                    for (int bj = 0; bj < 2; ++bj) { f32x4 v0 = acc[ai][bj][m][0] * sc, v1 = acc[ai][bj][m][1] * sc;
                        u32x4 w; w.x = cvt_pk_bf16(v0[0], v0[1]); w.y = cvt_pk_bf16(v0[2], v0[3]); w.z = cvt_pk_bf16(v1[0], v1[1]); w.w = cvt_pk_bf16(v1[2], v1[3]);
                        *(u32x4*)(rowp + bj * HALF) = w; } }
        }
    }
    __device__ __forceinline__ void fused(f32x4 (&acc)[2][2][4][2], const Unit& u, int wr, int wc, int fr, int fq, PG8_LAS unsigned char* lds, int wid, int lane) const {}
};
template <class Epi, class Sched, bool ALIGN_EPI = false, bool SP2 = false>
__device__ __forceinline__ void gemm_phase(PG8_LAS unsigned char* lds, const Gemm g, const Sched& S, const Epi& E) {
    int tid_ = threadIdx.x; asm volatile("" : "+v"(tid_)); const int tid = tid_, wid = __builtin_amdgcn_readfirstlane(tid >> 6), lane = tid & 63, wr = wid >> 2, wc = wid & 3, fr = lane & 15, fq = lane >> 4;
    const int K = g.K, nt = K / BK;
    unsigned voffA[2], voffB[2];
#pragma unroll
    for (int i = 0; i < 2; ++i) { int R, C; stage_rc(tid * 16 + i * 8192, R, C); const int Rb = Epi::PERM ? ((R & ~31) + perm32(R & 31)) : R;
        voffA[i] = (unsigned)(R * K + C) * 2u; voffB[i] = (unsigned)(Rb * K + C) * 2u; }
    const size_t kstep = (size_t)(BK * 2);
    const size_t hstep = (size_t)HALF * K * 2;
    const size_t tstep = 2 * hstep;
    const unsigned ldsw = (unsigned)wid * 1024u;
    const int aoff = lds_byte(wr * 64 + fr, fq * 8), boff = lds_byte(wc * 32 + fr, fq * 8);
#define PG8_SA(b, h) (((b) * 2 + (h)) * HTB)
#define PG8_SB(b, h) ((4 + (b) * 2 + (h)) * HTB)
#define PG8_STAGE(bufoff, gbase, voff) do { _Pragma("unroll") for (int _i = 0; _i < 2; ++_i) \
        __builtin_amdgcn_global_load_lds((const unsigned*)((const char*)(gbase) + (voff)[_i]), (PG8_LAS unsigned*)(lds + (bufoff) + ldsw + _i * 8192), 16, 0, 0); } while (0)
#define PG8_LDA(dst, b, h) do { _Pragma("unroll") for (int m = 0; m < 4; ++m) _Pragma("unroll") for (int k = 0; k < 2; ++k) dst[m][k] = *(const PG8_LAS bf16x8*)(lds + PG8_SA(b, h) + aoff + m * 2048 + k * 1024); } while (0)
#define PG8_LDB(dst, b, h) do { _Pragma("unroll") for (int n = 0; n < 2; ++n) _Pragma("unroll") for (int k = 0; k < 2; ++k) dst[n][k] = *(const PG8_LAS bf16x8*)(lds + PG8_SB(b, h) + boff + n * 2048 + k * 1024); } while (0)
#define PG8_MMA(ai, bj, At, Bt) do { __builtin_amdgcn_s_setprio(1); _Pragma("unroll") for (int m = 0; m < 4; ++m) _Pragma("unroll") for (int n = 0; n < 2; ++n) _Pragma("unroll") for (int k = 0; k < 2; ++k) \
        acc[ai][bj][m][n] = __builtin_amdgcn_mfma_f32_16x16x32_bf16(Bt[n][k], At[m][k], acc[ai][bj][m][n], 0, 0, 0); __builtin_amdgcn_s_setprio(0); } while (0)
#define PG8_WAIT_V(n) asm volatile("s_waitcnt vmcnt(" #n ")" ::: "memory")
#define PG8_WAIT_L(n) asm volatile("s_waitcnt lgkmcnt(" #n ")" ::: "memory")
#define PG8_BAR __builtin_amdgcn_s_barrier()
#define PG8_SCHED __builtin_amdgcn_sched_barrier(0)
    Unit cur, nxt; int ui = 0;
    if (!S.next(0, cur)) return;
    f32x4 acc[2][2][4][2];
#pragma unroll
    for (int a = 0; a < 2; ++a)
#pragma unroll
        for (int b = 0; b < 2; ++b)
#pragma unroll
            for (int m = 0; m < 4; ++m)
#pragma unroll
                for (int n = 0; n < 2; ++n) acc[a][b][m][n] = (f32x4){0.f, 0.f, 0.f, 0.f};
    bf16x8 At[4][2], B0[2][2], B1[2][2];
    const char* cA = (const char*)g.A + (size_t)cur.pm * tstep; const char* cB = (const char*)g.Bt + (size_t)cur.pn * tstep;
    S.a_ready(cur);
    if constexpr (SP2) {
        PG8_STAGE(PG8_SB(0, 0), cB, voffB); PG8_STAGE(PG8_SB(0, 1), cB + hstep, voffB); PG8_STAGE(PG8_SA(0, 0), cA, voffA); PG8_STAGE(PG8_SA(0, 1), cA + hstep, voffA);
        if (wr == 1) PG8_BAR;
        PG8_WAIT_V(2); PG8_BAR;
        PG8_STAGE(PG8_SB(1, 0), cB + kstep, voffB); PG8_STAGE(PG8_SA(1, 0), cA + kstep, voffA); PG8_STAGE(PG8_SB(1, 1), cB + hstep + kstep, voffB);
        PG8_WAIT_V(6); PG8_BAR;
    } else {
        PG8_STAGE(PG8_SB(0, 0), cB, voffB); PG8_STAGE(PG8_SA(0, 0), cA, voffA); PG8_STAGE(PG8_SB(0, 1), cB + hstep, voffB); PG8_STAGE(PG8_SA(0, 1), cA + hstep, voffA);
        if (wr == 1) PG8_BAR;
        PG8_WAIT_V(4); PG8_BAR;
        PG8_STAGE(PG8_SB(1, 0), cB + kstep, voffB); PG8_STAGE(PG8_SA(1, 0), cA + kstep, voffA); PG8_STAGE(PG8_SB(1, 1), cB + hstep + kstep, voffB);
        PG8_WAIT_V(6); PG8_BAR;
    }
    for (;;) {
        const bool has_next = S.next(ui + 1, nxt);
        const char* nA = has_next ? (const char*)g.A + (size_t)nxt.pm * tstep : cA; const char* nB = has_next ? (const char*)g.Bt + (size_t)nxt.pn * tstep : cB;
        for (int t = 0; t < nt; t += 2) {
            const bool last = (t == nt - 2);
            const char* a1 = cA + (size_t)(t + 1) * kstep;
            const char* a2 = last ? nA : cA + (size_t)(t + 2) * kstep; const char* b2 = last ? nB : cB + (size_t)(t + 2) * kstep;
            const char* a3 = a2 + kstep; const char* b3 = b2 + kstep;
            if (last && has_next) S.a_ready(nxt);
            if constexpr (SP2) {
            PG8_LDB(B0, 0, 0); PG8_LDB(B1, 0, 1); PG8_SCHED; PG8_LDA(At, 0, 0); PG8_STAGE(PG8_SA(1, 1), a1 + hstep, voffA);
            PG8_WAIT_V(8); PG8_WAIT_L(0); PG8_BAR; PG8_MMA(0, 0, At, B0); PG8_MMA(0, 1, At, B1); PG8_BAR; PG8_SCHED;
            PG8_LDA(At, 0, 1); PG8_STAGE(PG8_SB(0, 0), b2, voffB); PG8_STAGE(PG8_SB(0, 1), b2 + hstep, voffB); PG8_STAGE(PG8_SA(0, 0), a2, voffA);
            PG8_WAIT_V(8); PG8_WAIT_L(0); PG8_BAR; PG8_MMA(1, 0, At, B0); PG8_MMA(1, 1, At, B1); PG8_BAR; PG8_SCHED;
            PG8_LDB(B0, 1, 0); PG8_LDB(B1, 1, 1); PG8_SCHED; PG8_LDA(At, 1, 0); PG8_STAGE(PG8_SA(0, 1), a2 + hstep, voffA);
            PG8_WAIT_V(8); PG8_WAIT_L(0); PG8_BAR; PG8_MMA(0, 0, At, B0); PG8_MMA(0, 1, At, B1); PG8_BAR; PG8_SCHED;
            PG8_LDA(At, 1, 1); PG8_STAGE(PG8_SB(1, 0), b3, voffB); PG8_STAGE(PG8_SB(1, 1), b3 + hstep, voffB); PG8_STAGE(PG8_SA(1, 0), a3, voffA);
            PG8_WAIT_V(8); PG8_WAIT_L(0); PG8_BAR; PG8_MMA(1, 0, At, B0); PG8_MMA(1, 1, At, B1); PG8_BAR; PG8_SCHED;
            } else {
            PG8_LDB(B0, 0, 0); PG8_SCHED; PG8_LDA(At, 0, 0); PG8_STAGE(PG8_SA(1, 1), a1 + hstep, voffA);
            PG8_WAIT_L(8); PG8_BAR; PG8_WAIT_L(0); PG8_MMA(0, 0, At, B0); PG8_BAR; PG8_SCHED;
            PG8_LDB(B1, 0, 1); PG8_STAGE(PG8_SB(0, 0), b2, voffB);
            PG8_BAR; PG8_WAIT_L(0); PG8_MMA(0, 1, At, B1); PG8_BAR;
            PG8_LDA(At, 0, 1); PG8_STAGE(PG8_SA(0, 0), a2, voffA);
            PG8_BAR; PG8_WAIT_L(0); PG8_MMA(1, 0, At, B0); PG8_BAR; PG8_SCHED;
            PG8_STAGE(PG8_SB(0, 1), b2 + hstep, voffB);
            PG8_WAIT_V(6); PG8_BAR; PG8_MMA(1, 1, At, B1); PG8_BAR;
            PG8_LDB(B0, 1, 0); PG8_SCHED; PG8_LDA(At, 1, 0); PG8_STAGE(PG8_SA(0, 1), a2 + hstep, voffA);
            PG8_WAIT_L(8); PG8_BAR; PG8_WAIT_L(0); PG8_MMA(0, 0, At, B0); PG8_BAR; PG8_SCHED;
            PG8_LDB(B1, 1, 1); PG8_STAGE(PG8_SB(1, 0), b3, voffB);
            PG8_BAR; PG8_WAIT_L(0); PG8_MMA(0, 1, At, B1); PG8_BAR;
            PG8_LDA(At, 1, 1); PG8_STAGE(PG8_SA(1, 0), a3, voffA);
            PG8_BAR; PG8_WAIT_L(0); PG8_MMA(1, 0, At, B0); PG8_BAR; PG8_SCHED;
            PG8_STAGE(PG8_SB(1, 1), b3 + hstep, voffB);
            PG8_WAIT_V(6); PG8_BAR; PG8_MMA(1, 1, At, B1); PG8_BAR;
            }
        }
        if constexpr (ALIGN_EPI) { if (wr == 0) PG8_BAR; }
        if constexpr (!Epi::AFTER_DRAIN) { E(acc, cur, wr, wc, fr, fq); S.done(cur); }
        if (!has_next) break;
#pragma unroll
        for (int a = 0; a < 2; ++a)
#pragma unroll
            for (int b = 0; b < 2; ++b)
#pragma unroll
                for (int m = 0; m < 4; ++m)
#pragma unroll
                    for (int n = 0; n < 2; ++n) acc[a][b][m][n] = (f32x4){0.f, 0.f, 0.f, 0.f};
        cur = nxt; cA = nA; cB = nB; ++ui;
        if constexpr (ALIGN_EPI) { if (wr == 1) PG8_BAR; }
    }
    PG8_WAIT_V(0);
    if constexpr (!ALIGN_EPI) { if (wr == 0) PG8_BAR; }
    PG8_BAR;
    if constexpr (Epi::AFTER_DRAIN) { E.fused(acc, cur, wr, wc, fr, fq, lds, wid, lane); S.done(cur); }
#undef PG8_SA
#undef PG8_SB
#undef PG8_STAGE
#undef PG8_LDA
#undef PG8_LDB
#undef PG8_MMA
#undef PG8_WAIT_V
#undef PG8_WAIT_L
#undef PG8_BAR
#undef PG8_SCHED
}
}
#define LAS __attribute__((address_space(3)))
#define DI __device__ __forceinline__
typedef unsigned short bf16;
typedef float f32x4 __attribute__((ext_vector_type(4)));
typedef float f32x16 __attribute__((ext_vector_type(16)));
typedef float f32x2 __attribute__((ext_vector_type(2)));
typedef unsigned u32x4 __attribute__((ext_vector_type(4)));
typedef unsigned u32x2 __attribute__((ext_vector_type(2)));
typedef short bf16x8 __attribute__((ext_vector_type(8)));
typedef short s16x4 __attribute__((ext_vector_type(4)));
typedef __bf16 bf16x2_t __attribute__((ext_vector_type(2)));

constexpr int NTHR = 512;
constexpr int DM = 1024, MPR = 16384, MVALID = 16512, MPAD = 16640, NZ = 3584, DIN = 3592, DFF = 2816, NU = 5632;
constexpr int SEQ = 8192;
constexpr float EPS = 1e-6f;
constexpr int LDS_BYTES = 147456 + 64;
constexpr size_t MiB = 1u << 20;
constexpr size_t WS_IG = 0, WS_LF = 512 * 1024, WS_BL = 1 * MiB, WS_AC = 1 * MiB + 8192, WS_MPREV = 1 * MiB + 16384, WS_NC = 2 * MiB, WS_NPREV = 3 * MiB;
constexpr size_t WS_BAR = 3 * MiB + 768 * 1024;
constexpr size_t WS_WIN = 4 * MiB, WS_WOUT = 11 * MiB + 512 * 1024, WS_WUP = 13 * MiB + 512 * 1024, WS_WDN = 24 * MiB + 512 * 1024;
constexpr size_t WS_ACT = 30 * MiB;
constexpr size_t WS_KC = 244 * MiB, WS_VC = 248 * MiB;
constexpr size_t WS_X16 = 63 * MiB;
constexpr size_t WS_R = 96 * MiB;
constexpr size_t WS_Z = WS_R, WS_SC = 210 * MiB;
constexpr size_t WS_MIX = WS_R;
constexpr size_t WS_UQ = WS_R, WS_G = 141 * MiB;
constexpr size_t WS_FFN = WS_R;
constexpr size_t WS_END = 256 * MiB;
static_assert(WS_Z + (size_t)MPAD * NZ * 2 <= WS_SC && WS_SC + (size_t)1056 * 32768 <= WS_KC && WS_X16 + (size_t)MVALID * DM * 2 <= WS_R, "ws stage 1");
static_assert(WS_UQ + (size_t)(MPAD / 4) * NU * 2 <= WS_G && WS_G + (size_t)MPAD * DFF * 2 <= WS_KC, "ws stage 3");
static_assert(WS_ACT + (size_t)MPAD * DM * 2 <= WS_X16 && WS_WDN + (size_t)DM * DFF * 2 <= WS_ACT, "ws fixed");
constexpr size_t O_X = 0, O_KP = 16908288, O_VP = O_KP + 1048576, O_CP = O_VP + 1048576, O_NP = O_CP + 262144, O_MP = O_NP + 2048, O_FP = O_MP + 16,
                 O_KS = O_FP + 45056, O_VS = O_KS + 131072, O_CS = O_VS + 131072, O_NS = O_CS + 1048576, O_MS = O_NS + 8192, O_FS = O_MS + 64, O_END = O_FS + 180224;

DI unsigned pk2(float lo, float hi) { f32x2 v = {lo, hi}; bf16x2_t b = __builtin_convertvector(v, bf16x2_t); return __builtin_bit_cast(unsigned, b); }
DI float bf2f(unsigned short b) { return __uint_as_float((unsigned)b << 16); }
DI float bflo(unsigned w) { return __uint_as_float(w << 16); }
DI float bfhi(unsigned w) { return __uint_as_float(w & 0xffff0000u); }
DI float wave_sum(float v) {
#pragma unroll
    for (int o = 1; o < 64; o <<= 1) v += __shfl_xor(v, o);
    return v;
}
DI float wave_max(float v) {
#pragma unroll
    for (int o = 1; o < 64; o <<= 1) v = fmaxf(v, __shfl_xor(v, o));
    return v;
}
#define MFMA32(a, b, c) __builtin_amdgcn_mfma_f32_32x32x16_bf16((a), (b), (c), 0, 0, 0)
DI s16x4 vtr(const LAS char* p) { return __builtin_bit_cast(s16x4, __builtin_amdgcn_ds_read_tr16_b64_v4i16((LAS s16x4*)p)); }
DI bf16x8 vtr2(const LAS char* p, int rows4_bytes) { s16x4 lo = vtr(p), hi = vtr(p + rows4_bytes); return __builtin_shufflevector(lo, hi, 0, 1, 2, 3, 4, 5, 6, 7); }
DI int crow(int i, int h) { return (i & 3) + 8 * (i >> 2) + 4 * h; }
DI bf16x8 pack8(const f32x16& x, int s) {
    u32x4 p; p.x = pk2(x[8 * s], x[8 * s + 1]); p.y = pk2(x[8 * s + 2], x[8 * s + 3]); p.z = pk2(x[8 * s + 4], x[8 * s + 5]); p.w = pk2(x[8 * s + 6], x[8 * s + 7]);
    return __builtin_bit_cast(bf16x8, p);
}
DI f32x16 zero16() { f32x16 z;
#pragma unroll
    for (int i = 0; i < 16; ++i) z[i] = 0.f; return z; }
#define LDS_FENCE() asm volatile("s_waitcnt lgkmcnt(0)" ::: "memory")

struct Args { const float* in[20]; float* out; unsigned char* ws; };
typedef const __attribute__((address_space(4))) Args* ArgsP;
DI ArgsP get_args() { ArgsP p = (ArgsP)__builtin_amdgcn_kernarg_segment_ptr(); asm volatile("" : "+s"(p)); return p; }
DI int get_bid() { int b = blockIdx.x; asm volatile("" : "+s"(b)); return b; }
DI int get_nb() { int b = gridDim.x; asm volatile("" : "+s"(b)); return b; }
DI int get_tid() { int t = threadIdx.x; asm volatile("" : "+v"(t)); return t; }

DI void transpose_item(const float* W, int ldw, int K, int nblk, bf16* WT, LAS float* scr, int item, int lane, bool perm_up = false, int cmax = (1 << 30)) {
    const int kb = item / nblk, nb = item % nblk, k0 = 64 * kb, n0 = 32 * nb;
    const int r0 = !perm_up ? n0 : (n0 < DFF ? 256 * (n0 >> 7) + (n0 & 127) : 256 * ((n0 - DFF) >> 7) + 128 + ((n0 - DFF) & 127));
    { int col0 = n0 + (lane & 7) * 4; col0 = col0 + 3 <= cmax ? col0 : cmax - 3;
      f32x4 v[8];
#pragma unroll
      for (int i = 0; i < 8; ++i) v[i] = __builtin_nontemporal_load((const f32x4*)(W + (size_t)(k0 + 8 * i + (lane >> 3)) * ldw + col0));
#pragma unroll
      for (int i = 0; i < 8; ++i) { const int kk = 8 * i + (lane >> 3); LAS float* d = scr + kk * 33 + (lane & 7) * 4; d[0] = v[i].x; d[1] = v[i].y; d[2] = v[i].z; d[3] = v[i].w; } }
    LDS_FENCE();
    const int c = lane & 7;
#pragma unroll
    for (int j = 0; j < 4; ++j) { const int n = (lane >> 3) + 8 * j; const LAS float* s = scr + (8 * c) * 33 + n;
        u32x4 o; o.x = pk2(s[0 * 33], s[1 * 33]); o.y = pk2(s[2 * 33], s[3 * 33]); o.z = pk2(s[4 * 33], s[5 * 33]); o.w = pk2(s[6 * 33], s[7 * 33]);
        *(u32x4*)(WT + (size_t)(r0 + n) * K + k0 + 8 * c) = o; }
    LDS_FENCE();
}
DI void phase_convert(int l, LAS unsigned char* lds) {
    const ArgsP a = get_args(); const int tid = get_tid(), lane = tid & 63, wave = tid >> 6;
    LAS float* scr = (LAS float*)(lds + wave * 8448);
    const int gw = get_bid() * 8 + wave, NGW = get_nb() * 8;
    constexpr int I_IN = 16 * 113, I_OUT = 16 * 32, I_UP = 16 * 176, I_DN = 44 * 32;
    const float* win = a->in[9] + (size_t)l * DM * DIN; const float* wout = a->in[15] + (size_t)l * DM * DM;
    const float* wup = a->in[16] + (size_t)l * DM * NU; const float* wdn = a->in[19] + (size_t)l * DFF * DM;
    for (int it = gw; it < I_IN + I_OUT + I_UP + I_DN; it += NGW) {
        int r = it;
        if (r < I_IN) { transpose_item(win, DIN, DM, 113, (bf16*)(a->ws + WS_WIN), scr, r, lane, false, DIN - 1); continue; } r -= I_IN;
        if (r < I_OUT) { transpose_item(wout, DM, DM, 32, (bf16*)(a->ws + WS_WOUT), scr, r, lane); continue; } r -= I_OUT;
        if (r < I_UP) { transpose_item(wup, NU, DM, 176, (bf16*)(a->ws + WS_WUP), scr, r, lane, true); continue; } r -= I_UP;
        transpose_item(wdn, DM, DFF, 32, (bf16*)(a->ws + WS_WDN), scr, r, lane);
    }
    {   const int gt0 = get_bid() * NTHR + tid, gstep = get_nb() * NTHR;
        for (int it0 = gt0; it0 < 2 * 262144; it0 += 4 * gstep) {
            f32x4 x0[4], x1[4];
#pragma unroll
            for (int k = 0; k < 4; ++k) { const int it = it0 + k * gstep; if (it < 2 * 262144) { const int kv = it >> 18, e = (it & 262143) * 8; const float* src = a->in[2 + kv] + (size_t)l * 2097152 + e; x0[k] = __builtin_nontemporal_load((const f32x4*)src); x1[k] = __builtin_nontemporal_load((const f32x4*)(src + 4)); } }
#pragma unroll
            for (int k = 0; k < 4; ++k) { const int it = it0 + k * gstep; if (it < 2 * 262144) { const int kv = it >> 18, e = (it & 262143) * 8;
                u32x4 w; w.x = pk2(x0[k].x, x0[k].y); w.y = pk2(x0[k].z, x0[k].w); w.z = pk2(x1[k].x, x1[k].y); w.w = pk2(x1[k].z, x1[k].w);
                *(u32x4*)((bf16*)(a->ws + (kv ? WS_VC : WS_KC)) + e) = w; } }
        } }
}

DI void phase_rows(LAS unsigned char* lds, bool first, const bf16* addsrc, const float* gadd, const float* gn, int gate_layer  , bool final) {
    const ArgsP a = get_args(); const int tid = get_tid(), lane = tid & 63, wave = tid >> 6;
    float* Y = a->out; bf16* X16 = (bf16*)(a->ws + WS_X16); bf16* ACT = (bf16*)(a->ws + WS_ACT);
    const int gw = get_bid() * 8 + wave, NGW = get_nb() * 8;
    float ga[16], gb[16];
#pragma unroll
    for (int j = 0; j < 2; ++j)
#pragma unroll
        for (int k = 0; k < 8; ++k) { ga[8 * j + k] = addsrc ? gadd[8 * lane + 512 * j + k] : 0.f; gb[8 * j + k] = gn ? gn[8 * lane + 512 * j + k] : 0.f; }
#define ROWS_LOAD(MM, VV, XX, FF) do { const int mm_ = (MM); \
        if (first) { const float* xr_ = mm_ < MPR ? a->in[0] + (size_t)mm_ * DM : a->in[1] + (size_t)(mm_ - MPR) * DM; \
            _Pragma("unroll") for (int j = 0; j < 2; ++j) { VV[2 * j] = __builtin_nontemporal_load((const f32x4*)(xr_ + 8 * lane + 512 * j)); VV[2 * j + 1] = __builtin_nontemporal_load((const f32x4*)(xr_ + 8 * lane + 512 * j + 4)); } } \
        else { _Pragma("unroll") for (int j = 0; j < 2; ++j) XX[j] = *(const u32x4*)(X16 + (size_t)mm_ * DM + 8 * lane + 512 * j); } \
        if (addsrc) { _Pragma("unroll") for (int j = 0; j < 2; ++j) FF[j] = *(const u32x4*)(addsrc + (size_t)mm_ * DM + 8 * lane + 512 * j); } } while (0)
    f32x4 vn[4], vn2[4]; u32x4 xn[2], fn[2], xn2[2], fn2[2];
#pragma unroll
    for (int j = 0; j < 4; ++j) { vn[j] = (f32x4){0.f, 0.f, 0.f, 0.f}; vn2[j] = vn[j]; }
#pragma unroll
    for (int j = 0; j < 2; ++j) { xn[j] = (u32x4){0u, 0u, 0u, 0u}; fn[j] = xn[j]; xn2[j] = xn[j]; fn2[j] = xn[j]; }
    if (gw < MVALID) ROWS_LOAD(gw, vn, xn, fn);
    if (gw + NGW < MVALID) ROWS_LOAD(gw + NGW, vn2, xn2, fn2);
    for (int m = gw; m < MVALID; m += NGW) {
        float v[16], f[16];
#pragma unroll
        for (int j = 0; j < 2; ++j) {
            if (first) {
#pragma unroll
                for (int k = 0; k < 4; ++k) { v[8 * j + k] = vn[2 * j][k]; v[8 * j + 4 + k] = vn[2 * j + 1][k]; }
            } else { v[8 * j] = bflo(xn[j].x); v[8 * j + 1] = bfhi(xn[j].x); v[8 * j + 2] = bflo(xn[j].y); v[8 * j + 3] = bfhi(xn[j].y); v[8 * j + 4] = bflo(xn[j].z); v[8 * j + 5] = bfhi(xn[j].z); v[8 * j + 6] = bflo(xn[j].w); v[8 * j + 7] = bfhi(xn[j].w); }
            f[8 * j] = bflo(fn[j].x); f[8 * j + 1] = bfhi(fn[j].x); f[8 * j + 2] = bflo(fn[j].y); f[8 * j + 3] = bfhi(fn[j].y); f[8 * j + 4] = bflo(fn[j].z); f[8 * j + 5] = bfhi(fn[j].z); f[8 * j + 6] = bflo(fn[j].w); f[8 * j + 7] = bfhi(fn[j].w);
        }
#pragma unroll
        for (int j = 0; j < 4; ++j) vn[j] = vn2[j];
#pragma unroll
        for (int j = 0; j < 2; ++j) { xn[j] = xn2[j]; fn[j] = fn2[j]; }
        if (m + 2 * NGW < MVALID) ROWS_LOAD(m + 2 * NGW, vn2, xn2, fn2);
        if (addsrc) {
            float s = 0.f;
#pragma unroll
            for (int k = 0; k < 16; ++k) s += f[k] * f[k];
            const float r = 1.0f / sqrtf(wave_sum(s) * (1.f / DM) + EPS);
#pragma unroll
            for (int k = 0; k < 16; ++k) v[k] = v[k] + f[k] * r * ga[k];
#pragma unroll
            for (int j = 0; j < 2; ++j) {
                if (final) { float* yp = Y + (size_t)m * DM + 8 * lane + 512 * j; __builtin_nontemporal_store((f32x4){v[8 * j], v[8 * j + 1], v[8 * j + 2], v[8 * j + 3]}, (f32x4*)yp); __builtin_nontemporal_store((f32x4){v[8 * j + 4], v[8 * j + 5], v[8 * j + 6], v[8 * j + 7]}, (f32x4*)(yp + 4)); }
                else { u32x4 o; o.x = pk2(v[8 * j], v[8 * j + 1]); o.y = pk2(v[8 * j + 2], v[8 * j + 3]); o.z = pk2(v[8 * j + 4], v[8 * j + 5]); o.w = pk2(v[8 * j + 6], v[8 * j + 7]); *(u32x4*)(X16 + (size_t)m * DM + 8 * lane + 512 * j) = o; } }
        }
        if (first && !addsrc) {
#pragma unroll
            for (int j = 0; j < 2; ++j) { u32x4 o; o.x = pk2(v[8 * j], v[8 * j + 1]); o.y = pk2(v[8 * j + 2], v[8 * j + 3]); o.z = pk2(v[8 * j + 4], v[8 * j + 5]); o.w = pk2(v[8 * j + 6], v[8 * j + 7]); *(u32x4*)(X16 + (size_t)m * DM + 8 * lane + 512 * j) = o; }
        }
        if (gn) {
            float s = 0.f;
#pragma unroll
            for (int k = 0; k < 16; ++k) s += v[k] * v[k];
            const float r = 1.0f / sqrtf(wave_sum(s) * (1.f / DM) + EPS);
#pragma unroll
            for (int j = 0; j < 2; ++j) { u32x4 o;
                o.x = pk2(v[8 * j] * r * gb[8 * j], v[8 * j + 1] * r * gb[8 * j + 1]); o.y = pk2(v[8 * j + 2] * r * gb[8 * j + 2], v[8 * j + 3] * r * gb[8 * j + 3]);
                o.z = pk2(v[8 * j + 4] * r * gb[8 * j + 4], v[8 * j + 5] * r * gb[8 * j + 5]); o.w = pk2(v[8 * j + 6] * r * gb[8 * j + 6], v[8 * j + 7] * r * gb[8 * j + 7]);
                *(u32x4*)(ACT + (size_t)m * DM + 8 * lane + 512 * j) = o; }
        }
    }
#undef ROWS_LOAD
}

DI void mini_gemm(LAS unsigned char* lds, const bf16* A, const bf16* Bt, int K, bf16* O) {
    const int tid = get_tid(), lane = tid & 63, wave = tid >> 6, fr = lane & 15, fq = lane >> 4;
    LAS float* red = (LAS float*)lds;
    const int ksl = K >> 3, k0 = wave * ksl, nks = ksl >> 5;
    for (int unit = get_bid(); unit < 256; unit += get_nb()) {
        const int rt = unit >> 5, ct = unit & 31;
        const bf16* ap = A + (size_t)(rt * 16 + fr) * K + k0 + 8 * fq;
        const bf16* bp0 = Bt + (size_t)(ct * 32 + fr) * K + k0 + 8 * fq; const bf16* bp1 = bp0 + (size_t)16 * K;
        f32x4 acc0 = {0.f, 0.f, 0.f, 0.f}, acc1 = {0.f, 0.f, 0.f, 0.f};
#pragma unroll 4
        for (int ks = 0; ks < nks; ++ks) { const bf16x8 av = *(const bf16x8*)(ap + 32 * ks), b0 = *(const bf16x8*)(bp0 + 32 * ks), b1 = *(const bf16x8*)(bp1 + 32 * ks);
            acc0 = __builtin_amdgcn_mfma_f32_16x16x32_bf16(av, b0, acc0, 0, 0, 0); acc1 = __builtin_amdgcn_mfma_f32_16x16x32_bf16(av, b1, acc1, 0, 0, 0); }
#pragma unroll
        for (int j = 0; j < 4; ++j) { red[(wave * 2 + 0) * 256 + j * 64 + lane] = acc0[j]; red[(wave * 2 + 1) * 256 + j * 64 + lane] = acc1[j]; }
        __syncthreads();
        { const int n = tid >> 8, idx = tid & 255, j = idx >> 6, ln = idx & 63; float s = 0.f;
#pragma unroll
          for (int w = 0; w < 8; ++w) s += red[(w * 2 + n) * 256 + idx];
          O[(size_t)(rt * 16 + 4 * (ln >> 4) + j) * DM + ct * 32 + 16 * n + (ln & 15)] = (bf16)(pk2(s, 0.f) & 0xffffu); }
        __syncthreads();
    }
}

constexpr int VP = 144;
DI void attn_step(const bf16x8 (&kf)[4], const bf16x8 (&qf)[4], f32x16 (&O)[2], float& mrun, float& lrun, const LAS float* tab, float bias_far, bool nearb, int dq  , int maskfrom  ,
                  const LAS char* vs, int kb, int h, int q4, int p4, int blk) {
    bf16x8 vf0[2], vf1[2];
#pragma unroll
    for (int dt = 0; dt < 2; ++dt) {
        vf0[dt] = vtr2(vs + (kb + 4 * h + q4) * VP + 2 * (32 * dt + 16 * blk) + 8 * p4, 8 * VP);
        vf1[dt] = vtr2(vs + (kb + 16 + 4 * h + q4) * VP + 2 * (32 * dt + 16 * blk) + 8 * p4, 8 * VP); }
    f32x16 S = zero16();
#pragma unroll
    for (int s = 0; s < 4; ++s) S = MFMA32(kf[s], qf[s], S);
    if (nearb) {
#pragma unroll
        for (int i = 0; i < 16; ++i) { int d = dq - ((i & 3) + 8 * (i >> 2)); d = d > 256 ? 256 : d; S[i] += tab[d + 63]; }
    } else {
#pragma unroll
        for (int i = 0; i < 16; ++i) S[i] += bias_far;
    }
    if (maskfrom < 64) {
#pragma unroll
        for (int i = 0; i < 16; ++i) if ((i & 3) + 8 * (i >> 2) + 4 * h >= maskfrom) S[i] = -1e30f;
    }
    float mx = S[0];
#pragma unroll
    for (int i = 1; i < 16; ++i) mx = fmaxf(mx, S[i]);
    mx = fmaxf(mx, __shfl_xor(mx, 32));
    const float mnew = fmaxf(mrun, mx), alpha = __builtin_amdgcn_exp2f(mrun - mnew);
    float rs = 0.f;
#pragma unroll
    for (int i = 0; i < 16; ++i) { S[i] = __builtin_amdgcn_exp2f(S[i] - mnew); rs += S[i]; }
    lrun = lrun * alpha + rs;
    if (__builtin_amdgcn_ballot_w64(mnew > mrun)) { O[0] *= alpha; O[1] *= alpha; }
    mrun = mnew;
    const bf16x8 pf0 = pack8(S, 0), pf1 = pack8(S, 1);
#pragma unroll
    for (int dt = 0; dt < 2; ++dt) { O[dt] = MFMA32(vf0[dt], pf0, O[dt]); O[dt] = MFMA32(vf1[dt], pf1, O[dt]); }
}
template <bool SAMPLE>
DI void attn_unit(int l, int bb, int c, int qhalf, LAS unsigned char* lds) {
    const ArgsP a = get_args(); const int tid = get_tid(), lane = tid & 63, hd = tid >> 6, r = lane & 31, h = lane >> 5;
    const int i16 = lane & 15, q4 = i16 >> 2, p4 = i16 & 3, blk = (lane >> 4) & 1;
    const bf16* Z = (const bf16*)(a->ws + WS_Z); bf16* ACT = (bf16*)(a->ws + WS_ACT);
    LAS char* vs = (LAS char*)(lds + hd * 9216);
    const LAS float* tab = (const LAS float*)(lds + 73728 + hd * 1280);
    LAS float* xs = (LAS float*)(lds + 73728 + 10240);
    const int qrow0 = SAMPLE ? MPR + bb * 16 : bb * SEQ + c * 64;
    const bf16* kc16 = (const bf16*)(a->ws + WS_KC) + (size_t)(bb * 8 + hd) * 512 * 64;
    const bf16* vc16 = (const bf16*)(a->ws + WS_VC) + (size_t)(bb * 8 + hd) * 512 * 64;
    bf16x8 qf[4];
    { const int qr = SAMPLE ? (r < 16 ? r : 15) : 32 * qhalf + r;
#pragma unroll
      for (int s = 0; s < 4; ++s) qf[s] = *(const bf16x8*)(Z + (size_t)(qrow0 + qr) * NZ + hd * 64 + 16 * s + 8 * h); }
    f32x16 O[2]; O[0] = zero16(); O[1] = zero16(); float mrun = -1e30f, lrun = 0.f;
    const float bias_far = tab[319];
    const int q = 32 * qhalf + r;
    const int jstart = SAMPLE ? 0 : (c >= 8 ? 0 : 8 - c);
#define ATT_SRC(J) const bf16* kb_; const bf16* vb_; int pitch_, rmax_; \
    if (SAMPLE && (J) < 8) { kb_ = kc16 + (size_t)(64 * (J)) * 64; vb_ = vc16 + (size_t)(64 * (J)) * 64; pitch_ = 64; rmax_ = 63; } \
    else if (SAMPLE) { kb_ = Z + (size_t)qrow0 * NZ + 512 + hd * 64; vb_ = kb_ + 512; pitch_ = NZ; rmax_ = 15; } \
    else { kb_ = Z + (size_t)(bb * SEQ + (c + (J) - 8) * 64) * NZ + 512 + hd * 64; vb_ = kb_ + 512; pitch_ = NZ; rmax_ = 63; }
#define ATT_LOADK(J, KS, KF) do { ATT_SRC(J) int kr_ = 32 * (KS) + r; kr_ = kr_ > rmax_ ? rmax_ : kr_; (void)vb_; \
    _Pragma("unroll") for (int s = 0; s < 4; ++s) KF[s] = *(const bf16x8*)(kb_ + (size_t)kr_ * pitch_ + 16 * s + 8 * h); } while (0)
#define ATT_LOADV(J, VR) do { ATT_SRC(J) (void)kb_; \
    _Pragma("unroll") for (int it = 0; it < 8; ++it) { int key_ = it * 8 + (lane >> 3); key_ = key_ > rmax_ ? rmax_ : key_; VR[it] = *(const u32x4*)(vb_ + (size_t)key_ * pitch_ + (lane & 7) * 8); } } while (0)
    bf16x8 kA[4], kB[4]; u32x4 vr[8];
    ATT_LOADK(jstart, 0, kA);
    ATT_LOADV(jstart, vr);
#pragma unroll 1
    for (int j = jstart; j < 9; ++j) {
        LDS_FENCE();
#pragma unroll
        for (int it = 0; it < 8; ++it) *(LAS u32x4*)(vs + (it * 8 + (lane >> 3)) * VP + (lane & 7) * 16) = vr[it];
        if (j < 8) ATT_LOADV(j + 1, vr);
        ATT_LOADK(j, 1, kB);
        LDS_FENCE();
        const bool nearb = j >= 4; const int mf = (SAMPLE && j == 8) ? 16 : 64;
        attn_step(kA, qf, O, mrun, lrun, tab, bias_far, nearb, 512 + q - (64 * j + 4 * h), mf, vs, 0, h, q4, p4, blk);
        if (j < 8) ATT_LOADK(j + 1, 0, kA);
        if (!(SAMPLE && j == 8)) attn_step(kB, qf, O, mrun, lrun, tab, bias_far, nearb, 512 + q - (64 * j + 32 + 4 * h), 64, vs, 32, h, q4, p4, blk);
    }
#undef ATT_SRC
#undef ATT_LOADK
#undef ATT_LOADV
    const float lt = lrun + __shfl_xor(lrun, 32); const float inv = 1.0f / lt; float ssq = 0.f;
#pragma unroll
    for (int dt = 0; dt < 2; ++dt) { O[dt] *= inv;
#pragma unroll
        for (int i = 0; i < 16; ++i) ssq += O[dt][i] * O[dt][i]; }
    ssq += __shfl_xor(ssq, 32);
    if (h == 0) xs[hd * 64 + 32 * qhalf + r] = ssq;
    __syncthreads();
    const float* gatt = a->in[13] + l * 512 + hd * 64;
    float tot = 0.f;
#pragma unroll
    for (int w = 0; w < 8; ++w) tot += xs[w * 64 + 32 * qhalf + r];
    const float rr = 1.0f / sqrtf(tot * (1.f / 512.f) + EPS);
    const bool ok = SAMPLE ? (r < 16) : true;
    bf16* orow = ACT + (size_t)(qrow0 + 32 * qhalf + r) * DM + hd * 64;
    if (ok) {
#pragma unroll
        for (int dt = 0; dt < 2; ++dt)
#pragma unroll
            for (int g = 0; g < 4; ++g) { const int e0 = 32 * dt + 8 * g + 4 * h; const f32x4 gv = *(const f32x4*)(gatt + e0);
                u32x2 o; o.x = pk2(O[dt][4 * g] * rr * gv.x, O[dt][4 * g + 1] * rr * gv.y); o.y = pk2(O[dt][4 * g + 2] * rr * gv.z, O[dt][4 * g + 3] * rr * gv.w);
                *(u32x2*)(orow + e0) = o; }
    }
    __syncthreads();
}

constexpr int MPB = 288;
DI void m1_item(bool sample, int bb, int c, LAS unsigned char* lds, int hp = -1  ) {
    const ArgsP a = get_args(); const int tid = get_tid(), lane = tid & 63, wave = tid >> 6, head = wave >> 1, half = wave & 1, r = lane & 31, h = lane >> 5;
    const int i16 = lane & 15, q4 = i16 >> 2, p4 = i16 & 3, blk = (lane >> 4) & 1;
    const bf16* Z = (const bf16*)(a->ws + WS_Z); const float* IG = (const float*)(a->ws + WS_IG); const float* LF = (const float*)(a->ws + WS_LF);
    bf16* SC = (bf16*)(a->ws + WS_SC);
    const int row0 = sample ? MPR + bb * 16 : bb * SEQ + c * 64;
    const int u = sample ? 1024 + bb * 4 + head : (bb * 4 + head) * 128 + c;
    const bool act = (hp < 0) || ((head >> 1) == hp);
    u32x4 st16[16];
#pragma unroll
    for (int it = 0; it < 16; ++it) { const int rr = it * 4 + (lane >> 4), ch = lane & 15; const int srow = row0 + (sample ? (rr < 16 ? rr : 15) : rr);
        st16[it] = *(const u32x4*)(Z + (size_t)srow * NZ + (half == 0 ? 2048 : 2560) + head * 128 + ch * 8); }
    const bool valid = sample ? (lane < 16) : true;
    const int rs = row0 + (sample ? (lane < 16 ? lane : 15) : lane);
    float b = valid ? LF[(size_t)rs * 4 + head] : 0.f; const float ig = valid ? IG[(size_t)rs * 4 + head] : -INFINITY;
#pragma unroll
    for (int o = 1; o < 64; o <<= 1) { const float t = __shfl_up(b, o); if (lane >= o) b += t; }
    const float av = ig - b; const float ac = wave_max(av); const float w = __expf(av - ac); const float bl = __shfl(b, 63);
    if (act && half == 0 && lane == 0) { ((float*)(a->ws + WS_BL))[u] = bl; ((float*)(a->ws + WS_AC))[u] = ac; }
    LAS char* kbase = (LAS char*)(lds + head * 36864); LAS char* vbase = kbase + 18432;
#pragma unroll
    for (int it = 0; it < 16; ++it) { const int rr = it * 4 + (lane >> 4), ch = lane & 15;
        const float wr = __shfl(w, rr); const u32x4 x = st16[it];
        if (half == 0) { u32x4 o;
            o.x = pk2(bflo(x.x) * wr, bfhi(x.x) * wr); o.y = pk2(bflo(x.y) * wr, bfhi(x.y) * wr); o.z = pk2(bflo(x.z) * wr, bfhi(x.z) * wr); o.w = pk2(bflo(x.w) * wr, bfhi(x.w) * wr);
            *(LAS u32x4*)(kbase + rr * MPB + ch * 16) = o; }
        else *(LAS u32x4*)(vbase + rr * MPB + ch * 16) = x;
    }
    __syncthreads();
    if (act) {
#pragma unroll
    for (int dh = 0; dh < 2; ++dh) {
        f32x16 acc[2][2];
#pragma unroll
        for (int di = 0; di < 2; ++di) { acc[di][0] = zero16(); acc[di][1] = zero16(); }
#pragma unroll
        for (int ks = 0; ks < 4; ++ks) {
            bf16x8 af[2], bfr[2];
#pragma unroll
            for (int di = 0; di < 2; ++di) af[di] = vtr2(kbase + (16 * ks + 8 * h + q4) * MPB + 2 * (32 * (2 * dh + di) + 16 * blk) + 8 * p4, 4 * MPB);
#pragma unroll
            for (int ei = 0; ei < 2; ++ei) bfr[ei] = vtr2(vbase + (16 * ks + 8 * h + q4) * MPB + 2 * (32 * (2 * half + ei) + 16 * blk) + 8 * p4, 4 * MPB);
#pragma unroll
            for (int di = 0; di < 2; ++di)
#pragma unroll
                for (int ei = 0; ei < 2; ++ei) acc[di][ei] = MFMA32(af[di], bfr[ei], acc[di][ei]);
        }
#pragma unroll
        for (int di = 0; di < 2; ++di)
#pragma unroll
            for (int ei = 0; ei < 2; ++ei)
#pragma unroll
                for (int g = 0; g < 4; ++g) { const int e = 32 * (2 * half + ei) + r, d0 = 32 * (2 * dh + di) + 8 * g + 4 * h;
                    u32x2 o; o.x = pk2(acc[di][ei][4 * g], acc[di][ei][4 * g + 1]); o.y = pk2(acc[di][ei][4 * g + 2], acc[di][ei][4 * g + 3]);
                    *(u32x2*)(SC + (size_t)u * 16384 + e * 128 + d0) = o; }
    }
    { const int d = half * 64 + lane; float s = 0.f;
#pragma unroll 8
      for (int sidx = 0; sidx < 64; ++sidx) s += bf2f(*(const LAS unsigned short*)(kbase + sidx * MPB + d * 2));
      ((float*)(a->ws + WS_NC))[(size_t)u * 128 + d] = s; }
    }
    __syncthreads();
}

DI void phase_c_pre(int l) {
    const ArgsP a = get_args(); const int tid = get_tid();
    const bf16* Z = (const bf16*)(a->ws + WS_Z);
    for (int it = get_bid() * NTHR + tid; it < 147456; it += get_nb() * NTHR) {
        int row, kv, cc; float* dst;
        if (it < 131072) { const int b = it >> 16, t = (it >> 7) & 511; kv = (it >> 6) & 1; cc = it & 63; row = b * SEQ + (SEQ - 512) + t;
            dst = a->out + (kv ? O_VP : O_KP) + ((size_t)((l * 2 + b) * 8 + (cc >> 3)) * 512 + t) * 64 + (cc & 7) * 8; }
        else { const int i2 = it - 131072; const int rr = i2 >> 7; kv = (i2 >> 6) & 1; cc = i2 & 63; row = MPR + rr; const int sb = rr >> 4, t = rr & 15;
            dst = a->out + (kv ? O_VS : O_KS) + ((size_t)((l * 8 + sb) * 8 + (cc >> 3)) * 16 + t) * 64 + (cc & 7) * 8; }
        const u32x4 x = *(const u32x4*)(Z + (size_t)row * NZ + 512 + kv * 512 + cc * 8);
        f32x4 o0 = {bflo(x.x), bfhi(x.x), bflo(x.y), bfhi(x.y)}, o1 = {bflo(x.z), bfhi(x.z), bflo(x.w), bfhi(x.w)};
        __builtin_nontemporal_store(o0, (f32x4*)dst); __builtin_nontemporal_store(o1, (f32x4*)(dst + 4));
    }
}

DI void phase_m2(int l, LAS unsigned char* lds) {
    const ArgsP a = get_args(); const int tid = get_tid(), lane = tid & 63;
    bf16* SC = (bf16*)(a->ws + WS_SC); const float* BL = (const float*)(a->ws + WS_BL); const float* AC = (const float*)(a->ws + WS_AC);
    float* MPREV = (float*)(a->ws + WS_MPREV); const float* NC = (const float*)(a->ws + WS_NC); float* NPREV = (float*)(a->ws + WS_NPREV);
    LAS float* DEC = (LAS float*)lds; LAS float* SCL = DEC + 128;
    const int NTH = get_nb() * NTHR;
    const int b0_ = get_bid(); const int vb_ = (get_nb() == 256) ? ((b0_ & 7) * 32 + (b0_ >> 3)) : b0_;
    for (int base = vb_ * NTHR; base < 8 * 16384; base += NTH) {
        const int bh = base >> 14, el = (base & 16383) + tid; const bool doN = el < 128;
        __syncthreads();
        if (tid < 64) {
            float Fc = 0.f, gc = 0.f;
#pragma unroll
            for (int rd = 0; rd < 2; ++rd) {
                const int c = rd * 64 + lane, u = bh * 128 + c; const float bl = BL[u], ac = AC[u];
                float F = bl;
#pragma unroll
                for (int o = 1; o < 64; o <<= 1) { const float t = __shfl_up(F, o); if (lane >= o) F += t; }
                F += Fc;
                float Fm1 = __shfl_up(F, 1); if (lane == 0) Fm1 = Fc;
                float g = ac - Fm1;
#pragma unroll
                for (int o = 1; o < 64; o <<= 1) { const float t = __shfl_up(g, o); if (lane >= o) g = fmaxf(g, t); }
                g = fmaxf(g, gc);
                float gm1 = __shfl_up(g, 1); if (lane == 0) gm1 = gc;
                const float mprev = Fm1 + gm1, mnew = F + g;
                DEC[c] = expf(bl + mprev - mnew); SCL[c] = expf(bl + ac - mnew);
                if ((base & 16383) == 0) { MPREV[u] = mprev; if (c == 127) a->out[O_MP + l * 8 + bh] = mnew; }
                Fc = __shfl(F, 63); gc = __shfl(g, 63);
            }
        }
        __syncthreads();
        float C = 0.f, n = 0.f;
#pragma unroll 1
        for (int c0 = 0; c0 < 128; c0 += 32) {
            float s[32];
#pragma unroll
            for (int k = 0; k < 32; ++k) s[k] = bf2f(SC[(size_t)(bh * 128 + c0 + k) * 16384 + el]);
            if (doN) {
                float nc[32];
#pragma unroll
                for (int k = 0; k < 32; ++k) nc[k] = NC[(size_t)(bh * 128 + c0 + k) * 128 + el];
#pragma unroll
                for (int k = 0; k < 32; ++k) { NPREV[(size_t)(bh * 128 + c0 + k) * 128 + el] = n; n = DEC[c0 + k] * n + SCL[c0 + k] * nc[k]; }
            }
#pragma unroll
            for (int k = 0; k < 32; ++k) { SC[(size_t)(bh * 128 + c0 + k) * 16384 + el] = (bf16)(pk2(C, 0.f) & 0xffffu); C = DEC[c0 + k] * C + SCL[c0 + k] * s[k]; }
        }
        const int e = el >> 7, d = el & 127;
        a->out[O_CP + (size_t)(l * 8 + bh) * 16384 + d * 128 + e] = C;
        if (doN) a->out[O_NP + (size_t)(l * 8 + bh) * 128 + el] = n;
    }
}

DI void m3_item(int l, bool sample, int bb, int c, LAS unsigned char* lds, int hp = -1) {
    const ArgsP a = get_args(); const int tid = get_tid(), lane = tid & 63, wave = tid >> 6, head = wave >> 1, tt = wave & 1, r = lane & 31, h = lane >> 5;
    const int i16 = lane & 15, q4 = i16 >> 2, p4 = i16 & 3, blk = (lane >> 4) & 1;
    const bf16* Z = (const bf16*)(a->ws + WS_Z); const float* IG = (const float*)(a->ws + WS_IG); const float* LF = (const float*)(a->ws + WS_LF);
    const bf16* SC = (const bf16*)(a->ws + WS_SC); bf16* ACT = (bf16*)(a->ws + WS_ACT);
    const int row0 = sample ? MPR + bb * 16 : bb * SEQ + c * 64;
    const int u = sample ? 1024 + bb * 4 + head : (bb * 4 + head) * 128 + c;
    LAS char* vbase = (LAS char*)(lds + head * 18432);
    LAS float* AS = (LAS float*)(lds + 73728) + head * 64; LAS float* BS = (LAS float*)(lds + 73728 + 1024) + head * 64;
    LAS float* MT = (LAS float*)(lds + 73728 + 2048) + head * 64; LAS float* NP = (LAS float*)(lds + 73728 + 3072) + head * 128;
    const float mprev = ((const float*)(a->ws + WS_MPREV))[u];
    {
        const bool valid = sample ? (lane < 16) : true;
        const int rs = row0 + (sample ? (lane < 16 ? lane : 15) : lane);
        float b = valid ? LF[(size_t)rs * 4 + head] : 0.f; const float ig = valid ? IG[(size_t)rs * 4 + head] : -INFINITY;
#pragma unroll
        for (int o = 1; o < 64; o <<= 1) { const float t = __shfl_up(b, o); if (lane >= o) b += t; }
        const float av = ig - b; float cm = av;
#pragma unroll
        for (int o = 1; o < 64; o <<= 1) { const float t = __shfl_up(cm, o); if (lane >= o) cm = fmaxf(cm, t); }
        const float mt = b + fmaxf(mprev, cm);
        if (tt == 0) { AS[lane] = av; BS[lane] = b; MT[lane] = mt; const float* np = (const float*)(a->ws + WS_NPREV) + (size_t)u * 128; NP[lane] = np[lane]; NP[64 + lane] = np[64 + lane]; }
    }
#pragma unroll
    for (int hb = 0; hb < 2; ++hb) {
        u32x4 vst[4];
#pragma unroll
        for (int it = 0; it < 4; ++it) { const int idx = (4 * hb + it) * 128 + tt * 64 + lane; const int rr = idx >> 4, ch = idx & 15; const int srow = row0 + (sample ? (rr < 16 ? rr : 15) : rr);
            vst[it] = *(const u32x4*)(Z + (size_t)srow * NZ + 2560 + head * 128 + ch * 8); }
#pragma unroll
        for (int it = 0; it < 4; ++it) { const int idx = (4 * hb + it) * 128 + tt * 64 + lane; const int rr = idx >> 4, ch = idx & 15; *(LAS u32x4*)(vbase + rr * MPB + ch * 16) = vst[it]; }
    }
    const int t = 32 * tt + r;
    const int rowt = row0 + (sample ? (t < 16 ? t : 15) : t);
    bf16x8 qf[8];
#pragma unroll
    for (int s = 0; s < 8; ++s) qf[s] = *(const bf16x8*)(Z + (size_t)rowt * NZ + 1536 + head * 128 + 16 * s + 8 * h);
    bf16x8 scf[2][8], kf0[8];
#pragma unroll
    for (int et = 0; et < 2; ++et)
#pragma unroll
        for (int s = 0; s < 8; ++s) scf[et][s] = *(const bf16x8*)(SC + (size_t)u * 16384 + (32 * et + r) * 128 + 16 * s + 8 * h);
    { const int krow = row0 + (sample ? (r < 16 ? r : 15) : r);
#pragma unroll
      for (int s = 0; s < 8; ++s) kf0[s] = *(const bf16x8*)(Z + (size_t)krow * NZ + 2048 + head * 128 + 16 * s + 8 * h); }
    __syncthreads();
    if (!(sample && tt == 1) && ((hp < 0) || ((head >> 1) == hp))) {
        f32x16 acc[4];
#pragma unroll
        for (int et = 0; et < 2; ++et) { acc[et] = zero16();
#pragma unroll
            for (int s = 0; s < 8; ++s) acc[et] = MFMA32(scf[et][s], qf[s], acc[et]); }
#pragma unroll
        for (int et = 2; et < 4; ++et) { acc[et] = zero16();
#pragma unroll
            for (int s = 0; s < 8; ++s) { const bf16x8 af = *(const bf16x8*)(SC + (size_t)u * 16384 + (32 * et + r) * 128 + 16 * s + 8 * h); acc[et] = MFMA32(af, qf[s], acc[et]); } }
        const float bt = BS[t], mtt = MT[t]; const float wint = __expf(bt + mprev - mtt);
#pragma unroll
        for (int et = 0; et < 4; ++et) acc[et] *= wint;
        float qn = 0.f;
#pragma unroll
        for (int s = 0; s < 8; ++s)
#pragma unroll
            for (int jj = 0; jj < 8; ++jj) qn += bf2f((unsigned short)qf[s][jj]) * NP[16 * s + 8 * h + jj];
        qn += __shfl_xor(qn, 32);
        float den = wint * qn, denp = 0.f;
        u32x2 ogv[4][4];
#pragma unroll
        for (int et = 0; et < 4; ++et)
#pragma unroll
            for (int g = 0; g < 4; ++g) ogv[et][g] = *(const u32x2*)(Z + (size_t)rowt * NZ + 3072 + head * 128 + 32 * et + 8 * g + 4 * h);
        for (int st = 0; st <= tt; ++st) {
            f32x16 S = zero16();
            const int kr = 32 * st + r; const int krow = row0 + (sample ? (kr < 16 ? kr : 15) : kr);
            if (st == 0) {
#pragma unroll
                for (int s = 0; s < 8; ++s) S = MFMA32(kf0[s], qf[s], S);
            } else {
#pragma unroll
                for (int s = 0; s < 8; ++s) { const bf16x8 kf = *(const bf16x8*)(Z + (size_t)krow * NZ + 2048 + head * 128 + 16 * s + 8 * h); S = MFMA32(kf, qf[s], S); }
            }
#pragma unroll
            for (int i = 0; i < 16; ++i) { const int sl = 32 * st + (i & 3) + 8 * (i >> 2) + 4 * h; const float wgt = (sl <= t) ? __expf(bt + AS[sl] - mtt) : 0.f; S[i] *= wgt; denp += S[i]; }
            const bf16x8 pf0 = pack8(S, 0), pf1 = pack8(S, 1);
#pragma unroll
            for (int et = 0; et < 4; ++et) {
                const bf16x8 v0 = vtr2(vbase + (32 * st + 4 * h + q4) * MPB + 2 * (32 * et + 16 * blk) + 8 * p4, 8 * MPB);
                const bf16x8 v1 = vtr2(vbase + (32 * st + 16 + 4 * h + q4) * MPB + 2 * (32 * et + 16 * blk) + 8 * p4, 8 * MPB);
                acc[et] = MFMA32(v0, pf0, acc[et]); acc[et] = MFMA32(v1, pf1, acc[et]);
            }
        }
        den += denp + __shfl_xor(denp, 32);
        const float dd = fmaxf(fabsf(den), __expf(-mtt)); const float inv = 1.0f / dd;
        float ssq = 0.f;
#pragma unroll
        for (int et = 0; et < 4; ++et) { acc[et] *= inv;
#pragma unroll
            for (int i = 0; i < 16; ++i) ssq += acc[et][i] * acc[et][i]; }
        ssq += __shfl_xor(ssq, 32);
        const float rr = 1.0f / sqrtf(ssq * (1.f / 128.f) + EPS);
        const bool ok = sample ? (t < 16) : true;
        if (ok) {
            const float* gml = a->in[14] + l * 512 + head * 128;
#pragma unroll
            for (int et = 0; et < 4; ++et)
#pragma unroll
                for (int g = 0; g < 4; ++g) { const int e0 = 32 * et + 8 * g + 4 * h;
                    const u32x2 ob = ogv[et][g]; const f32x4 gm = *(const f32x4*)(gml + e0);
                    const float o0 = bflo(ob.x), o1 = bfhi(ob.x), o2 = bflo(ob.y), o3 = bfhi(ob.y);
                    const float y0 = acc[et][4 * g] * rr * gm.x * __builtin_amdgcn_rcpf(1.f + __expf(-o0)), y1 = acc[et][4 * g + 1] * rr * gm.y * __builtin_amdgcn_rcpf(1.f + __expf(-o1));
                    const float y2 = acc[et][4 * g + 2] * rr * gm.z * __builtin_amdgcn_rcpf(1.f + __expf(-o2)), y3 = acc[et][4 * g + 3] * rr * gm.w * __builtin_amdgcn_rcpf(1.f + __expf(-o3));
                    u32x2 o; o.x = pk2(y0, y1); o.y = pk2(y2, y3);
                    *(u32x2*)(ACT + (size_t)rowt * DM + 512 + head * 128 + e0) = o; }
        }
    }
    __syncthreads();
}
DI void sample_m2(int l, int sb, int hp, LAS unsigned char* lds) {
    const ArgsP a = get_args(); const int tid = get_tid();
    bf16* SC = (bf16*)(a->ws + WS_SC); const float* BL = (const float*)(a->ws + WS_BL); const float* AC = (const float*)(a->ws + WS_AC);
    float* MPREV = (float*)(a->ws + WS_MPREV); const float* NC = (const float*)(a->ws + WS_NC); float* NPREV = (float*)(a->ws + WS_NPREV);
    LAS float* Lc = (LAS float*)lds; LAS float* Ls = Lc + 128 * 129;
    for (int hh = 2 * hp; hh < 2 * hp + 2; ++hh) {
        const int su = sb * 4 + hh, u = 1024 + su;
        const float* c0p = a->in[4] + (size_t)(l * 32 + su) * 16384; bf16* scp = SC + (size_t)u * 16384; float* ocp = a->out + O_CS + (size_t)(l * 32 + su) * 16384;
        const float m0 = a->in[6][l * 32 + su];
        const float bl = BL[u], ac = AC[u]; const float mn = bl + fmaxf(m0, ac); const float dec = expf(bl + m0 - mn), sc = expf(bl + ac - mn);
#pragma unroll 1
        for (int i0 = 0; i0 < 32; i0 += 16) {
            float cv[16]; unsigned short sv[16];
#pragma unroll
            for (int ii = 0; ii < 16; ++ii) { const int idx = tid + (i0 + ii) * NTHR; cv[ii] = c0p[idx]; sv[ii] = scp[idx]; }
#pragma unroll
            for (int ii = 0; ii < 16; ++ii) { const int idx = tid + (i0 + ii) * NTHR; const int r = idx >> 7, q = idx & 127; Lc[r * 129 + q] = cv[ii]; Ls[r * 129 + q] = bf2f(sv[ii]); }
        }
        __syncthreads();
#pragma unroll
        for (int ii = 0; ii < 32; ++ii) { const int idx = tid + ii * NTHR; const int r = idx >> 7, q = idx & 127;
            scp[idx] = (bf16)(pk2(Lc[q * 129 + r], 0.f) & 0xffffu);
            ocp[idx] = dec * Lc[r * 129 + q] + sc * Ls[q * 129 + r]; }
        if (tid < 128) { const float n0 = a->in[5][(size_t)(l * 32 + su) * 128 + tid]; NPREV[(size_t)u * 128 + tid] = n0; a->out[O_NS + (size_t)(l * 32 + su) * 128 + tid] = dec * n0 + sc * NC[(size_t)u * 128 + tid]; }
        if (tid == 0) { MPREV[u] = m0; a->out[O_MS + l * 32 + su] = mn; }
        __syncthreads();
    }
}
#define BLOCK_MEM_SYNC() do { asm volatile("s_waitcnt vmcnt(0)" ::: "memory"); __syncthreads(); __builtin_amdgcn_fence(__ATOMIC_ACQUIRE, "agent"); asm volatile("s_waitcnt vmcnt(0)" ::: "memory"); } while (0)
DI void load_bias(int l, LAS unsigned char* lds) {
    const ArgsP a = get_args(); const int tid = get_tid();
    for (int e = tid; e < 8 * 320; e += NTHR) { const int hd = e / 320, i = e % 320; ((LAS float*)(lds + 73728))[hd * 320 + i] = a->in[12][(size_t)(l * 8 + hd) * 513 + 193 + i] * 1.4426950408889634f; }
    __syncthreads();
}
DI void phase_c(int l, LAS unsigned char* lds) {
    phase_c_pre(l);
    const int bid = get_bid(), nb = get_nb();
    const bool deal = (nb == 256);
    const int v = deal ? ((bid & 7) * 32 + (bid >> 3)) : bid;
    for (int t = v; t < 16; t += nb) {
        m1_item(true, t >> 1, 0, lds, t & 1);
        BLOCK_MEM_SYNC();
        sample_m2(l, t >> 1, t & 1, lds);
        BLOCK_MEM_SYNC();
        m3_item(l, true, t >> 1, 0, lds, t & 1);
    }
    int p_lo, p_hi, p_st, m_lo, m_hi, m_st;
    if (deal) { const int w = v - 16; p_lo = w < 0 ? 520 : (w * 520) / 240; p_hi = w < 0 ? 520 : ((w + 1) * 520) / 240; p_st = 1;
                const int r2 = 3 * w - p_lo; const bool two = (w >= 0) && (p_hi - p_lo == 2); m_lo = two ? (r2 * 256) / 200 : 256; m_hi = two ? ((r2 + 1) * 256) / 200 : 256; m_st = 1; }
    else { p_lo = bid; p_hi = 520; p_st = nb; m_lo = bid; m_hi = 256; m_st = nb; }
    if (p_lo < p_hi) load_bias(l, lds);
    for (int p = p_lo; p < p_hi; p += p_st) {
        if (p >= 512) attn_unit<true>(l, p - 512, 0, 0, lds);
        else attn_unit<false>(l, p >> 8, (p >> 1) & 127, p & 1, lds);
    }
    __syncthreads();
    for (int t = m_lo; t < m_hi; t += m_st) m1_item(false, t >> 7, t & 127, lds);
}
DI void phase_e(int l, LAS unsigned char* lds) {
    const int bid = get_bid(), nb = get_nb(); const int v0 = (nb == 256) ? ((bid & 7) * 32 + (bid >> 3)) : bid;
    for (int it = v0; it < 256; it += nb) m3_item(l, false, it >> 7, it & 127, lds);
}

DI float gelu_tanh(float x) { const float ee = __builtin_amdgcn_exp2f(x * (2.3022082f + 0.10294324f * x * x)); return x - x * __builtin_amdgcn_rcpf(ee + 1.f); }
DI void ld8(const bf16* p, float (&o)[8]) { const u32x4 x = *(const u32x4*)p; o[0] = bflo(x.x); o[1] = bfhi(x.x); o[2] = bflo(x.y); o[3] = bfhi(x.y); o[4] = bflo(x.z); o[5] = bfhi(x.z); o[6] = bflo(x.w); o[7] = bfhi(x.w); }
DI void ldf8(const float* p, float (&o)[8]) { const f32x4 x = *(const f32x4*)p, y = *(const f32x4*)(p + 4); o[0] = x.x; o[1] = x.y; o[2] = x.z; o[3] = x.w; o[4] = y.x; o[5] = y.y; o[6] = y.z; o[7] = y.w; }
DI void phase_fix(int l) {
    const ArgsP a = get_args(); const int gt = get_bid() * NTHR + get_tid(), NTH = get_nb() * NTHR;
    const bf16* UQ = (const bf16*)(a->ws + WS_UQ); bf16* G = (bf16*)(a->ws + WS_G);
    const float* wc = a->in[17] + (size_t)l * 3 * NU; const float* bc = a->in[18] + (size_t)l * NU;
    for (int item = gt; item < (MVALID / 16) * 352; item += NTH) {
        const int k = item / 352, cc = item % 352, j0 = cc * 8; const int m0 = 16 * k;
        const bool smp = m0 >= MPR; const bool bstart = smp ? true : ((m0 & (SEQ - 1)) == 0); const int sb = smp ? (m0 - MPR) >> 4 : 0;
        float w0g[8], w1g[8], w2g[8], bg[8], w0u[8], w1u[8], w2u[8], bu[8];
        ldf8(wc + j0, w0g); ldf8(wc + NU + j0, w1g); ldf8(wc + 2 * NU + j0, w2g); ldf8(bc + j0, bg);
        ldf8(wc + DFF + j0, w0u); ldf8(wc + NU + DFF + j0, w1u); ldf8(wc + 2 * NU + DFF + j0, w2u); ldf8(bc + DFF + j0, bu);
        float p2g[8], p1g[8], p2u[8], p1u[8], c0g[8], c0u[8], c1g[8], c1u[8];
        if (bstart) {
            if (smp) { const float* cb = a->in[7] + (size_t)((l * 8 + sb) * 2) * NU; ldf8(cb + j0, p2g); ldf8(cb + NU + j0, p1g); ldf8(cb + DFF + j0, p2u); ldf8(cb + NU + DFF + j0, p1u); }
            else {
#pragma unroll
                for (int q = 0; q < 8; ++q) { p2g[q] = 0.f; p1g[q] = 0.f; p2u[q] = 0.f; p1u[q] = 0.f; } }
        } else { const bf16* pq = UQ + (size_t)(4 * (k - 1) + 2) * NU; ld8(pq + j0, p2g); ld8(pq + NU + j0, p1g); ld8(pq + DFF + j0, p2u); ld8(pq + NU + DFF + j0, p1u); }
        const bf16* cq = UQ + (size_t)(4 * k) * NU; ld8(cq + j0, c0g); ld8(cq + DFF + j0, c0u); ld8(cq + NU + j0, c1g); ld8(cq + NU + DFF + j0, c1u);
        float o0[8], o1[8];
#pragma unroll
        for (int q = 0; q < 8; ++q) {
            o0[q] = gelu_tanh(bg[q] + p2g[q] * w0g[q] + p1g[q] * w1g[q] + c0g[q] * w2g[q]) * (bu[q] + p2u[q] * w0u[q] + p1u[q] * w1u[q] + c0u[q] * w2u[q]);
            o1[q] = gelu_tanh(bg[q] + p1g[q] * w0g[q] + c0g[q] * w1g[q] + c1g[q] * w2g[q]) * (bu[q] + p1u[q] * w0u[q] + c0u[q] * w1u[q] + c1u[q] * w2u[q]); }
        u32x4 ov; ov.x = pk2(o0[0], o0[1]); ov.y = pk2(o0[2], o0[3]); ov.z = pk2(o0[4], o0[5]); ov.w = pk2(o0[6], o0[7]);
        *(u32x4*)(G + (size_t)m0 * DFF + j0) = ov;
        ov.x = pk2(o1[0], o1[1]); ov.y = pk2(o1[2], o1[3]); ov.z = pk2(o1[4], o1[5]); ov.w = pk2(o1[6], o1[7]);
        *(u32x4*)(G + (size_t)(m0 + 1) * DFF + j0) = ov;
        const bool lastg = smp ? true : ((m0 & (SEQ - 1)) == SEQ - 16);
        if (lastg) {
            float* fo = smp ? a->out + O_FS + (size_t)((l * 8 + sb) * 2) * NU : a->out + O_FP + (size_t)((l * 2 + (m0 >> 13)) * 2) * NU;
            float e0[8], e1[8]; const bf16* lq = UQ + (size_t)(4 * k + 2) * NU;
            ld8(lq + j0, e0); ld8(lq + NU + j0, e1);
            *(f32x4*)(fo + j0) = (f32x4){e0[0], e0[1], e0[2], e0[3]}; *(f32x4*)(fo + j0 + 4) = (f32x4){e0[4], e0[5], e0[6], e0[7]};
            *(f32x4*)(fo + NU + j0) = (f32x4){e1[0], e1[1], e1[2], e1[3]}; *(f32x4*)(fo + NU + j0 + 4) = (f32x4){e1[4], e1[5], e1[6], e1[7]};
            ld8(lq + DFF + j0, e0); ld8(lq + NU + DFF + j0, e1);
            *(f32x4*)(fo + DFF + j0) = (f32x4){e0[0], e0[1], e0[2], e0[3]}; *(f32x4*)(fo + DFF + j0 + 4) = (f32x4){e0[4], e0[5], e0[6], e0[7]};
            *(f32x4*)(fo + NU + DFF + j0) = (f32x4){e1[0], e1[1], e1[2], e1[3]}; *(f32x4*)(fo + NU + DFF + j0 + 4) = (f32x4){e1[4], e1[5], e1[6], e1[7]};
        }
    }
}

#define XB_TMO      128
#define XB_XCNT(j)  (256  + 64 * (j))
#define XB_XSUB(j)  (1280 + 64 * (j))
#define XB_XGEN(j)  (2304 + 64 * (j))
#define XB_TOP      3328
#define XB_TOPGEN   3392
#define XCD_BAR_WORDS 3456
#define XB_SPIN_CAP (1u << 18)
__device__ __forceinline__ unsigned xb_ld(unsigned* p)              { return __hip_atomic_load(p, __ATOMIC_RELAXED, __HIP_MEMORY_SCOPE_AGENT); }
__device__ __forceinline__ unsigned xb_add(unsigned* p, unsigned v) { return __hip_atomic_fetch_add(p, v, __ATOMIC_RELAXED, __HIP_MEMORY_SCOPE_AGENT); }
__device__ __forceinline__ unsigned xb_xcc_id() { return (unsigned)__builtin_amdgcn_s_getreg((3 << 11) | 20) & 0xFu; }
#define XB_SPIN(cond, bar) do { unsigned _sp = 0; while (cond) { __builtin_amdgcn_s_sleep(1); \
    if ((++_sp & 255u) == 0u) { if (xb_ld(&(bar)[XB_TMO])) break; if (_sp > XB_SPIN_CAP) { atomicAdd(&(bar)[XB_TMO], 1u); break; } } } } while (0)

struct XcdBarrier {
    unsigned* bar; unsigned x;
    volatile LAS unsigned* st;
};

__device__ __forceinline__ XcdBarrier xcd_barrier_post(unsigned* bar, volatile LAS unsigned* st) {
    XcdBarrier b; b.bar = bar; b.x = xb_xcc_id(); b.st = st;
    if (threadIdx.x == 0) (void)xb_add(&bar[XB_XCNT(b.x)], 1u);
    return b;
}
__device__ __forceinline__ void xcd_barrier_complete(unsigned* bar, unsigned x, unsigned& nloc, unsigned& nx) {
    const unsigned G = gridDim.x * gridDim.y * gridDim.z;
    unsigned sum, cnt, mine, sp = 0u;
    for (;;) {
        sum = 0u; cnt = 0u; mine = 0u;
#pragma unroll
        for (unsigned j = 0; j < 16; ++j) { const unsigned c = xb_ld(&bar[XB_XCNT(j)]); sum += c; cnt += (c > 0u) ? 1u : 0u; mine = (j == x) ? c : mine; }
        if (sum == G) break;
        __builtin_amdgcn_s_sleep(1);
        if ((++sp & 255u) == 0u) { if (xb_ld(&bar[XB_TMO])) break; if (sp > XB_SPIN_CAP) { atomicAdd(&bar[XB_TMO], 1u); break; } }
    }
    nloc = mine > 0u ? mine : 1u; nx = cnt > 0u ? cnt : 1u;
}

__device__ __forceinline__ void xcd_barrier(const XcdBarrier& b) {
    asm volatile("s_waitcnt vmcnt(0)" ::: "memory");
    __syncthreads();
    if (threadIdx.x == 0) {
        unsigned* bar = b.bar;
        __builtin_amdgcn_s_waitcnt(0);
        unsigned nloc = b.st[0], nx = b.st[1];
        if (nloc == 0u) { xcd_barrier_complete(bar, b.x, nloc, nx); b.st[0] = nloc; b.st[1] = nx; }
        const unsigned old = xb_add(&bar[XB_XSUB(b.x)], 1u);
        const unsigned gen = old / nloc;
        if (old + 1u == (gen + 1u) * nloc) {
            __builtin_amdgcn_fence(__ATOMIC_RELEASE, "agent");
            asm volatile("s_waitcnt vmcnt(0)" ::: "memory");
            const unsigned og = xb_add(&bar[XB_TOP], 1u);
            const unsigned tg = og / nx;
            if (og + 1u == (tg + 1u) * nx) xb_add(&bar[XB_TOPGEN], 1u);
            else XB_SPIN(xb_ld(&bar[XB_TOPGEN]) == tg, bar);
            __builtin_amdgcn_fence(__ATOMIC_ACQUIRE, "agent");
            xb_add(&bar[XB_XGEN(b.x)], 1u);
            asm volatile("s_waitcnt vmcnt(0)" ::: "memory");
        } else {
            XB_SPIN(xb_ld(&bar[XB_XGEN(b.x)]) == gen, bar);
            __builtin_amdgcn_fence(__ATOMIC_ACQUIRE, "agent");
            asm volatile("s_waitcnt vmcnt(0)" ::: "memory");
        }
    }
    __syncthreads();
}


#ifndef PHMASK
#define PHMASK 0xffff
#endif
#ifndef REP_GEMM
#define REP_GEMM 1
#endif
#ifndef REP_C
#define REP_C 1
#endif
#ifndef REP_E
#define REP_E 1
#endif
#ifndef REP_SYNC
#define REP_SYNC 1
#endif
#ifndef REP_CONV
#define REP_CONV 1
#endif
__global__ void __launch_bounds__(NTHR, 2) fwd_mega(Args a_unused) {
    extern __shared__ __attribute__((aligned(16))) unsigned char lds_raw[];
    LAS unsigned char* lds0 = (LAS unsigned char*)lds_raw;
    cg::grid_group grid = cg::this_grid();
    volatile LAS unsigned* st = (volatile LAS unsigned*)(lds0 + 147456);
    if (threadIdx.x < 4) st[threadIdx.x] = 0u;
    __syncthreads();
    unsigned* barw = (unsigned*)(get_args()->ws + WS_BAR);
    if (blockIdx.x == 0) { for (int i = threadIdx.x; i < XCD_BAR_WORDS; i += NTHR) __hip_atomic_store(barw + i, 0u, __ATOMIC_RELAXED, __HIP_MEMORY_SCOPE_AGENT); }
    grid.sync();
    const XcdBarrier bar = xcd_barrier_post(barw, st);
#pragma nounroll
    for (int step = 0; step < 21; ++step) {
        const int l = step / 10, ph = (step == 20) ? 12 : step % 10;
        LAS unsigned char* lds = lds0; asm volatile("" : "+s"(lds));
        if (ph == 1 || ph == 5 || ph == 7 || ph == 9) {
            if (PHMASK & 4) {
            const ArgsP a = get_args(); unsigned char* ws = a->ws;
            const bf16* A; const bf16* Bt; void* O; int M, N, K, mode;
            if (ph == 1)       { A = (const bf16*)(ws + WS_ACT); Bt = (const bf16*)(ws + WS_WIN); O = ws + WS_Z; M = MPAD; N = NZ + 256; K = DM; mode = 1; }
            else if (ph == 5)  { A = (const bf16*)(ws + WS_ACT); Bt = (const bf16*)(ws + WS_WOUT); O = ws + WS_MIX; M = MPR; N = DM; K = DM; mode = 0; }
            else if (ph == 7)  { A = (const bf16*)(ws + WS_ACT); Bt = (const bf16*)(ws + WS_WUP); O = ws + WS_G; M = MPAD; N = NU; K = DM; mode = 3; }
            else               { A = (const bf16*)(ws + WS_G); Bt = (const bf16*)(ws + WS_WDN); O = ws + WS_FFN; M = MPR; N = DM; K = DFF; mode = 0; }
            pg8::EpiGen E{O, N, mode, ws + WS_UQ, a->in[17] + (size_t)l * 3 * NU, a->in[18] + (size_t)l * NU, (float*)(ws + WS_IG), (float*)(ws + WS_LF), a->in[10] + l * 4, a->in[11] + l * 4};
            pg8::Gemm g{A, Bt, M, N, K}; pg8::StaticOrder S; S.init(M, N, get_nb(), get_bid());
            pg8::gemm_phase<pg8::EpiGen, pg8::StaticOrder, true, true>(lds, g, S, E);
            if (ph == 5 || ph == 9) mini_gemm(lds, A + (size_t)MPR * K, Bt, K, (bf16*)O + (size_t)MPR * DM);
            }
        } else if (ph == 0 || ph == 6 || ph == 12) {
            if (ph == 0 && (PHMASK & 1)) { phase_convert(l, lds); __syncthreads(); }
            if (PHMASK & 2) {
            const ArgsP a = get_args();
            const float* ngl = a->in[8] + (size_t)l * 4 * DM;
            bool first; const bf16* addsrc; const float* gadd; const float* gn; int gl;
            if (ph == 0) { first = (l == 0); addsrc = (l == 0) ? nullptr : (const bf16*)(a->ws + WS_FFN); gadd = ngl - DM; gn = ngl; gl = -1; }
            else if (ph == 6) { first = false; addsrc = (const bf16*)(a->ws + WS_MIX); gadd = ngl + DM; gn = ngl + 2 * DM; gl = -1; }
            else { first = false; addsrc = (const bf16*)(a->ws + WS_FFN); gadd = a->in[8] + (size_t)7 * DM; gn = nullptr; gl = -1; }
            phase_rows(lds, first, addsrc, gadd, gn, gl, ph == 12);
            }
        } else if (ph == 2) { if (PHMASK & 8) phase_c(l, lds); }
        else if (ph == 3) { if (PHMASK & 16) phase_m2(l, lds); }
        else if (ph == 4) { if (PHMASK & 32) phase_e(l, lds); }
        else { if (PHMASK & 512) phase_fix(l); }
        if (step < 20) xcd_barrier(bar);
    }
}

extern "C" void kernel_launch(void* const* d_in, const int* in_sizes, int n_in, void* d_out, int out_size, void* d_ws, size_t ws_size, hipStream_t stream) {
    static int grid = 0;
    if (grid == 0) {
        if (n_in != 20 || (size_t)out_size != O_END || ws_size < WS_END) { fprintf(stderr, "kernel_launch: unexpected shapes: n_in %d out %d ws %zu\n", n_in, out_size, ws_size); grid = -1; return; }
        int dev = 0, cus = 0, per_cu = 0;
        (void)hipGetDevice(&dev);
        (void)hipDeviceGetAttribute(&cus, hipDeviceAttributeMultiprocessorCount, dev);
        (void)hipFuncSetAttribute((const void*)fwd_mega, hipFuncAttributeMaxDynamicSharedMemorySize, LDS_BYTES);
        (void)hipOccupancyMaxActiveBlocksPerMultiprocessor(&per_cu, (const void*)fwd_mega, NTHR, LDS_BYTES);
        if (per_cu < 1) per_cu = 1;
        grid = cus * per_cu;
    }
    if (grid < 0) return;
    Args a{};
    for (int i = 0; i < 20; ++i) a.in[i] = (const float*)d_in[i];
    a.out = (float*)d_out; a.ws = (unsigned char*)d_ws;
    void* args[] = {&a};
    hipError_t e = hipLaunchCooperativeKernel((const void*)fwd_mega, dim3(grid), dim3(NTHR), args, LDS_BYTES, stream);
    if (e != hipSuccess) fprintf(stderr, "cooperative launch failed: %s (grid %d)\n", hipGetErrorString(e), grid);
}
```
